# Optimizing an MI355X kernel written in HIP

```python
import jax, jax.numpy as jnp
from jax import lax
import numpy as np

D_MODEL = 1024
BATCH = 8
SEQ = 8192
DEPTH = 1
DEC_BATCH = 4
DEC_SEQ = 8192
PAST_LEN = 128

N_META = 16
GRID_W = 64
HEAD_DIM = 64
N_Q_HEADS = 8
N_KV_HEADS = 2
ATTN_WIDTH = N_Q_HEADS * HEAD_DIM
KV_WIDTH = N_KV_HEADS * HEAD_DIM
LRU_WIDTH = D_MODEL - ATTN_WIDTH
LRU_BLOCKS = 8
LRU_BLOCK_W = LRU_WIDTH // LRU_BLOCKS
IN_WIDTH = ATTN_WIDTH + 2 * KV_WIDTH + 2 * LRU_WIDTH
CONV_W = 4
CONV_LEFT = 2
LRU_C = 8.0
ROPE_AXIS_DIM = HEAD_DIM // 2
ROPE_THETA = 10000.0
Q_BLOCK = 128
FFN_HIDDEN = -(-8 * D_MODEL // (3 * 256)) * 256
EPS = 1e-6

kernel_name = "hymba_griffin_axial_gqa_encoder"


def rms_norm(x, g):
    xf = x.astype(jnp.float32)
    y = xf * lax.rsqrt(jnp.mean(xf * xf, axis=-1, keepdims=True) + EPS)
    return (y * g.astype(jnp.float32)).astype(x.dtype)


def axial_rope_tables(n_tokens):
    n_rows = n_tokens // GRID_W
    row = jnp.repeat(jnp.arange(n_rows), GRID_W).astype(jnp.float32)
    col = jnp.tile(jnp.arange(GRID_W), n_rows).astype(jnp.float32)
    freqs = ROPE_THETA ** (-jnp.arange(0, ROPE_AXIS_DIM, 2, dtype=jnp.float32) / ROPE_AXIS_DIM)
    ang = jnp.concatenate([row[:, None] * freqs, col[:, None] * freqs], axis=-1)
    ang = jnp.concatenate([jnp.zeros((N_META, ang.shape[1]), jnp.float32), ang], axis=0)
    return jnp.cos(ang), jnp.sin(ang)


def rotate_half_split(xp, c, s):
    h = xp.shape[-1] // 2
    x1, x2 = xp[..., :h], xp[..., h:]
    c = c[None, :, None, :]
    s = s[None, :, None, :]
    return jnp.concatenate([x1 * c - x2 * s, x2 * c + x1 * s], axis=-1)


def apply_axial_rope(x, cos, sin):
    xf = x.astype(jnp.float32)
    hf = ROPE_AXIS_DIM // 2
    xr = rotate_half_split(xf[..., :ROPE_AXIS_DIM], cos[:, :hf], sin[:, :hf])
    xc = rotate_half_split(xf[..., ROPE_AXIS_DIM:], cos[:, hf:], sin[:, hf:])
    return jnp.concatenate([xr, xc], axis=-1).astype(x.dtype)


def gqa_attention(q, k, v):
    B, L = q.shape[0], q.shape[1]
    G = N_Q_HEADS // N_KV_HEADS
    q = (q * (HEAD_DIM ** -0.5)).reshape(B, L, N_KV_HEADS, G, HEAD_DIM)

    def block(qb):
        s = jnp.einsum('bqkgd,bskd->bkgqs', qb, k).astype(jnp.float32)
        p = jax.nn.softmax(s, axis=-1).astype(v.dtype)
        return jnp.einsum('bkgqs,bskd->bqkgd', p, v)

    o_meta = block(q[:, :N_META]).reshape(B, N_META, ATTN_WIDTH)
    n_real = L - N_META
    nb = n_real // Q_BLOCK
    q_real = jnp.moveaxis(q[:, N_META:].reshape(B, nb, Q_BLOCK, N_KV_HEADS, G, HEAD_DIM), 1, 0)
    o_real = lax.map(block, q_real)
    o_real = jnp.moveaxis(o_real, 0, 1).reshape(B, n_real, ATTN_WIDTH)
    return jnp.concatenate([o_meta, o_real], axis=1)


def centred_depthwise_conv(x, w, b):
    L = x.shape[1]
    xp = jnp.pad(x, ((0, 0), (CONV_LEFT, CONV_W - 1 - CONV_LEFT), (0, 0)))
    out = b
    for j in range(CONV_W):
        out = out + xp[:, j:j + L] * w[j]
    return out


def _lin_combine(e1, e2):
    a1, b1 = e1
    a2, b2 = e2
    return a1 * a2, a2 * b1 + b2


def rg_lru_bidirectional(x, w_a, b_a, w_x, b_x, lam):
    B, L, W = x.shape
    xf = x.astype(jnp.float32)
    xb = xf.reshape(B, L, LRU_BLOCKS, LRU_BLOCK_W)
    ga = jnp.einsum('blhi,dhij->dblhj', xb, w_a.astype(jnp.float32)).reshape(2, B, L, W)
    gx = jnp.einsum('blhi,dhij->dblhj', xb, w_x.astype(jnp.float32)).reshape(2, B, L, W)
    r = jax.nn.sigmoid(ga + b_a.astype(jnp.float32)[:, None, None, :])
    i = jax.nn.sigmoid(gx + b_x.astype(jnp.float32)[:, None, None, :])
    log_a = -LRU_C * jax.nn.softplus(-lam.astype(jnp.float32))[:, None, None, :] * r
    a = jnp.exp(log_a)
    u = jnp.sqrt(-jnp.expm1(2.0 * log_a)) * (i * xf[None])
    h_f = lax.associative_scan(_lin_combine, (a[0], u[0]), axis=1)[1]
    h_b = lax.associative_scan(_lin_combine, (a[1], u[1]), axis=1, reverse=True)[1]
    return (h_f + h_b).astype(x.dtype)


def trunk(x, meta_tokens, norm_mix_g, w_in, q_norm_g, k_norm_g, conv_w, conv_b,
          lru_w_a, lru_b_a, lru_w_x, lru_b_x, lru_lam, attn_out_g, lru_out_g, w_out,
          norm_ffn_g, w_gate_up, w_down, final_norm_g):
    B, n_tok = x.shape[0], x.shape[1]
    cos, sin = axial_rope_tables(n_tok)
    h = jnp.concatenate([jnp.broadcast_to(meta_tokens.astype(x.dtype)[None], (B, N_META, D_MODEL)), x], axis=1)
    L = h.shape[1]
    splits = np.cumsum([ATTN_WIDTH, KV_WIDTH, KV_WIDTH, LRU_WIDTH]).tolist()
    for l in range(DEPTH):
        xn = rms_norm(h, norm_mix_g[l])
        proj = xn @ w_in[l]
        q, k, v, lru_in, lru_gate = jnp.split(proj, splits, axis=-1)
        q = rms_norm(q.reshape(B, L, N_Q_HEADS, HEAD_DIM), q_norm_g[l])
        k = rms_norm(k.reshape(B, L, N_KV_HEADS, HEAD_DIM), k_norm_g[l])
        v = v.reshape(B, L, N_KV_HEADS, HEAD_DIM)
        q = apply_axial_rope(q, cos, sin)
        k = apply_axial_rope(k, cos, sin)
        attn_o = rms_norm(gqa_attention(q, k, v), attn_out_g[l])
        c = centred_depthwise_conv(lru_in, conv_w[l], conv_b[l])
        rec = rg_lru_bidirectional(c, lru_w_a[l], lru_b_a[l], lru_w_x[l], lru_b_x[l], lru_lam[l])
        lru_o = rms_norm(rec * jax.nn.gelu(lru_gate), lru_out_g[l])
        h = h + jnp.concatenate([attn_o, lru_o], axis=-1) @ w_out[l]
        xn = rms_norm(h, norm_ffn_g[l])
        g, u = jnp.split(xn @ w_gate_up[l], 2, axis=-1)
        h = h + (jax.nn.silu(g) * u) @ w_down[l]
    h = rms_norm(h, final_norm_g)
    return h[:, N_META:]


def setup_inputs(seed: int = 0) -> dict:
    key = jax.random.key(seed)
    ks = jax.random.split(key, 24)
    f32 = jnp.float32
    nrm = lambda k, shape, scale: scale * jax.random.normal(k, shape, f32)
    gain = lambda k, shape: 1.0 + 0.02 * jax.random.normal(k, shape, f32)
    u = jax.random.uniform(ks[14], (DEPTH, 2, LRU_WIDTH), f32, minval=0.9, maxval=0.999)
    s = u ** (1.0 / LRU_C)
    lru_lam = jnp.log(s) - jnp.log1p(-s)
    return {
        "x_prompt": jax.random.normal(ks[0], (BATCH, SEQ, D_MODEL), f32),
        "x_sample": jax.random.normal(ks[1], (DEC_BATCH, DEC_SEQ, D_MODEL), f32),
        "meta_tokens": nrm(ks[2], (N_META, D_MODEL), 1.0),
        "norm_mix_g": gain(ks[3], (DEPTH, D_MODEL)),
        "w_in": nrm(ks[4], (DEPTH, D_MODEL, IN_WIDTH), D_MODEL ** -0.5),
        "q_norm_g": gain(ks[5], (DEPTH, HEAD_DIM)),
        "k_norm_g": gain(ks[6], (DEPTH, HEAD_DIM)),
        "conv_w": nrm(ks[7], (DEPTH, CONV_W, LRU_WIDTH), CONV_W ** -0.5),
        "conv_b": nrm(ks[8], (DEPTH, LRU_WIDTH), 0.01),
        "lru_w_a": nrm(ks[9], (DEPTH, 2, LRU_BLOCKS, LRU_BLOCK_W, LRU_BLOCK_W), LRU_BLOCK_W ** -0.5),
        "lru_b_a": nrm(ks[10], (DEPTH, 2, LRU_WIDTH), 0.01),
        "lru_w_x": nrm(ks[11], (DEPTH, 2, LRU_BLOCKS, LRU_BLOCK_W, LRU_BLOCK_W), LRU_BLOCK_W ** -0.5),
        "lru_b_x": nrm(ks[12], (DEPTH, 2, LRU_WIDTH), 0.01),
        "lru_lam": lru_lam,
        "attn_out_g": gain(ks[15], (DEPTH, ATTN_WIDTH)),
        "lru_out_g": gain(ks[16], (DEPTH, LRU_WIDTH)),
        "w_out": nrm(ks[17], (DEPTH, D_MODEL, D_MODEL), D_MODEL ** -0.5),
        "norm_ffn_g": gain(ks[18], (DEPTH, D_MODEL)),
        "w_gate_up": nrm(ks[19], (DEPTH, D_MODEL, 2 * FFN_HIDDEN), D_MODEL ** -0.5),
        "w_down": nrm(ks[20], (DEPTH, FFN_HIDDEN, D_MODEL), FFN_HIDDEN ** -0.5),
        "final_norm_g": gain(ks[21], (D_MODEL,)),
    }


def reference(x_prompt, x_sample, meta_tokens, norm_mix_g, w_in, q_norm_g, k_norm_g, conv_w, conv_b,
              lru_w_a, lru_b_a, lru_w_x, lru_b_x, lru_lam, attn_out_g, lru_out_g, w_out,
              norm_ffn_g, w_gate_up, w_down, final_norm_g):
    weights = (meta_tokens, norm_mix_g, w_in, q_norm_g, k_norm_g, conv_w, conv_b,
               lru_w_a, lru_b_a, lru_w_x, lru_b_x, lru_lam, attn_out_g, lru_out_g, w_out,
               norm_ffn_g, w_gate_up, w_down, final_norm_g)
    y_prompt = trunk(x_prompt, *weights)
    y_sample = trunk(x_sample, *weights)
    return (y_prompt, y_sample)
```

```cpp
#include <hip/hip_runtime.h>
#include <hip/hip_cooperative_groups.h>
#include <hip/hip_bf16.h>
#include <cstdio>
#include <cstdint>
#include <cmath>
namespace cg = cooperative_groups;

namespace pg8 {
#define PG8_LAS __attribute__((address_space(3)))
typedef unsigned short bf16_t;
typedef short bf16x8 __attribute__((ext_vector_type(8)));
typedef float f32x4 __attribute__((ext_vector_type(4)));
typedef unsigned u32x4 __attribute__((ext_vector_type(4)));
constexpr int BM = 256, BK = 64, HALF = 128, HTB = HALF * BK * 2  , STAGE_BYTES = 8 * HTB, NXCD = 8, WGM = 8;

__host__ __device__ __forceinline__ int lds_byte(int r, int c) { const int st = (r >> 4) * 2 + (c >> 5), rr = r & 15, cc = c & 31, ob = rr * 64 + cc * 2; return st * 1024 + (ob ^ (((ob >> 9) & 1) << 5)); }
__host__ __device__ __forceinline__ void stage_rc(int b, int& R, int& C) { const int st = b / 1024, sb = b % 1024, swz = sb ^ (((sb >> 9) & 1) << 5); R = (st >> 1) * 16 + swz / 64; C = (st & 1) * 32 + (swz % 64) / 2; }
__host__ __device__ __forceinline__ int perm32(int rho) { const int n = rho >> 4, i = rho & 15; return 8 * (i >> 2) + 4 * n + (i & 3); }

struct Unit { int pm, pn; };
struct Gemm { const bf16_t* A; const bf16_t* Bt; int M, N, K; };

struct StaticOrder {
    int nM, nN, nwg, G, c;
    __host__ __device__ void init(int M, int N, int G_, int c_) { nM = M / BM; nN = N / BM; nwg = nM * nN; G = G_; c = c_; }
    __host__ __device__ bool next(int i, Unit& u) const {
        const long L = (long)i * G + c; if (L >= nwg) return false;
        int wgid = (int)L; { const int q = nwg / NXCD, r = nwg % NXCD, xcd = wgid % NXCD, off = wgid / NXCD; wgid = (xcd < r ? xcd * (q + 1) : r * (q + 1) + (xcd - r) * q) + off; }
        const int nig = WGM * nN, gid = wgid / nig, fm = gid * WGM, gsz = (nM - fm) < WGM ? (nM - fm) : WGM;
        u.pm = fm + ((wgid % nig) % gsz); u.pn = (wgid % nig) / gsz; return true;
    }
    __device__ __forceinline__ void a_ready(const Unit&) const {}
    __device__ __forceinline__ void done(const Unit&) const {}
};


template <class Epi, class Sched, bool ALIGN_EPI = false, bool SP2 = false>
__device__ __forceinline__ void gemm_phase(PG8_LAS unsigned char* lds, const Gemm g, const Sched& S, const Epi& E) {
    const int tid = threadIdx.x, wid = __builtin_amdgcn_readfirstlane(tid >> 6), lane = tid & 63, wr = wid >> 2, wc = wid & 3, fr = lane & 15, fq = lane >> 4;
    const int K = g.K, nt = K / BK;
    unsigned voffA[2], voffB[2];
#pragma unroll
    for (int i = 0; i < 2; ++i) { int R, C; stage_rc(tid * 16 + i * 8192, R, C); const int Rb = Epi::PERM ? ((R & ~31) + perm32(R & 31)) : R;
        voffA[i] = (unsigned)(R * K + C) * 2u; voffB[i] = (unsigned)(Rb * K + C) * 2u; }
    const size_t kstep = (size_t)(BK * 2);
    const size_t hstep = (size_t)HALF * K * 2;
    const size_t tstep = 2 * hstep;
    const unsigned ldsw = (unsigned)wid * 1024u;
    const int aoff = lds_byte(wr * 64 + fr, fq * 8), boff = lds_byte(wc * 32 + fr, fq * 8);
#define PG8_SA(b, h) (((b) * 2 + (h)) * HTB)
#define PG8_SB(b, h) ((4 + (b) * 2 + (h)) * HTB)
#define PG8_STAGE(bufoff, gbase, voff) do { _Pragma("unroll") for (int _i = 0; _i < 2; ++_i) \
        __builtin_amdgcn_global_load_lds((const unsigned*)((const char*)(gbase) + (voff)[_i]), (PG8_LAS unsigned*)(lds + (bufoff) + ldsw + _i * 8192), 16, 0, 0); } while (0)
#define PG8_LDA(dst, b, h) do { _Pragma("unroll") for (int m = 0; m < 4; ++m) _Pragma("unroll") for (int k = 0; k < 2; ++k) dst[m][k] = *(const PG8_LAS bf16x8*)(lds + PG8_SA(b, h) + aoff + m * 2048 + k * 1024); } while (0)
#define PG8_LDB(dst, b, h) do { _Pragma("unroll") for (int n = 0; n < 2; ++n) _Pragma("unroll") for (int k = 0; k < 2; ++k) dst[n][k] = *(const PG8_LAS bf16x8*)(lds + PG8_SB(b, h) + boff + n * 2048 + k * 1024); } while (0)
#define PG8_MMA(ai, bj, At, Bt) do { __builtin_amdgcn_s_setprio(1); _Pragma("unroll") for (int m = 0; m < 4; ++m) _Pragma("unroll") for (int n = 0; n < 2; ++n) _Pragma("unroll") for (int k = 0; k < 2; ++k) \
        acc[ai][bj][m][n] = __builtin_amdgcn_mfma_f32_16x16x32_bf16(Bt[n][k], At[m][k], acc[ai][bj][m][n], 0, 0, 0); __builtin_amdgcn_s_setprio(0); } while (0)
#define PG8_WAIT_V(n) asm volatile("s_waitcnt vmcnt(" #n ")" ::: "memory")
#define PG8_WAIT_L(n) asm volatile("s_waitcnt lgkmcnt(" #n ")" ::: "memory")
#define PG8_BAR __builtin_amdgcn_s_barrier()
#define PG8_SCHED __builtin_amdgcn_sched_barrier(0)
    Unit cur, nxt; int ui = 0;
    if (!S.next(0, cur)) return;
    f32x4 acc[2][2][4][2];
#pragma unroll
    for (int a = 0; a < 2; ++a)
#pragma unroll
        for (int b = 0; b < 2; ++b)
#pragma unroll
            for (int m = 0; m < 4; ++m)
#pragma unroll
                for (int n = 0; n < 2; ++n) acc[a][b][m][n] = (f32x4){0.f, 0.f, 0.f, 0.f};
    bf16x8 At[4][2], B0[2][2], B1[2][2];
    const char* cA = (const char*)g.A + (size_t)cur.pm * tstep; const char* cB = (const char*)g.Bt + (size_t)cur.pn * tstep;
    S.a_ready(cur);
    if constexpr (SP2) {
        PG8_STAGE(PG8_SB(0, 0), cB, voffB); PG8_STAGE(PG8_SB(0, 1), cB + hstep, voffB); PG8_STAGE(PG8_SA(0, 0), cA, voffA); PG8_STAGE(PG8_SA(0, 1), cA + hstep, voffA);
        if (wr == 1) PG8_BAR;
        PG8_WAIT_V(2); PG8_BAR;
        PG8_STAGE(PG8_SB(1, 0), cB + kstep, voffB); PG8_STAGE(PG8_SA(1, 0), cA + kstep, voffA); PG8_STAGE(PG8_SB(1, 1), cB + hstep + kstep, voffB);
        PG8_WAIT_V(6); PG8_BAR;
    } else {
        PG8_STAGE(PG8_SB(0, 0), cB, voffB); PG8_STAGE(PG8_SA(0, 0), cA, voffA); PG8_STAGE(PG8_SB(0, 1), cB + hstep, voffB); PG8_STAGE(PG8_SA(0, 1), cA + hstep, voffA);
        if (wr == 1) PG8_BAR;
        PG8_WAIT_V(4); PG8_BAR;
        PG8_STAGE(PG8_SB(1, 0), cB + kstep, voffB); PG8_STAGE(PG8_SA(1, 0), cA + kstep, voffA); PG8_STAGE(PG8_SB(1, 1), cB + hstep + kstep, voffB);
        PG8_WAIT_V(6); PG8_BAR;
    }
    for (;;) {
        const bool has_next = S.next(ui + 1, nxt);
        const char* nA = has_next ? (const char*)g.A + (size_t)nxt.pm * tstep : cA; const char* nB = has_next ? (const char*)g.Bt + (size_t)nxt.pn * tstep : cB;
        for (int t = 0; t < nt; t += 2) {
            const bool last = (t == nt - 2);
            const char* a1 = cA + (size_t)(t + 1) * kstep;
            const char* a2 = last ? nA : cA + (size_t)(t + 2) * kstep; const char* b2 = last ? nB : cB + (size_t)(t + 2) * kstep;
            const char* a3 = a2 + kstep; const char* b3 = b2 + kstep;
            if (last && has_next) S.a_ready(nxt);
            if constexpr (SP2) {
            PG8_LDB(B0, 0, 0); PG8_LDB(B1, 0, 1); PG8_SCHED; PG8_LDA(At, 0, 0); PG8_STAGE(PG8_SA(1, 1), a1 + hstep, voffA);
            PG8_WAIT_V(8); PG8_WAIT_L(0); PG8_BAR; PG8_MMA(0, 0, At, B0); PG8_MMA(0, 1, At, B1); PG8_BAR; PG8_SCHED;
            PG8_LDA(At, 0, 1); PG8_STAGE(PG8_SB(0, 0), b2, voffB); PG8_STAGE(PG8_SB(0, 1), b2 + hstep, voffB); PG8_STAGE(PG8_SA(0, 0), a2, voffA);
            PG8_WAIT_V(8); PG8_WAIT_L(0); PG8_BAR; PG8_MMA(1, 0, At, B0); PG8_MMA(1, 1, At, B1); PG8_BAR; PG8_SCHED;
            PG8_LDB(B0, 1, 0); PG8_LDB(B1, 1, 1); PG8_SCHED; PG8_LDA(At, 1, 0); PG8_STAGE(PG8_SA(0, 1), a2 + hstep, voffA);
            PG8_WAIT_V(8); PG8_WAIT_L(0); PG8_BAR; PG8_MMA(0, 0, At, B0); PG8_MMA(0, 1, At, B1); PG8_BAR; PG8_SCHED;
            PG8_LDA(At, 1, 1); PG8_STAGE(PG8_SB(1, 0), b3, voffB); PG8_STAGE(PG8_SB(1, 1), b3 + hstep, voffB); PG8_STAGE(PG8_SA(1, 0), a3, voffA);
            PG8_WAIT_V(8); PG8_WAIT_L(0); PG8_BAR; PG8_MMA(1, 0, At, B0); PG8_MMA(1, 1, At, B1); PG8_BAR; PG8_SCHED;
            } else {
            PG8_LDB(B0, 0, 0); PG8_SCHED; PG8_LDA(At, 0, 0); PG8_STAGE(PG8_SA(1, 1), a1 + hstep, voffA);
            PG8_WAIT_L(8); PG8_BAR; PG8_WAIT_L(0); PG8_MMA(0, 0, At, B0); PG8_BAR; PG8_SCHED;
            PG8_LDB(B1, 0, 1); PG8_STAGE(PG8_SB(0, 0), b2, voffB);
            PG8_BAR; PG8_WAIT_L(0); PG8_MMA(0, 1, At, B1); PG8_BAR;
            PG8_LDA(At, 0, 1); PG8_STAGE(PG8_SA(0, 0), a2, voffA);
            PG8_BAR; PG8_WAIT_L(0); PG8_MMA(1, 0, At, B0); PG8_BAR; PG8_SCHED;
            PG8_STAGE(PG8_SB(0, 1), b2 + hstep, voffB);
            PG8_WAIT_V(6); PG8_BAR; PG8_MMA(1, 1, At, B1); PG8_BAR;
            PG8_LDB(B0, 1, 0); PG8_SCHED; PG8_LDA(At, 1, 0); PG8_STAGE(PG8_SA(0, 1), a2 + hstep, voffA);
            PG8_WAIT_L(8); PG8_BAR; PG8_WAIT_L(0); PG8_MMA(0, 0, At, B0); PG8_BAR; PG8_SCHED;
            PG8_LDB(B1, 1, 1); PG8_STAGE(PG8_SB(1, 0), b3, voffB);
            PG8_BAR; PG8_WAIT_L(0); PG8_MMA(0, 1, At, B1); PG8_BAR;
            PG8_LDA(At, 1, 1); PG8_STAGE(PG8_SA(1, 0), a3, voffA);
            PG8_BAR; PG8_WAIT_L(0); PG8_MMA(1, 0, At, B0); PG8_BAR; PG8_SCHED;
            PG8_STAGE(PG8_SB(1, 1), b3 + hstep, voffB);
            PG8_WAIT_V(6); PG8_BAR; PG8_MMA(1, 1, At, B1); PG8_BAR;
            }
        }
        if constexpr (ALIGN_EPI) { if (wr == 0) PG8_BAR; }
        if constexpr (!Epi::AFTER_DRAIN) { E(acc, cur, wr, wc, fr, fq); S.done(cur); }
        if (!has_next) break;
#pragma unroll
        for (int a = 0; a < 2; ++a)
#pragma unroll
            for (int b = 0; b < 2; ++b)
#pragma unroll
                for (int m = 0; m < 4; ++m)
#pragma unroll
                    for (int n = 0; n < 2; ++n) acc[a][b][m][n] = (f32x4){0.f, 0.f, 0.f, 0.f};
        cur = nxt; cA = nA; cB = nB; ++ui;
        if constexpr (ALIGN_EPI) { if (wr == 1) PG8_BAR; }
    }
    PG8_WAIT_V(0);
    if constexpr (!ALIGN_EPI) { if (wr == 0) PG8_BAR; }
    PG8_BAR;
    if constexpr (Epi::AFTER_DRAIN) { E.fused(acc, cur, wr, wc, fr, fq, lds, wid, lane); S.done(cur); }
#undef PG8_SA
#undef PG8_SB
#undef PG8_STAGE
#undef PG8_LDA
#undef PG8_LDB
#undef PG8_MMA
#undef PG8_WAIT_V
#undef PG8_WAIT_L
#undef PG8_BAR
#undef PG8_SCHED
}
}

namespace pg8 {
typedef float f32x2e __attribute__((ext_vector_type(2))); typedef __bf16 bf16x2e __attribute__((ext_vector_type(2))); typedef unsigned u32x2e __attribute__((ext_vector_type(2)));
__device__ __forceinline__ unsigned pkbf(float lo, float hi) { f32x2e v = {lo, hi}; bf16x2e b = __builtin_convertvector(v, bf16x2e); return __builtin_bit_cast(unsigned, b); }
struct EpiStore {
    static constexpr bool PERM = true, AFTER_DRAIN = false;
    bf16_t* O; int ldc;
    __device__ __forceinline__ void operator()(const f32x4 (&acc)[2][2][4][2], const Unit& u, int wr, int wc, int fr, int fq) const {
        const int row0 = u.pm * BM + wr * 64 + fr, col0 = u.pn * BM + wc * 32 + 8 * fq;
#pragma unroll
        for (int ai = 0; ai < 2; ++ai)
#pragma unroll
            for (int m = 0; m < 4; ++m) { bf16_t* rowp = O + (size_t)(row0 + ai * HALF + m * 16) * ldc + col0;
#pragma unroll
                for (int bj = 0; bj < 2; ++bj) { const f32x4 v0 = acc[ai][bj][m][0], v1 = acc[ai][bj][m][1];
                    u32x4 w; w.x = pkbf(v0[0], v0[1]); w.y = pkbf(v0[2], v0[3]); w.z = pkbf(v1[0], v1[1]); w.w = pkbf(v1[2], v1[3]);
                    *(u32x4*)(rowp + bj * HALF) = w; } }
    }
};
struct EpiResid1 {
    static constexpr bool PERM = false, AFTER_DRAIN = false;
    const float* xp; const float* xs; float* out; bf16_t* hb; float* ssq;
    __device__ __forceinline__ void operator()(const f32x4 (&acc)[2][2][4][2], const Unit& u, int wr, int wc, int fr, int fq) const {
        const int rbase = u.pm * BM;
        const float* xb = rbase < 65536 ? xp + (size_t)rbase * 1024 : xs + (size_t)(rbase - 65536) * 1024;
        float* ob = out + (size_t)rbase * 1024; bf16_t* hbb = hb + (size_t)rbase * 1024;
        const int col0 = u.pn * BM + wc * 32 + 4 * fq;
#pragma unroll
        for (int ai = 0; ai < 2; ++ai)
#pragma unroll
            for (int m = 0; m < 4; ++m) { const int r = ai * HALF + wr * 64 + m * 16 + fr; float s = 0.f;
#pragma unroll
                for (int bj = 0; bj < 2; ++bj)
#pragma unroll
                    for (int n = 0; n < 2; ++n) { const size_t off = (size_t)r * 1024 + col0 + bj * HALF + n * 16;
                        const f32x4 h = *(const f32x4*)(xb + off) + acc[ai][bj][m][n];
                        *(f32x4*)(ob + off) = h; u32x2e w; w.x = pkbf(h[0], h[1]); w.y = pkbf(h[2], h[3]); *(u32x2e*)(hbb + off) = w;
                        s += (h[0] * h[0] + h[1] * h[1]) + (h[2] * h[2] + h[3] * h[3]); }
                s += __shfl_xor(s, 16); s += __shfl_xor(s, 32);
                if (fq == 0) ssq[(size_t)(rbase + r) * 16 + u.pn * 4 + wc] = s; }
    }
};
struct EpiSwiglu {
    static constexpr bool PERM = true, AFTER_DRAIN = false;
    bf16_t* H; int ldh; const float* ssq;
    __device__ __forceinline__ void operator()(const f32x4 (&acc)[2][2][4][2], const Unit& u, int wr, int wc, int fr, int fq) const {
        const int col0 = u.pn * HALF + wc * 32 + 8 * fq;
#pragma unroll
        for (int ai = 0; ai < 2; ++ai)
#pragma unroll
            for (int m = 0; m < 4; ++m) { const int row = u.pm * BM + ai * HALF + wr * 64 + m * 16 + fr;
                const f32x4* sp = (const f32x4*)(ssq + (size_t)row * 16); const f32x4 a = sp[0], b = sp[1], c = sp[2], d = sp[3];
                const float tot = (((a[0] + a[1]) + (a[2] + a[3])) + ((b[0] + b[1]) + (b[2] + b[3]))) + (((c[0] + c[1]) + (c[2] + c[3])) + ((d[0] + d[1]) + (d[2] + d[3])));
                const float rstd = __builtin_amdgcn_rsqf(tot * (1.0f / 1024.0f) + 1e-6f);
                float hv[8];
#pragma unroll
                for (int n = 0; n < 2; ++n)
#pragma unroll
                    for (int i = 0; i < 4; ++i) { const float g = acc[ai][0][m][n][i] * rstd, uu = acc[ai][1][m][n][i] * rstd;
                        const float sg = g * __builtin_amdgcn_rcpf(1.0f + __builtin_amdgcn_exp2f(g * -1.4426950408889634f)); hv[n * 4 + i] = sg * uu; }
                u32x4 w; w.x = pkbf(hv[0], hv[1]); w.y = pkbf(hv[2], hv[3]); w.z = pkbf(hv[4], hv[5]); w.w = pkbf(hv[6], hv[7]);
                *(u32x4*)(H + (size_t)row * ldh + col0) = w; }
    }
};
struct EpiResid2 {
    static constexpr bool PERM = false, AFTER_DRAIN = false;
    float* out; float* ssq;
    __device__ __forceinline__ void operator()(const f32x4 (&acc)[2][2][4][2], const Unit& u, int wr, int wc, int fr, int fq) const {
        const int rbase = u.pm * BM; float* ob = out + (size_t)rbase * 1024;
        const int col0 = u.pn * BM + wc * 32 + 4 * fq;
#pragma unroll
        for (int ai = 0; ai < 2; ++ai)
#pragma unroll
            for (int m = 0; m < 4; ++m) { const int r = ai * HALF + wr * 64 + m * 16 + fr; float s = 0.f;
#pragma unroll
                for (int bj = 0; bj < 2; ++bj)
#pragma unroll
                    for (int n = 0; n < 2; ++n) { const size_t off = (size_t)r * 1024 + col0 + bj * HALF + n * 16;
                        const f32x4 h = *(const f32x4*)(ob + off) + acc[ai][bj][m][n];
                        *(f32x4*)(ob + off) = h;
                        s += (h[0] * h[0] + h[1] * h[1]) + (h[2] * h[2] + h[3] * h[3]); }
                s += __shfl_xor(s, 16); s += __shfl_xor(s, 32);
                if (fq == 0) ssq[(size_t)(rbase + r) * 16 + u.pn * 4 + wc] = s; }
    }
};
}

#include <hip/hip_bf16.h>
#include <cmath>
namespace attn_body {
using bf16=__hip_bfloat16;
using bf16x8=__attribute__((ext_vector_type(8)))short;
using s16x4=__attribute__((ext_vector_type(4)))short;
using f32x16=__attribute__((ext_vector_type(16)))float;
using u32x4=__attribute__((ext_vector_type(4)))unsigned;
constexpr int D=64,QP=1792,OP=1024;
constexpr int NW=8,QBLK=32,QB=QBLK*NW,KVBLK=64,NT=129;
__device__ __forceinline__ int crow(int r,int hi){return (r&3)+8*(r>>2)+4*hi;}
#define SBAR() __builtin_amdgcn_sched_barrier(0)
__device__ __forceinline__ void tmask(f32x16&p0,f32x16&p1){
  const float NEG=-INFINITY;
  #pragma unroll
  for(int r=0;r<16;++r){ if(r>=8)p0[r]=NEG; p1[r]=NEG; }
}

constexpr int NSLOT=3, SLOTB=8192;
constexpr int LDS_K=0, LDS_V=NSLOT*SLOTB, LDS_WS=2*NSLOT*SLOTB, LDS_OST=LDS_WS+NW*64*4, LDS_BYTES=LDS_OST+NW*4096;
constexpr float C2=0.125f*1.4426950408889634f;
__device__ __forceinline__ void glds16(const void*gsrc,unsigned lds_dst){unsigned keep;
  asm volatile("s_mov_b32 %0, m0\n\ts_mov_b32 m0, %2\n\ts_nop 0\n\tglobal_load_lds_dwordx4 %1, off\n\ts_mov_b32 m0, %0":"=&s"(keep):"v"(gsrc),"s"(lds_dst):"memory");}
__device__ __forceinline__ float max3f(float a,float b,float c){float r;asm("v_max3_f32 %0, %1, %2, %3":"=v"(r):"v"(a),"v"(b),"v"(c));return r;}
__device__ __forceinline__ float max2f(float a,float b){float r;asm("v_max_f32_e32 %0, %1, %2":"=v"(r):"v"(a),"v"(b));return r;}
__device__ __forceinline__ float fadd_s(float a,float b){float r;asm("v_add_f32_e32 %0, %1, %2":"=v"(r):"v"(a),"v"(b));return r;}
__device__ __forceinline__ float fsub_s(float a,float b){float r;asm("v_sub_f32_e32 %0, %1, %2":"=v"(r):"v"(a),"v"(b));return r;}
typedef float f32x2_t __attribute__((ext_vector_type(2))); typedef __bf16 bf16x2_t __attribute__((ext_vector_type(2)));
__device__ __forceinline__ unsigned cvtpk_s(float lo,float hi){f32x2_t v={lo,hi};bf16x2_t b=__builtin_convertvector(v,bf16x2_t);return __builtin_bit_cast(unsigned,b);}
#define WAIT_BAR(N) asm volatile("s_waitcnt vmcnt(" #N ") lgkmcnt(0)\n\ts_barrier":::"memory")

__device__ __forceinline__ void qkt(f32x16&p0,f32x16&p1,const char*Kslot,const bf16x8*qr,const f32x16&negm,int r32,int hi){
  const char*kb=Kslot+hi*1024+r32*16;
  #pragma unroll
  for(int d0=0;d0<4;++d0){
    const bf16x8 b0=*reinterpret_cast<const bf16x8*>(kb+d0*2048);
    const bf16x8 b1=*reinterpret_cast<const bf16x8*>(kb+d0*2048+512);
    if(d0==0){p0=__builtin_amdgcn_mfma_f32_32x32x16_bf16(b0,qr[0],negm,0,0,0);p1=__builtin_amdgcn_mfma_f32_32x32x16_bf16(b1,qr[0],negm,0,0,0);}
    else{p0=__builtin_amdgcn_mfma_f32_32x32x16_bf16(b0,qr[d0],p0,0,0,0);p1=__builtin_amdgcn_mfma_f32_32x32x16_bf16(b1,qr[d0],p1,0,0,0);}}
}
typedef __attribute__((address_space(3))) const char* lds_cptr;
typedef short v4i16_t __attribute__((ext_vector_type(4)));
__device__ __forceinline__ void kload8(bf16x8*kf,lds_cptr kp){
  kf[0]=*(const __attribute__((address_space(3))) bf16x8*)(kp);      kf[1]=*(const __attribute__((address_space(3))) bf16x8*)(kp+512);
  kf[2]=*(const __attribute__((address_space(3))) bf16x8*)(kp+2048); kf[3]=*(const __attribute__((address_space(3))) bf16x8*)(kp+2560);
  kf[4]=*(const __attribute__((address_space(3))) bf16x8*)(kp+4096); kf[5]=*(const __attribute__((address_space(3))) bf16x8*)(kp+4608);
  kf[6]=*(const __attribute__((address_space(3))) bf16x8*)(kp+6144); kf[7]=*(const __attribute__((address_space(3))) bf16x8*)(kp+6656);
}
__device__ __forceinline__ void kload2(bf16x8*kf,lds_cptr kp,int j){ kf[2*j]=*(const __attribute__((address_space(3))) bf16x8*)(kp+j*2048); kf[2*j+1]=*(const __attribute__((address_space(3))) bf16x8*)(kp+j*2048+512); }
__device__ __forceinline__ s16x4 vtr(lds_cptr p){ return __builtin_bit_cast(s16x4,__builtin_amdgcn_ds_read_tr16_b64_v4i16((__attribute__((address_space(3))) v4i16_t*)p)); }
__device__ __forceinline__ float rowmax(const f32x16&p0,const f32x16&p1){
  float a=max3f(p0[0],p0[1],p1[0]),b=max3f(p0[2],p0[3],p1[1]);a=max3f(a,p1[2],p1[3]);
  #pragma unroll
  for(int r=4;r<16;r+=4){a=max3f(a,p0[r],p0[r+1]);b=max3f(b,p0[r+2],p0[r+3]);a=max3f(a,p1[r],p1[r+1]);b=max3f(b,p1[r+2],p1[r+3]);}
  const float m=max2f(a,b);
  auto rr=__builtin_amdgcn_permlane32_swap(__float_as_uint(m),__float_as_uint(m),false,false);
  return max2f(__uint_as_float(rr[0]),__uint_as_float(rr[1]));
}
__device__ __forceinline__ void pv(f32x16*o,int vb,bf16x8 pa0,bf16x8 pa1,bf16x8 pa2,bf16x8 pa3){
  #pragma unroll
  for(int d0=0;d0<2;++d0){s16x4 lo[4],hi[4];
    #pragma unroll
    for(int ks=0;ks<4;++ks){
      asm volatile("ds_read_b64_tr_b16 %0,%1 offset:%c2":"=&v"(lo[ks]):"v"(vb),"i"(d0*4096+ks*1024):"memory");
      asm volatile("ds_read_b64_tr_b16 %0,%1 offset:%c2":"=&v"(hi[ks]):"v"(vb),"i"(d0*4096+ks*1024+512):"memory");}
    asm volatile("s_waitcnt lgkmcnt(0)":::"memory");SBAR();
    #define PK(k) (bf16x8){lo[k][0],lo[k][1],lo[k][2],lo[k][3],hi[k][0],hi[k][1],hi[k][2],hi[k][3]}
    o[d0]=__builtin_amdgcn_mfma_f32_32x32x16_bf16(pa0,PK(0),o[d0],0,0,0);
    o[d0]=__builtin_amdgcn_mfma_f32_32x32x16_bf16(pa1,PK(1),o[d0],0,0,0);
    o[d0]=__builtin_amdgcn_mfma_f32_32x32x16_bf16(pa2,PK(2),o[d0],0,0,0);
    o[d0]=__builtin_amdgcn_mfma_f32_32x32x16_bf16(pa3,PK(3),o[d0],0,0,0);
    #undef PK
  }
}

#ifndef ATTN_STORE16
#define ATTN_STORE16(p,v) (*(u32x4*)(p)=(v))
#endif
template<int THRL> __device__ __forceinline__ void attn_unit(const bf16*Qw0,const bf16*__restrict__ Kh,const bf16*__restrict__ Vh,bf16*Ow0,char*shm){
  const int tid=threadIdx.x,lane=tid&63,r32=lane&31,hi=lane>>5; const int wid=__builtin_amdgcn_readfirstlane(tid>>6);
  const bf16*Qw=Qw0+(long)(wid*QBLK)*QP;
  const unsigned lds0=(unsigned)(uintptr_t)shm;
  float*wsf=(float*)(shm+LDS_WS)+wid*64;
  const bf16*ksrc=Kh+(long)lane*QP+wid*8;
  const bf16*vsrc=Vh+(long)(16*(wid&3)+(lane>>2))*QP+(wid>>2)*32+(lane&3)*8;
  const unsigned kdst=lds0+LDS_K+wid*1024, vdst=lds0+LDS_V+wid*1024;
  #define DMA_K(t,slot) glds16(ksrc+(long)(t)*KVBLK*QP,(unsigned)__builtin_amdgcn_readfirstlane(kdst+(slot)))
  #define DMA_V(t,slot) glds16(vsrc+(long)(t)*KVBLK*QP,(unsigned)__builtin_amdgcn_readfirstlane(vdst+(slot)))
  const int vb0=(int)(lds0+LDS_V)+((lane>>4)&1)*32+(lane&3)*8+(4*hi+((lane&15)>>2))*64;
  const char*Kbase=shm+LDS_K; bf16x8 kf[8];
  const lds_cptr shm3=(lds_cptr)shm; const lds_cptr kp0=shm3+LDS_K+hi*1024+r32*16; const lds_cptr vp0=shm3+LDS_V+((lane>>4)&1)*32+(lane&3)*8+(4*hi+((lane&15)>>2))*64;
  DMA_K(0,0);DMA_V(0,0);DMA_K(1,SLOTB);
  bf16x8 qr[4];
  #pragma unroll
  for(int d0=0;d0<4;++d0)qr[d0]=*reinterpret_cast<const bf16x8*>(&Qw[(long)r32*QP+d0*16+hi*8]);
  float mhat=0.f,l_reg=0.f;f32x16 o[2];o[0]=f32x16{};o[1]=f32x16{};f32x16 negm=f32x16{};asm volatile("":"+v"(negm));
  #define CMASK(P0,P1,t) do{ if((t)==NT-1)tmask(P0,P1); }while(0)
  bool resc=false;
  #define START(P0,P1) do{ const float rm=rowmax(P0,P1); resc=false; \
    { const float dl=rm; mhat=fadd_s(mhat,dl); \
      _Pragma("unroll") for(int r=0;r<16;++r){P0[r]=fsub_s(P0[r],dl);P1[r]=fsub_s(P1[r],dl);} \
      _Pragma("unroll") for(int r=0;r<16;++r)negm[r]=-mhat; asm volatile("":"+v"(negm)); } \
    _Pragma("unroll") for(int r=0;r<16;++r)P0[r]=__builtin_amdgcn_exp2f(P0[r]); }while(0)
  #define RESC() do{ if(resc){ asm volatile("s_waitcnt lgkmcnt(0)":::"memory"); \
      _Pragma("unroll") for(int d_=0;d_<2;++d_) _Pragma("unroll") for(int r=0;r<16;++r)o[d_][r]*=wsf[crow(r,hi)]; } }while(0)
  f32x16 pA0,pA1,pB0,pB1;
  int sl_prev=0,sl_cur=0,sl_next=SLOTB;
  #define ROT() do{sl_prev=sl_cur;sl_cur=sl_next;sl_next=(sl_next==(NSLOT-1)*SLOTB)?0:sl_next+SLOTB;}while(0)
  DMA_K(2,2*SLOTB);
  WAIT_BAR(3);
  qkt(pA0,pA1,Kbase,qr,negm,r32,hi);asm volatile("s_nop 15\n\ts_nop 7":"+v"(pA0),"+v"(pA1));CMASK(pA0,pA1,0);
  START(pA0,pA1);
  _Pragma("unroll") for(int r=0;r<16;++r)pA1[r]=__builtin_amdgcn_exp2f(pA1[r]);
  WAIT_BAR(0);
  DMA_K(3,0);DMA_V(1,SLOTB);
  ROT();
  kload8(kf,kp0+sl_cur);
  WAIT_BAR(2);
  s16x4 vlo[8],vhi[8]; u32x4 pw0,pw1,pw2,pw3;
  #define PKW(P,B) cvtpk_s(P[B],P[B+1])
  #define PAF(k) __builtin_bit_cast(bf16x8,pw##k)
  #define VFR(i) (bf16x8){vlo[i][0],vlo[i][1],vlo[i][2],vlo[i][3],vhi[i][0],vhi[i][1],vhi[i][2],vhi[i][3]}
  #define PIN(x) asm volatile("":"+v"(x))
  #define MX3(a,b,c) __builtin_fmaxf(__builtin_fmaxf((a),(b)),(c))
  #define GAPA(MF,A0,A1,A2,A3,W0,W1,PW) do{ MF; sacc+=A0; sacc+=A1; sacc+=A2; sacc+=A3; PIN(sacc); W0; W1; PIN(PW); SBAR(); }while(0)
  #define EX(v) __builtin_amdgcn_exp2f(v)
  #define GAPB(MF,X,B) do{ MF; X[B]=EX(X[B]); X[B+1]=EX(X[B+1]); X[B+2]=EX(X[B+2]); X[B+3]=EX(X[B+3]); PIN(X); SBAR(); }while(0)
  #define VRD(i) do{ vlo[i]=vtr(vp_+(((i)>>2)*4096+((i)&3)*1024)); vhi[i]=vtr(vp_+(((i)>>2)*4096+((i)&3)*1024+512)); }while(0)
  #define KRD(G,j) do{ if(G){ kload2(kf,kp0+sl_next,j); SBAR(); } }while(0)
  #define STEP(C0,C1,P0,P1,t,GK,GV,GL) do{ SBAR(); \
    const lds_cptr vp_=vp0+sl_prev; \
    VRD(0); SBAR(); float sacc=(P0[0]+P0[1]); \
    GAPA(C0=__builtin_amdgcn_mfma_f32_32x32x16_bf16(kf[0],qr[0],negm,0,0,0), P0[2],P0[3],P0[4],P0[5],     pw0[0]=PKW(P0,0), pw0[1]=PKW(P0,2), pw0); \
    VRD(4); SBAR(); GAPA(C1=__builtin_amdgcn_mfma_f32_32x32x16_bf16(kf[1],qr[0],negm,0,0,0), P0[6],P0[7],P0[8],P0[9],     pw0[2]=PKW(P0,4), pw0[3]=PKW(P0,6), pw0); \
    VRD(1); SBAR(); GAPA(C0=__builtin_amdgcn_mfma_f32_32x32x16_bf16(kf[2],qr[1],C0,0,0,0),   P0[10],P0[11],P0[12],P0[13], pw1[0]=PKW(P0,8), pw1[1]=PKW(P0,10), pw1); \
    VRD(5); SBAR(); GAPA(C1=__builtin_amdgcn_mfma_f32_32x32x16_bf16(kf[3],qr[1],C1,0,0,0),   P0[14],P0[15],P1[0],P1[1],   pw1[2]=PKW(P0,12),pw1[3]=PKW(P0,14), pw1); \
    VRD(2); SBAR(); GAPA(C0=__builtin_amdgcn_mfma_f32_32x32x16_bf16(kf[4],qr[2],C0,0,0,0),   P1[2],P1[3],P1[4],P1[5],     pw2[0]=PKW(P1,0), pw2[1]=PKW(P1,2), pw2); \
    VRD(6); SBAR(); GAPA(C1=__builtin_amdgcn_mfma_f32_32x32x16_bf16(kf[5],qr[2],C1,0,0,0),   P1[6],P1[7],P1[8],P1[9],     pw2[2]=PKW(P1,4), pw2[3]=PKW(P1,6), pw2); \
    VRD(3); SBAR(); GAPA(C0=__builtin_amdgcn_mfma_f32_32x32x16_bf16(kf[6],qr[3],C0,0,0,0),   P1[10],P1[11],P1[12],P1[13], pw3[0]=PKW(P1,8), pw3[1]=PKW(P1,10), pw3); \
    VRD(7); SBAR(); GAPA(C1=__builtin_amdgcn_mfma_f32_32x32x16_bf16(kf[7],qr[3],C1,0,0,0),   P1[14],P1[15],0.f,0.f,       pw3[2]=PKW(P1,12),pw3[3]=PKW(P1,14), pw3); \
    l_reg+=sacc; \
    if(GK){DMA_K((t)+3,sl_cur);} if(GV){DMA_V((t)+1,sl_next);} \
    CMASK(C0,C1,t); \
    { float a=MX3(C0[0],C0[1],C1[0]),b=MX3(C0[2],C0[3],C1[1]); a=MX3(a,C1[2],C1[3]); \
      _Pragma("unroll") for(int r=4;r<16;r+=4){a=MX3(a,C0[r],C0[r+1]);b=MX3(b,C0[r+2],C0[r+3]);a=MX3(a,C1[r],C1[r+1]);b=MX3(b,C1[r+2],C1[r+3]);} \
      float rm=__builtin_fmaxf(a,b); { auto rr=__builtin_amdgcn_permlane32_swap(__float_as_uint(rm),__float_as_uint(rm),false,false); rm=__builtin_fmaxf(__uint_as_float(rr[0]),__uint_as_float(rr[1])); } \
      resc=false; \
      if(__builtin_expect(__any(rm>(float)THRL),0)){ const float dl=__builtin_fmaxf(rm,0.f); mhat+=dl; \
        _Pragma("unroll") for(int r=0;r<16;++r){C0[r]-=dl;C1[r]-=dl;} \
        _Pragma("unroll") for(int r=0;r<16;++r)negm[r]=-mhat; asm volatile("":"+v"(negm)); \
        const float f=__builtin_amdgcn_exp2f(-dl); l_reg*=f; if(hi==0)wsf[r32]=f; resc=true; } } \
    SBAR(); \
    GAPB(o[0]=__builtin_amdgcn_mfma_f32_32x32x16_bf16(PAF(0),VFR(0),o[0],0,0,0), C0,0); \
    GAPB(o[1]=__builtin_amdgcn_mfma_f32_32x32x16_bf16(PAF(0),VFR(4),o[1],0,0,0), C0,4); \
    KRD(GL,0); GAPB(o[0]=__builtin_amdgcn_mfma_f32_32x32x16_bf16(PAF(1),VFR(1),o[0],0,0,0), C0,8); \
    KRD(GL,1); GAPB(o[1]=__builtin_amdgcn_mfma_f32_32x32x16_bf16(PAF(1),VFR(5),o[1],0,0,0), C0,12); \
    KRD(GL,2); GAPB(o[0]=__builtin_amdgcn_mfma_f32_32x32x16_bf16(PAF(2),VFR(2),o[0],0,0,0), C1,0); \
    KRD(GL,3); GAPB(o[1]=__builtin_amdgcn_mfma_f32_32x32x16_bf16(PAF(2),VFR(6),o[1],0,0,0), C1,4); \
    GAPB(o[0]=__builtin_amdgcn_mfma_f32_32x32x16_bf16(PAF(3),VFR(3),o[0],0,0,0), C1,8); \
    GAPB(o[1]=__builtin_amdgcn_mfma_f32_32x32x16_bf16(PAF(3),VFR(7),o[1],0,0,0), C1,12); \
    }while(0)
  int t=1;
  #define ENDW(tt) do{ if((tt)+3<NT){WAIT_BAR(2);} else if((tt)+2<NT){WAIT_BAR(1);} else {WAIT_BAR(0);} }while(0)
  #undef CMASK
  #define CMASK(P0,P1,t) do{}while(0)
  for(;t+4<NT;t+=2){
    STEP(pB0,pB1,pA0,pA1,t,true,true,true);     WAIT_BAR(2); RESC(); ROT();
    STEP(pA0,pA1,pB0,pB1,t+1,true,true,true);   WAIT_BAR(2); RESC(); ROT();
  }
  for(;t+2<NT;t+=2){
    STEP(pB0,pB1,pA0,pA1,t,(t+3<NT),(t+1<NT),(t+1<NT));       ENDW(t);   RESC(); ROT();
    STEP(pA0,pA1,pB0,pB1,t+1,(t+4<NT),(t+2<NT),(t+2<NT));     ENDW(t+1); RESC(); ROT();
  }
  STEP(pB0,pB1,pA0,pA1,NT-2,false,true,true); WAIT_BAR(0); RESC(); ROT();
  #undef CMASK
  #define CMASK(P0,P1,t) tmask(P0,P1)
  STEP(pA0,pA1,pB0,pB1,NT-1,false,false,false); RESC();
  { float sacc=pA0[0]+pA0[1]; _Pragma("unroll") for(int r=2;r<16;++r)sacc+=pA0[r]; _Pragma("unroll") for(int r=0;r<16;++r)sacc+=pA1[r]; l_reg+=sacc;
    pw0=(u32x4){PKW(pA0,0),PKW(pA0,2),PKW(pA0,4),PKW(pA0,6)};pw1=(u32x4){PKW(pA0,8),PKW(pA0,10),PKW(pA0,12),PKW(pA0,14)};pw2=(u32x4){PKW(pA1,0),PKW(pA1,2),PKW(pA1,4),PKW(pA1,6)};pw3=(u32x4){PKW(pA1,8),PKW(pA1,10),PKW(pA1,12),PKW(pA1,14)};
    SBAR(); pv(o,vb0+sl_cur,PAF(0),PAF(1),PAF(2),PAF(3)); }
  #undef PKW
  #undef PAF
  #undef VFR
  #undef PIN
  #undef MX3
  #undef GAPA
  #undef GAPB
  #undef EX
  #undef VRD
  #undef KRD
  #undef STEP
  #undef ENDW
  {auto rr=__builtin_amdgcn_permlane32_swap(__float_as_uint(l_reg),__float_as_uint(l_reg),false,false);l_reg=__uint_as_float(rr[0])+__uint_as_float(rr[1]);}
  if(hi==0)wsf[32+r32]=l_reg;asm volatile("s_waitcnt lgkmcnt(0)":::"memory");
  float rli[16];
  #pragma unroll
  for(int r=0;r<16;++r)rli[r]=__builtin_amdgcn_rcpf(wsf[32+crow(r,hi)]);
  bf16*Ow=Ow0+(long)(wid*QBLK)*OP;
  { bf16*stg=(bf16*)(shm+LDS_OST)+wid*2048;
    #pragma unroll
    for(int r=0;r<16;++r){const int orow=crow(r,hi);
      #pragma unroll
      for(int d0=0;d0<2;++d0)stg[orow*64+d0*32+r32]=__float2bfloat16(o[d0][r]*rli[r]);}
    asm volatile("s_waitcnt lgkmcnt(0)":::"memory");
    #pragma unroll
    for(int i=0;i<4;++i){const int row=i*8+(lane>>3),ch=lane&7; const u32x4 v=*(const u32x4*)(stg+row*64+ch*8); ATTN_STORE16(Ow+(long)row*OP+ch*8,v);} }
  asm volatile("s_waitcnt lgkmcnt(0)\n\ts_barrier":::"memory");
  #undef DMA_K
  #undef DMA_V
  #undef CMASK
  #undef START
  #undef RESC
  #undef ROT
}
constexpr int ATTN_LDS_BYTES=LDS_BYTES;
#undef SBAR
#undef WAIT_BAR
}

#ifndef MK_N_LAUNCHES
#define MK_N_LAUNCHES 1
#endif
constexpr int NWAVES = 8, NPHASE = 9;
constexpr int DM = 1024, NSEQ = 12, SEQ = 8192, NMETA = 16, LSEQ = SEQ + NMETA;
constexpr int TNAT = NSEQ * LSEQ, MP = 98560, MC = NSEQ * SEQ;
constexpr int INW = 1792, FFH = 2816, LRUW = 512;
constexpr int COL_K = 512, COL_V = 640, COL_LIN = 768, COL_LG = 1280;
constexpr int CT = 32, NCH = 257, NLU = NSEQ * NCH;
constexpr float QSCALE = 0.125f * 1.4426950408889634f;
constexpr size_t MiB = 1u << 20;
constexpr size_t WS_WIN = 2 * MiB, WS_WOUT = 6 * MiB, WS_WGU = 8 * MiB, WS_WDN = 20 * MiB, WS_WLRU = 26 * MiB, WS_NL = 26 * MiB + 512 * 1024;
constexpr size_t WS_COS = 27 * MiB, WS_SIN = 28 * MiB;
constexpr size_t WS_AGG = 32 * MiB, WS_CARRY = 60 * MiB, WS_SSQ1 = 74 * MiB, WS_SSQ2 = 82 * MiB;
constexpr size_t WS_XN = 96 * MiB;
constexpr size_t WS_PROJ = 300 * MiB;
constexpr size_t WS_HID = 96 * MiB;
constexpr size_t WS_H1B = 656 * MiB;
constexpr size_t WS_END = 860 * MiB;
static_assert(WS_AGG + (size_t)NLU * 2048 * 4 <= WS_CARRY && WS_CARRY + (size_t)NLU * 1024 * 4 <= WS_SSQ1 && WS_SSQ1 + (size_t)MC * 64 <= WS_SSQ2 && WS_SSQ2 + (size_t)MC * 64 <= WS_XN, "ws map 1");
static_assert(WS_XN + (size_t)MP * 1024 * 2 <= WS_PROJ && WS_PROJ + (size_t)MP * INW * 2 <= WS_H1B && WS_HID + (size_t)MC * FFH * 2 <= WS_H1B && WS_H1B + (size_t)MC * 1024 * 2 <= WS_END, "ws map 2");
constexpr int LDS_BYTES = 147456;

#define GAS __attribute__((address_space(1)))
#define LAS __attribute__((address_space(3)))
typedef unsigned short bf16;
typedef unsigned v4u __attribute__((ext_vector_type(4)));
typedef unsigned v2u __attribute__((ext_vector_type(2)));
typedef float f32x4 __attribute__((ext_vector_type(4)));
typedef short bf16x8 __attribute__((ext_vector_type(8)));
using pg8::pkbf;
__device__ __forceinline__ float bflo(unsigned w) { return __uint_as_float(w << 16); }
__device__ __forceinline__ float bfhi(unsigned w) { return __uint_as_float(w & 0xffff0000u); }
__device__ __forceinline__ float wave_sum(float v) {
#pragma unroll
    for (int o = 1; o < 64; o <<= 1) v += __shfl_xor(v, o);
    return v;
}
template <int CTRL> __device__ __forceinline__ float dppf(float old, float v) { return __builtin_bit_cast(float, __builtin_amdgcn_update_dpp(__builtin_bit_cast(int, old), __builtin_bit_cast(int, v), CTRL, 0xf, 0xf, false)); }
__device__ __forceinline__ void scan_fwd16(float& A, float& B) {
#define SF(S) { const float Ap = dppf<0x110 + S>(1.f, A), Bp = dppf<0x110 + S>(0.f, B); B = fmaf(A, Bp, B); A = A * Ap; }
    SF(1) SF(2) SF(4) SF(8)
#undef SF
}
__device__ __forceinline__ void scan_bwd16(float& A, float& B) {
#define SB(S) { const float Ap = dppf<0x100 + S>(1.f, A), Bp = dppf<0x100 + S>(0.f, B); B = fmaf(A, Bp, B); A = A * Ap; }
    SB(1) SB(2) SB(4) SB(8)
#undef SB
}

struct Args {
    const float *x_prompt, *x_sample, *meta, *norm_mix_g, *w_in, *q_norm_g, *k_norm_g, *conv_w, *conv_b, *lru_w_a, *lru_b_a, *lru_w_x, *lru_b_x, *lru_lam,
                *attn_out_g, *lru_out_g, *w_out, *norm_ffn_g, *w_gate_up, *w_down, *final_norm_g;
    float* out; unsigned char* ws; int ph_lo, ph_hi;
};

__device__ __forceinline__ void p0_transpose_item(const float* W, int K, int N, bf16* WT, int mode, const float* kscale, LAS float* scr, int item, int lane) {
    const int nblk = N / 32, kb = item / nblk, nb = item % nblk, k0 = 64 * kb, n0 = 32 * nb;
#pragma unroll 8
    for (int i = 0; i < 32; ++i) { const int kk = 2 * i + (lane >> 5); float v = W[(size_t)(k0 + kk) * N + n0 + (lane & 31)]; if (kscale) v *= kscale[k0 + kk]; scr[kk * 33 + (lane & 31)] = v; }
    asm volatile("s_waitcnt lgkmcnt(0)" ::: "memory");
    int rbase = n0;
    if (mode == 1) { if (n0 < FFH) rbase = (n0 / 128) * 256 + (n0 % 128); else { const int j = n0 - FFH; rbase = (j / 128) * 256 + 128 + (j % 128); } }
    const int c = lane & 7;
#pragma unroll
    for (int j = 0; j < 4; ++j) { const int n = (lane >> 3) + 8 * j; const LAS float* s = scr + (8 * c) * 33 + n;
        v4u o; o.x = pkbf(s[0 * 33], s[1 * 33]); o.y = pkbf(s[2 * 33], s[3 * 33]); o.z = pkbf(s[4 * 33], s[5 * 33]); o.w = pkbf(s[6 * 33], s[7 * 33]);
        *(GAS v4u*)(WT + (size_t)(rbase + n) * K + k0 + 8 * c) = o; }
    asm volatile("s_waitcnt lgkmcnt(0)" ::: "memory");
}

__device__ __forceinline__ void phase0(const Args& a, LAS unsigned char* lds, int vcu, int G, int wave, int lane, int tid) {
    unsigned char* ws = a.ws;
    LAS float* scr = (LAS float*)(lds + wave * 16384);
    const int gw = vcu * NWAVES + wave, NGW = G * NWAVES;
    constexpr int I_IN = (DM / 64) * (INW / 32), I_OUT = (DM / 64) * (DM / 32), I_GU = (DM / 64) * (2 * FFH / 32), I_DN = (FFH / 64) * (DM / 32);
    constexpr int NITEMS = I_IN + I_OUT + I_GU + I_DN;
    for (int it = gw; it < NITEMS; it += NGW) {
        int r = it;
        if (r < I_IN) { p0_transpose_item(a.w_in, DM, INW, (bf16*)(ws + WS_WIN), 0, nullptr, scr, r, lane); continue; } r -= I_IN;
        if (r < I_OUT) { p0_transpose_item(a.w_out, DM, DM, (bf16*)(ws + WS_WOUT), 0, nullptr, scr, r, lane); continue; } r -= I_OUT;
        if (r < I_GU) { p0_transpose_item(a.w_gate_up, DM, 2 * FFH, (bf16*)(ws + WS_WGU), 1, a.norm_ffn_g, scr, r, lane); continue; } r -= I_GU;
        p0_transpose_item(a.w_down, FFH, DM, (bf16*)(ws + WS_WDN), 0, nullptr, scr, r, lane);
    }
    const int gt = vcu * (NWAVES * 64) + tid, NGT = G * NWAVES * 64;
    { bf16* Wl = (bf16*)(ws + WS_WLRU);
      for (int e = gt; e < 8 * 256 * 64; e += NGT) { const int h = e >> 14, o = (e >> 6) & 255, i = e & 63, g4 = o >> 6, j = o & 63, d = g4 >> 1;
          const float* src = (g4 & 1) ? a.lru_w_x : a.lru_w_a; Wl[e] = (bf16)(pkbf(src[((size_t)(d * 8 + h) * 64 + i) * 64 + j], 0.f) & 0xffffu); } }
    { float* nl = (float*)(ws + WS_NL); for (int e = gt; e < 2 * LRUW; e += NGT) nl[e] = -8.0f * log1pf(expf(-a.lru_lam[e])); }
    { float* ct = (float*)(ws + WS_COS); float* st = (float*)(ws + WS_SIN);
      for (int e = gt; e < SEQ * 32; e += NGT) { const int t = e >> 5, k = e & 31, pos = (k < 16) ? (t >> 6) : (t & 63), i = k & 15;
          const float freq = __builtin_amdgcn_exp2f(-(float)i * (13.287712379549449f / 16.0f));
          const float rev = (float)pos * freq * 0.15915494309189535f; const float fr = rev - rintf(rev);
          ct[e] = __builtin_amdgcn_cosf(fr); st[e] = __builtin_amdgcn_sinf(fr); } }
    { bf16* XN = (bf16*)(ws + WS_XN);
      f32x4 g4[4];
#pragma unroll
      for (int j = 0; j < 4; ++j) g4[j] = *((const f32x4*)a.norm_mix_g + lane + 64 * j);
      for (int r = gw; r < MP; r += NGW) {
          GAS unsigned long long* o8 = (GAS unsigned long long*)(XN + (size_t)r * DM) + lane;
          if (r >= TNAT) {
#pragma unroll
              for (int j = 0; j < 4; ++j) o8[64 * j] = 0ull;
              continue; }
          const int b = r / LSEQ, p = r - b * LSEQ;
          const float* src = (p < NMETA) ? a.meta + (size_t)p * DM : (b < 8 ? a.x_prompt + ((size_t)b * SEQ + (p - NMETA)) * DM : a.x_sample + ((size_t)(b - 8) * SEQ + (p - NMETA)) * DM);
          const f32x4* xr = (const f32x4*)src + lane; f32x4 v[4]; float s = 0.f;
#pragma unroll
          for (int j = 0; j < 4; ++j) { v[j] = xr[64 * j]; s += (v[j][0] * v[j][0] + v[j][1] * v[j][1]) + (v[j][2] * v[j][2] + v[j][3] * v[j][3]); }
          const float rstd = __builtin_amdgcn_rsqf(wave_sum(s) * (1.0f / DM) + 1e-6f);
#pragma unroll
          for (int j = 0; j < 4; ++j) { const f32x4 y = v[j] * rstd * g4[j]; o8[64 * j] = (unsigned long long)pkbf(y[0], y[1]) | ((unsigned long long)pkbf(y[2], y[3]) << 32); }
      } }
}

__device__ __forceinline__ void phase_qk(const Args& a, int vcu, int G, int wave, int lane) {
    bf16* proj = (bf16*)(a.ws + WS_PROJ); const float* ct = (const float*)(a.ws + WS_COS); const float* st = (const float*)(a.ws + WS_SIN);
    const int gw = vcu * NWAVES + wave, NGW = G * NWAVES; const int sub = lane >> 3, j = lane & 7;
    constexpr int NGRP = TNAT * 10 / 8;
    for (int grp = gw; grp < NGRP; grp += NGW) {
        const int item = grp * 8 + sub, row = item / 10, hh = item - row * 10;
        bf16* ptr = proj + (size_t)row * INW + hh * 64 + j * 8;
        const v4u raw = *(const v4u*)ptr;
        float x[8] = {bflo(raw.x), bfhi(raw.x), bflo(raw.y), bfhi(raw.y), bflo(raw.z), bfhi(raw.z), bflo(raw.w), bfhi(raw.w)};
        float ss = 0.f;
#pragma unroll
        for (int e = 0; e < 8; ++e) ss += x[e] * x[e];
        ss += __shfl_xor(ss, 1); ss += __shfl_xor(ss, 2); ss += __shfl_xor(ss, 4);
        const float rstd = __builtin_amdgcn_rsqf(ss * (1.0f / 64.0f) + 1e-6f);
        const float* gp = (hh < 8 ? a.q_norm_g : a.k_norm_g) + j * 8;
        const f32x4 g0 = *(const f32x4*)gp, g1 = *(const f32x4*)(gp + 4);
        float y[8];
#pragma unroll
        for (int e = 0; e < 8; ++e) y[e] = x[e] * rstd * (e < 4 ? g0[e] : g1[e - 4]);
        const int b = row / LSEQ, p = row - b * LSEQ;
        float c[8], s[8];
        if (p >= NMETA) { const int toff = (p - NMETA) * 32 + (j >> 2) * 16 + (j & 1) * 8;
            const f32x4 c0 = *(const f32x4*)(ct + toff), c1 = *(const f32x4*)(ct + toff + 4), s0 = *(const f32x4*)(st + toff), s1 = *(const f32x4*)(st + toff + 4);
#pragma unroll
            for (int e = 0; e < 4; ++e) { c[e] = c0[e]; c[e + 4] = c1[e]; s[e] = s0[e]; s[e + 4] = s1[e]; }
        } else {
#pragma unroll
            for (int e = 0; e < 8; ++e) { c[e] = 1.f; s[e] = 0.f; } }
        const float sgn = (j & 2) ? 1.f : -1.f, sc = (hh < 8) ? QSCALE : 1.f;
        float o[8];
#pragma unroll
        for (int e = 0; e < 8; ++e) { const float py = __shfl_xor(y[e], 2); o[e] = (y[e] * c[e] + sgn * py * s[e]) * sc; }
        v4u w; w.x = pkbf(o[0], o[1]); w.y = pkbf(o[2], o[3]); w.z = pkbf(o[4], o[5]); w.w = pkbf(o[6], o[7]);
        *(v4u*)ptr = w;
    }
}

constexpr int CB_ROW = 144, CB_WAVE = CT * CB_ROW, LRU_CB = 0, LRU_Y = NWAVES * CB_WAVE, Y_ROW = 2064, LRU_PART = LRU_Y + CT * Y_ROW;
static_assert(LRU_PART + CT * 8 * 4 <= 131072, "lru lds");
template <bool FINAL> __device__ __forceinline__ void lru_unit(const Args& a, LAS unsigned char* lds, int unit, int wave, int lane, int tid) {
    const bf16* proj = (const bf16*)(a.ws + WS_PROJ);
    const int b = unit / NCH, ci = unit - b * NCH, p0 = ci * CT; const size_t rowbase = (size_t)b * LSEQ;
    const int fr = lane & 15, fq = lane >> 4;
    LAS unsigned char* cb = lds + LRU_CB + wave * CB_WAVE;
    { const int j8 = lane & 7, ch = 64 * wave + 8 * j8;
      float cw[4][8], cbias[8];
#pragma unroll
      for (int jj = 0; jj < 4; ++jj) { const f32x4 w0 = *(const f32x4*)(a.conv_w + jj * LRUW + ch), w1 = *(const f32x4*)(a.conv_w + jj * LRUW + ch + 4);
#pragma unroll
          for (int e = 0; e < 4; ++e) { cw[jj][e] = w0[e]; cw[jj][e + 4] = w1[e]; } }
      { const f32x4 b0 = *(const f32x4*)(a.conv_b + ch), b1 = *(const f32x4*)(a.conv_b + ch + 4);
#pragma unroll
        for (int e = 0; e < 4; ++e) { cbias[e] = b0[e]; cbias[e + 4] = b1[e]; } }
#pragma unroll
      for (int stp = 0; stp < 4; ++stp) { const int tok = stp * 8 + (lane >> 3), p = p0 + tok;
          float acc[8];
#pragma unroll
          for (int e = 0; e < 8; ++e) acc[e] = cbias[e];
#pragma unroll
          for (int jj = 0; jj < 4; ++jj) { const int pp = p + jj - 2;
              if (pp >= 0 && pp < LSEQ) { const v4u raw = *(const v4u*)(proj + (rowbase + pp) * INW + COL_LIN + ch);
                  acc[0] += cw[jj][0] * bflo(raw.x); acc[1] += cw[jj][1] * bfhi(raw.x); acc[2] += cw[jj][2] * bflo(raw.y); acc[3] += cw[jj][3] * bfhi(raw.y);
                  acc[4] += cw[jj][4] * bflo(raw.z); acc[5] += cw[jj][5] * bfhi(raw.z); acc[6] += cw[jj][6] * bflo(raw.w); acc[7] += cw[jj][7] * bfhi(raw.w); } }
          v4u w; w.x = pkbf(acc[0], acc[1]); w.y = pkbf(acc[2], acc[3]); w.z = pkbf(acc[4], acc[5]); w.w = pkbf(acc[6], acc[7]);
          *(LAS v4u*)(cb + tok * CB_ROW + j8 * 16) = w; }
    }
    asm volatile("s_waitcnt lgkmcnt(0)" ::: "memory");
    const bf16* Wl = (const bf16*)(a.ws + WS_WLRU) + (size_t)wave * 256 * 64;
    const float* nl = (const float*)(a.ws + WS_NL);
    float ssq[2] = {0.f, 0.f};
#pragma unroll 1
    for (int cgi = 0; cgi < 4; ++cgi) {
        const int chl = cgi * 16 + 4 * fq, ch = 64 * wave + chl;
        bf16x8 wa[4][2];
#pragma unroll
        for (int g4 = 0; g4 < 4; ++g4)
#pragma unroll
            for (int ks = 0; ks < 2; ++ks) wa[g4][ks] = *(const bf16x8*)(Wl + (size_t)(g4 * 64 + cgi * 16 + fr) * 64 + ks * 32 + 8 * fq);
        const f32x4 baf = *(const f32x4*)(a.lru_b_a + ch), bab = *(const f32x4*)(a.lru_b_a + LRUW + ch), bxf = *(const f32x4*)(a.lru_b_x + ch), bxb = *(const f32x4*)(a.lru_b_x + LRUW + ch);
        const f32x4 nlf = *(const f32x4*)(nl + ch), nlb = *(const f32x4*)(nl + LRUW + ch);
        float AF[2][4], UF[2][4], AB[2][4], UB[2][4];
#pragma unroll
        for (int tt = 0; tt < 2; ++tt) {
            const LAS unsigned char* crow = cb + (tt * 16 + fr) * CB_ROW;
            const bf16x8 b0 = *(const LAS bf16x8*)(crow + fq * 16), b1 = *(const LAS bf16x8*)(crow + 64 + fq * 16);
            f32x4 pre[4];
#pragma unroll
            for (int g4 = 0; g4 < 4; ++g4) { pre[g4] = __builtin_amdgcn_mfma_f32_16x16x32_bf16(wa[g4][0], b0, (f32x4){0.f, 0.f, 0.f, 0.f}, 0, 0, 0);
                pre[g4] = __builtin_amdgcn_mfma_f32_16x16x32_bf16(wa[g4][1], b1, pre[g4], 0, 0, 0); }
            const v2u craw = *(const LAS v2u*)(crow + chl * 2);
            const float cv[4] = {bflo(craw.x), bfhi(craw.x), bflo(craw.y), bfhi(craw.y)};
            const bool valid = (p0 + tt * 16 + fr) < LSEQ;
#pragma unroll
            for (int i = 0; i < 4; ++i) {
                const float rf = __builtin_amdgcn_rcpf(1.0f + __builtin_amdgcn_exp2f((pre[0][i] + baf[i]) * -1.4426950408889634f));
                const float xf = __builtin_amdgcn_rcpf(1.0f + __builtin_amdgcn_exp2f((pre[1][i] + bxf[i]) * -1.4426950408889634f));
                const float rb = __builtin_amdgcn_rcpf(1.0f + __builtin_amdgcn_exp2f((pre[2][i] + bab[i]) * -1.4426950408889634f));
                const float xb = __builtin_amdgcn_rcpf(1.0f + __builtin_amdgcn_exp2f((pre[3][i] + bxb[i]) * -1.4426950408889634f));
                const float af = __builtin_amdgcn_exp2f(nlf[i] * rf * 1.4426950408889634f), ab = __builtin_amdgcn_exp2f(nlb[i] * rb * 1.4426950408889634f);
                const float uf = __builtin_amdgcn_sqrtf(fmaxf(1.0f - af * af, 0.f)) * xf * cv[i], ub = __builtin_amdgcn_sqrtf(fmaxf(1.0f - ab * ab, 0.f)) * xb * cv[i];
                AF[tt][i] = valid ? af : 1.f; UF[tt][i] = valid ? uf : 0.f; AB[tt][i] = valid ? ab : 1.f; UB[tt][i] = valid ? ub : 0.f;
            }
#pragma unroll
            for (int i = 0; i < 4; ++i) { scan_fwd16(AF[tt][i], UF[tt][i]); scan_bwd16(AB[tt][i], UB[tt][i]); }
        }
        if constexpr (!FINAL) {
            float* agg = (float*)(a.ws + WS_AGG) + (size_t)unit * 2048;
            if (fr == 15) { f32x4 A, B;
#pragma unroll
                for (int i = 0; i < 4; ++i) { A[i] = AF[0][i] * AF[1][i]; B[i] = fmaf(AF[1][i], UF[0][i], UF[1][i]); }
                *(f32x4*)(agg + ch) = A; *(f32x4*)(agg + 1024 + ch) = B; }
            if (fr == 0) { f32x4 A, B;
#pragma unroll
                for (int i = 0; i < 4; ++i) { A[i] = AB[0][i] * AB[1][i]; B[i] = fmaf(AB[0][i], UB[1][i], UB[0][i]); }
                *(f32x4*)(agg + LRUW + ch) = A; *(f32x4*)(agg + 1024 + LRUW + ch) = B; }
        } else {
            const float* carry = (const float*)(a.ws + WS_CARRY) + (size_t)unit * 1024;
            const f32x4 cf = *(const f32x4*)(carry + ch), cbk = *(const f32x4*)(carry + LRUW + ch);
            float hs[2][4];
#pragma unroll
            for (int i = 0; i < 4; ++i) {
                const float hf0 = fmaf(AF[0][i], cf[i], UF[0][i]); const float c1 = __shfl(hf0, 15, 16); const float hf1 = fmaf(AF[1][i], c1, UF[1][i]);
                const float hb1 = fmaf(AB[1][i], cbk[i], UB[1][i]); const float c0 = __shfl(hb1, 0, 16); const float hb0 = fmaf(AB[0][i], c0, UB[0][i]);
                hs[0][i] = hf0 + hb0; hs[1][i] = hf1 + hb1; }
#pragma unroll
            for (int tt = 0; tt < 2; ++tt) { const int tok = tt * 16 + fr, p = p0 + tok; f32x4 y = {0.f, 0.f, 0.f, 0.f};
                if (p < LSEQ) { const v2u graw = *(const v2u*)(proj + (rowbase + p) * INW + COL_LG + ch);
                    const float gv[4] = {bflo(graw.x), bfhi(graw.x), bflo(graw.y), bfhi(graw.y)};
#pragma unroll
                    for (int i = 0; i < 4; ++i) { const float g = gv[i], z = 1.5957691216057308f * (g + 0.044715f * g * g * g);
                        const float ge = g * __builtin_amdgcn_rcpf(1.0f + __builtin_amdgcn_exp2f(z * -1.4426950408889634f)); y[i] = hs[tt][i] * ge; } }
                ssq[tt] += (y[0] * y[0] + y[1] * y[1]) + (y[2] * y[2] + y[3] * y[3]);
                *(LAS f32x4*)(lds + LRU_Y + tok * Y_ROW + ch * 4) = y; }
        }
    }
    if constexpr (FINAL) {
#pragma unroll
        for (int tt = 0; tt < 2; ++tt) { float s = ssq[tt]; s += __shfl_xor(s, 16); s += __shfl_xor(s, 32); if (fq == 0) *(LAS float*)(lds + LRU_PART + ((tt * 16 + fr) * 8 + wave) * 4) = s; }
        __syncthreads();
        { const int tok = tid >> 4, seg = tid & 15, p = p0 + tok;
          if (p >= NMETA && p < LSEQ) {
              const LAS f32x4* pp = (const LAS f32x4*)(lds + LRU_PART + tok * 32); const f32x4 s0 = pp[0], s1 = pp[1];
              const float tot = ((s0[0] + s0[1]) + (s0[2] + s0[3])) + ((s1[0] + s1[1]) + (s1[2] + s1[3]));
              const float rstd = __builtin_amdgcn_rsqf(tot * (1.0f / LRUW) + 1e-6f);
              bf16* orow = (bf16*)(a.ws + WS_XN) + ((size_t)b * SEQ + (p - NMETA)) * DM + LRUW;
#pragma unroll
              for (int k = 0; k < 4; ++k) { const int ch = k * 128 + seg * 8;
                  const LAS f32x4* yp = (const LAS f32x4*)(lds + LRU_Y + tok * Y_ROW + ch * 4); const f32x4 y0 = yp[0], y1 = yp[1];
                  const f32x4 g0 = *(const f32x4*)(a.lru_out_g + ch), g1 = *(const f32x4*)(a.lru_out_g + ch + 4);
                  v4u w; w.x = pkbf(y0[0] * rstd * g0[0], y0[1] * rstd * g0[1]); w.y = pkbf(y0[2] * rstd * g0[2], y0[3] * rstd * g0[3]);
                  w.z = pkbf(y1[0] * rstd * g1[0], y1[1] * rstd * g1[1]); w.w = pkbf(y1[2] * rstd * g1[2], y1[3] * rstd * g1[3]);
                  *(v4u*)(orow + ch) = w; } } }
        __syncthreads();
    }
}

__device__ __forceinline__ void lru_carry(const Args& a, int id) {
    const float* __restrict__ agg = (const float*)(a.ws + WS_AGG); float* __restrict__ carry = (float*)(a.ws + WS_CARRY);
    const int b = id >> 10, dc = id & 1023, dir = dc >> 9; float h = 0.f;
    const float* ap = agg + (size_t)b * NCH * 2048 + dc; float* cp = carry + (size_t)b * NCH * 1024 + dc;
    const long sa = dir ? -2048 : 2048, sc = dir ? -1024 : 1024;
    if (dir) { ap += (size_t)(NCH - 1) * 2048; cp += (size_t)(NCH - 1) * 1024; }
    int ci = 0;
    for (; ci + 8 <= NCH; ci += 8) { float A[8], B[8];
#pragma unroll
        for (int k = 0; k < 8; ++k) { A[k] = ap[k * sa]; B[k] = ap[k * sa + 1024]; }
#pragma unroll
        for (int k = 0; k < 8; ++k) { cp[k * sc] = h; h = fmaf(A[k], h, B[k]); }
        ap += 8 * sa; cp += 8 * sc; }
    for (; ci < NCH; ++ci) { const float A = ap[0], B = ap[1024]; cp[0] = h; h = fmaf(A, h, B); ap += sa; cp += sc; }
}

__global__ void __launch_bounds__(NWAVES * 64, 2) hymba_fwd(Args a) {
    extern __shared__ __attribute__((aligned(16))) unsigned char lds_raw[];
    LAS unsigned char* lds = (LAS unsigned char*)lds_raw;
    cg::grid_group grid = cg::this_grid();
    const int tid = threadIdx.x, lane = tid & 63, wave = __builtin_amdgcn_readfirstlane(tid >> 6);
    const int G = gridDim.x, bx = blockIdx.x, vcu = (G % 8 == 0) ? (bx % 8) * (G / 8) + bx / 8 : bx;
    unsigned char* ws = a.ws;
    const int lo = a.ph_lo, hi = a.ph_hi;
#define IN(k) (lo <= (k) && (k) < hi)
#define SEAM(k) do { if (IN(k) && IN((k) + 1)) grid.sync(); } while (0)

    if (IN(0)) { phase0(a, lds, vcu, G, wave, lane, tid); }
    SEAM(0);
    if (IN(1)) {
        pg8::Gemm g{(const pg8::bf16_t*)(ws + WS_XN), (const pg8::bf16_t*)(ws + WS_WIN), MP, INW, DM}; pg8::StaticOrder S; S.init(MP, INW, G, bx);
        pg8::EpiStore E{(pg8::bf16_t*)(ws + WS_PROJ), INW};
        pg8::gemm_phase<pg8::EpiStore, pg8::StaticOrder, true, true>(lds, g, S, E);
    }
    SEAM(1);
    if (IN(2)) {
        phase_qk(a, vcu, G, wave, lane);
        for (int u = bx; u < NLU; u += G) lru_unit<false>(a, lds, u, wave, lane, tid);
    }
    SEAM(2);
    if (IN(3)) {
        if (bx < 24) lru_carry(a, bx * 512 + tid);
        const attn_body::bf16* proj = (const attn_body::bf16*)(ws + WS_PROJ); attn_body::bf16* mix = (attn_body::bf16*)(ws + WS_XN);
        if (G == 256) {
            const int x = bx & 7, jl = bx >> 3;
            for (int i = 0; i < 12; ++i) { const int pi = x + 8 * (i >> 2), w = jl * 4 + (i & 3), b = pi >> 1, kvh = pi & 1, h = kvh * 4 + (w >> 5), qb = w & 31;
                attn_body::attn_unit<8>(proj + ((size_t)b * LSEQ + NMETA + qb * 256) * INW + h * 64, proj + (size_t)b * LSEQ * INW + COL_K + kvh * 64, proj + (size_t)b * LSEQ * INW + COL_V + kvh * 64,
                                        mix + ((size_t)b * SEQ + qb * 256) * DM + h * 64, (char*)lds_raw); }
        } else {
            for (int u = bx; u < NSEQ * 8 * 32; u += G) { const int b = u >> 8, h = (u >> 5) & 7, qb = u & 31, kvh = h >> 2;
                attn_body::attn_unit<8>(proj + ((size_t)b * LSEQ + NMETA + qb * 256) * INW + h * 64, proj + (size_t)b * LSEQ * INW + COL_K + kvh * 64, proj + (size_t)b * LSEQ * INW + COL_V + kvh * 64,
                                        mix + ((size_t)b * SEQ + qb * 256) * DM + h * 64, (char*)lds_raw); }
        }
    }
    SEAM(3);
    if (IN(4)) {
        { bf16* mix = (bf16*)(ws + WS_XN); const int gw = vcu * NWAVES + wave, NGW = G * NWAVES;
          const f32x4 g0 = *(const f32x4*)(a.attn_out_g + lane * 8), g1 = *(const f32x4*)(a.attn_out_g + lane * 8 + 4);
          for (int r = gw; r < MC; r += NGW) { bf16* ptr = mix + (size_t)r * DM + lane * 8; const v4u raw = *(const v4u*)ptr;
              float x[8] = {bflo(raw.x), bfhi(raw.x), bflo(raw.y), bfhi(raw.y), bflo(raw.z), bfhi(raw.z), bflo(raw.w), bfhi(raw.w)};
              float s = 0.f;
#pragma unroll
              for (int e = 0; e < 8; ++e) s += x[e] * x[e];
              const float rstd = __builtin_amdgcn_rsqf(wave_sum(s) * (1.0f / 512.0f) + 1e-6f);
              v4u w; w.x = pkbf(x[0] * rstd * g0[0], x[1] * rstd * g0[1]); w.y = pkbf(x[2] * rstd * g0[2], x[3] * rstd * g0[3]);
              w.z = pkbf(x[4] * rstd * g1[0], x[5] * rstd * g1[1]); w.w = pkbf(x[6] * rstd * g1[2], x[7] * rstd * g1[3]);
              *(v4u*)ptr = w; } }
        for (int u = bx; u < NLU; u += G) lru_unit<true>(a, lds, u, wave, lane, tid);
    }
    SEAM(4);
    if (IN(5)) {
        pg8::Gemm g{(const pg8::bf16_t*)(ws + WS_XN), (const pg8::bf16_t*)(ws + WS_WOUT), MC, DM, DM}; pg8::StaticOrder S; S.init(MC, DM, G, bx);
        pg8::EpiResid1 E{a.x_prompt, a.x_sample, a.out, (pg8::bf16_t*)(ws + WS_H1B), (float*)(ws + WS_SSQ1)};
        pg8::gemm_phase<pg8::EpiResid1, pg8::StaticOrder, true, true>(lds, g, S, E);
    }
    SEAM(5);
    if (IN(6)) {
        pg8::Gemm g{(const pg8::bf16_t*)(ws + WS_H1B), (const pg8::bf16_t*)(ws + WS_WGU), MC, 2 * FFH, DM}; pg8::StaticOrder S; S.init(MC, 2 * FFH, G, bx);
        pg8::EpiSwiglu E{(pg8::bf16_t*)(ws + WS_HID), FFH, (const float*)(ws + WS_SSQ1)};
        pg8::gemm_phase<pg8::EpiSwiglu, pg8::StaticOrder, true, true>(lds, g, S, E);
    }
    SEAM(6);
    if (IN(7)) {
        pg8::Gemm g{(const pg8::bf16_t*)(ws + WS_HID), (const pg8::bf16_t*)(ws + WS_WDN), MC, DM, FFH}; pg8::StaticOrder S; S.init(MC, DM, G, bx);
        pg8::EpiResid2 E{a.out, (float*)(ws + WS_SSQ2)};
        pg8::gemm_phase<pg8::EpiResid2, pg8::StaticOrder, true, true>(lds, g, S, E);
    }
    SEAM(7);
    if (IN(8)) {
        const int gw = vcu * NWAVES + wave, NGW = G * NWAVES; const float* ssq = (const float*)(ws + WS_SSQ2);
        f32x4 g4[4];
#pragma unroll
        for (int j = 0; j < 4; ++j) g4[j] = *((const f32x4*)a.final_norm_g + lane + 64 * j);
        for (int r = gw; r < MC; r += NGW) { f32x4* xr = (f32x4*)(a.out + (size_t)r * DM) + lane;
            const f32x4* sp = (const f32x4*)(ssq + (size_t)r * 16); const f32x4 s0 = sp[0], s1 = sp[1], s2 = sp[2], s3 = sp[3];
            const float tot = (((s0[0] + s0[1]) + (s0[2] + s0[3])) + ((s1[0] + s1[1]) + (s1[2] + s1[3]))) + (((s2[0] + s2[1]) + (s2[2] + s2[3])) + ((s3[0] + s3[1]) + (s3[2] + s3[3])));
            const float rstd = __builtin_amdgcn_rsqf(tot * (1.0f / DM) + 1e-6f);
#pragma unroll
            for (int j = 0; j < 4; ++j) xr[64 * j] = xr[64 * j] * rstd * g4[j]; }
    }
#undef IN
#undef SEAM
}

extern "C" void kernel_launch(void* const* d_in, const int* in_sizes, int n_in, void* d_out, int out_size, void* d_ws, size_t ws_size, hipStream_t stream) {
    static int grid = 0;
    if (grid == 0) {
        if (n_in != 21 || out_size != MC * DM || ws_size < WS_END) { fprintf(stderr, "kernel_launch: unexpected shapes (n_in %d out %d ws %zu)\n", n_in, out_size, ws_size); grid = -1; return; }
        int dev = 0, cus = 0, per_cu = 0;
        (void)hipGetDevice(&dev); (void)hipDeviceGetAttribute(&cus, hipDeviceAttributeMultiprocessorCount, dev);
        if (hipFuncSetAttribute((const void*)hymba_fwd, hipFuncAttributeMaxDynamicSharedMemorySize, LDS_BYTES) != hipSuccess) { fprintf(stderr, "kernel_launch: hipFuncSetAttribute failed\n"); grid = -1; return; }
        if (hipOccupancyMaxActiveBlocksPerMultiprocessor(&per_cu, (const void*)hymba_fwd, NWAVES * 64, LDS_BYTES) != hipSuccess || per_cu < 1) { fprintf(stderr, "kernel_launch: occupancy query says %d\n", per_cu); per_cu = 1; }
        (void)hipGetLastError();
        grid = cus * 1;
        if (grid <= 0) grid = 256;
    }
    if (grid < 0) return;
    Args a{};
    const float** slots[21] = {&a.x_prompt, &a.x_sample, &a.meta, &a.norm_mix_g, &a.w_in, &a.q_norm_g, &a.k_norm_g, &a.conv_w, &a.conv_b, &a.lru_w_a, &a.lru_b_a, &a.lru_w_x, &a.lru_b_x, &a.lru_lam,
                               &a.attn_out_g, &a.lru_out_g, &a.w_out, &a.norm_ffn_g, &a.w_gate_up, &a.w_down, &a.final_norm_g};
    for (int i = 0; i < 21; ++i) *slots[i] = (const float*)d_in[i];
    a.out = (float*)d_out; a.ws = (unsigned char*)d_ws;
#if MK_N_LAUNCHES == 1
    a.ph_lo = 0; a.ph_hi = NPHASE;
    void* args[] = {&a};
    hipError_t e = hipLaunchCooperativeKernel((const void*)hymba_fwd, dim3(grid), dim3(NWAVES * 64), args, LDS_BYTES, stream);
    if (e != hipSuccess) fprintf(stderr, "kernel_launch: cooperative launch failed: %s (grid %d)\n", hipGetErrorString(e), grid);
#else
    for (int p = 0; p < NPHASE; ++p) { a.ph_lo = p; a.ph_hi = p + 1; hipLaunchKernelGGL(hymba_fwd, dim3(grid), dim3(NWAVES * 64), LDS_BYTES, stream, a); }
#endif
}
```

```cpp
#include <hip/hip_runtime.h>
#include <hip/hip_cooperative_groups.h>
#include <hip/hip_bf16.h>
#include <cstdio>
#include <cstdint>
#include <cmath>
namespace cg = cooperative_groups;

namespace pg8 {
#define PG8_LAS __attribute__((address_space(3)))
typedef unsigned short bf16_t;
typedef short bf16x8 __attribute__((ext_vector_type(8)));
typedef float f32x4 __attribute__((ext_vector_type(4)));
typedef unsigned u32x4 __attribute__((ext_vector_type(4)));
constexpr int BM = 256, BK = 64, HALF = 128, HTB = HALF * BK * 2  , STAGE_BYTES = 8 * HTB, NXCD = 8, WGM = 8;

__host__ __device__ __forceinline__ int lds_byte(int r, int c) { const int st = (r >> 4) * 2 + (c >> 5), rr = r & 15, cc = c & 31, ob = rr * 64 + cc * 2; return st * 1024 + (ob ^ (((ob >> 9) & 1) << 5)); }
__host__ __device__ __forceinline__ void stage_rc(int b, int& R, int& C) { const int st = b / 1024, sb = b % 1024, swz = sb ^ (((sb >> 9) & 1) << 5); R = (st >> 1) * 16 + swz / 64; C = (st & 1) * 32 + (swz % 64) / 2; }
__host__ __device__ __forceinline__ int perm32(int rho) { const int n = rho >> 4, i = rho & 15; return 8 * (i >> 2) + 4 * n + (i & 3); }

struct Unit { int pm, pn; };
struct Gemm { const bf16_t* A; const bf16_t* Bt; int M, N, K; };

struct StaticOrder {
    int nM, nN, nwg, G, c;
    __host__ __device__ void init(int M, int N, int G_, int c_) { nM = M / BM; nN = N / BM; nwg = nM * nN; G = G_; c = c_; }
    __host__ __device__ bool next(int i, Unit& u) const {
        const long L = (long)i * G + c; if (L >= nwg) return false;
        int wgid = (int)L; { const int q = nwg / NXCD, r = nwg % NXCD, xcd = wgid % NXCD, off = wgid / NXCD; wgid = (xcd < r ? xcd * (q + 1) : r * (q + 1) + (xcd - r) * q) + off; }
        const int nig = WGM * nN, gid = wgid / nig, fm = gid * WGM, gsz = (nM - fm) < WGM ? (nM - fm) : WGM;
        u.pm = fm + ((wgid % nig) % gsz); u.pn = (wgid % nig) / gsz; return true;
    }
    __device__ __forceinline__ void a_ready(const Unit&) const {}
    __device__ __forceinline__ void done(const Unit&) const {}
};


template <class Epi, class Sched, bool ALIGN_EPI = false, bool SP2 = false>
__device__ __forceinline__ void gemm_phase(PG8_LAS unsigned char* lds, const Gemm g, const Sched& S, const Epi& E) {
    const int tid = threadIdx.x, wid = __builtin_amdgcn_readfirstlane(tid >> 6), lane = tid & 63, wr = wid >> 2, wc = wid & 3, fr = lane & 15, fq = lane >> 4;
    const int K = g.K, nt = K / BK;
    unsigned voffA[2], voffB[2];
#pragma unroll
    for (int i = 0; i < 2; ++i) { int R, C; stage_rc(tid * 16 + i * 8192, R, C); const int Rb = Epi::PERM ? ((R & ~31) + perm32(R & 31)) : R;
        voffA[i] = (unsigned)(R * K + C) * 2u; voffB[i] = (unsigned)(Rb * K + C) * 2u; }
    const size_t kstep = (size_t)(BK * 2);
    const size_t hstep = (size_t)HALF * K * 2;
    const size_t tstep = 2 * hstep;
    const unsigned ldsw = (unsigned)wid * 1024u;
    const int aoff = lds_byte(wr * 64 + fr, fq * 8), boff = lds_byte(wc * 32 + fr, fq * 8);
#define PG8_SA(b, h) (((b) * 2 + (h)) * HTB)
#define PG8_SB(b, h) ((4 + (b) * 2 + (h)) * HTB)
#define PG8_STAGE(bufoff, gbase, voff) do { _Pragma("unroll") for (int _i = 0; _i < 2; ++_i) \
        __builtin_amdgcn_global_load_lds((const unsigned*)((const char*)(gbase) + (voff)[_i]), (PG8_LAS unsigned*)(lds + (bufoff) + ldsw + _i * 8192), 16, 0, 0); } while (0)
#define PG8_LDA(dst, b, h) do { _Pragma("unroll") for (int m = 0; m < 4; ++m) _Pragma("unroll") for (int k = 0; k < 2; ++k) dst[m][k] = *(const PG8_LAS bf16x8*)(lds + PG8_SA(b, h) + aoff + m * 2048 + k * 1024); } while (0)
#define PG8_LDB(dst, b, h) do { _Pragma("unroll") for (int n = 0; n < 2; ++n) _Pragma("unroll") for (int k = 0; k < 2; ++k) dst[n][k] = *(const PG8_LAS bf16x8*)(lds + PG8_SB(b, h) + boff + n * 2048 + k * 1024); } while (0)
#define PG8_MMA(ai, bj, At, Bt) do { __builtin_amdgcn_s_setprio(1); _Pragma("unroll") for (int m = 0; m < 4; ++m) _Pragma("unroll") for (int n = 0; n < 2; ++n) _Pragma("unroll") for (int k = 0; k < 2; ++k) \
        acc[ai][bj][m][n] = __builtin_amdgcn_mfma_f32_16x16x32_bf16(Bt[n][k], At[m][k], acc[ai][bj][m][n], 0, 0, 0); __builtin_amdgcn_s_setprio(0); } while (0)
#define PG8_WAIT_V(n) asm volatile("s_waitcnt vmcnt(" #n ")" ::: "memory")
#define PG8_WAIT_L(n) asm volatile("s_waitcnt lgkmcnt(" #n ")" ::: "memory")
#define PG8_BAR __builtin_amdgcn_s_barrier()
#define PG8_SCHED __builtin_amdgcn_sched_barrier(0)
    Unit cur, nxt; int ui = 0;
    if (!S.next(0, cur)) return;
    f32x4 acc[2][2][4][2];
#pragma unroll
    for (int a = 0; a < 2; ++a)
#pragma unroll
        for (int b = 0; b < 2; ++b)
#pragma unroll
            for (int m = 0; m < 4; ++m)
#pragma unroll
                for (int n = 0; n < 2; ++n) acc[a][b][m][n] = (f32x4){0.f, 0.f, 0.f, 0.f};
    bf16x8 At[4][2], B0[2][2], B1[2][2];
    const char* cA = (const char*)g.A + (size_t)cur.pm * tstep; const char* cB = (const char*)g.Bt + (size_t)cur.pn * tstep;
    S.a_ready(cur);
    if constexpr (SP2) {
        PG8_STAGE(PG8_SB(0, 0), cB, voffB); PG8_STAGE(PG8_SB(0, 1), cB + hstep, voffB); PG8_STAGE(PG8_SA(0, 0), cA, voffA); PG8_STAGE(PG8_SA(0, 1), cA + hstep, voffA);
        if (wr == 1) PG8_BAR;
        PG8_WAIT_V(2); PG8_BAR;
        PG8_STAGE(PG8_SB(1, 0), cB + kstep, voffB); PG8_STAGE(PG8_SA(1, 0), cA + kstep, voffA); PG8_STAGE(PG8_SB(1, 1), cB + hstep + kstep, voffB);
        PG8_WAIT_V(6); PG8_BAR;
    } else {
        PG8_STAGE(PG8_SB(0, 0), cB, voffB); PG8_STAGE(PG8_SA(0, 0), cA, voffA); PG8_STAGE(PG8_SB(0, 1), cB + hstep, voffB); PG8_STAGE(PG8_SA(0, 1), cA + hstep, voffA);
        if (wr == 1) PG8_BAR;
        PG8_WAIT_V(4); PG8_BAR;
        PG8_STAGE(PG8_SB(1, 0), cB + kstep, voffB); PG8_STAGE(PG8_SA(1, 0), cA + kstep, voffA); PG8_STAGE(PG8_SB(1, 1), cB + hstep + kstep, voffB);
        PG8_WAIT_V(6); PG8_BAR;
    }
    for (;;) {
        const bool has_next = S.next(ui + 1, nxt);
        const char* nA = has_next ? (const char*)g.A + (size_t)nxt.pm * tstep : cA; const char* nB = has_next ? (const char*)g.Bt + (size_t)nxt.pn * tstep : cB;
        for (int t = 0; t < nt; t += 2) {
            const bool last = (t == nt - 2);
            const char* a1 = cA + (size_t)(t + 1) * kstep;
            const char* a2 = last ? nA : cA + (size_t)(t + 2) * kstep; const char* b2 = last ? nB : cB + (size_t)(t + 2) * kstep;
            const char* a3 = a2 + kstep; const char* b3 = b2 + kstep;
            if (last && has_next) S.a_ready(nxt);
            if constexpr (SP2) {
            PG8_LDB(B0, 0, 0); PG8_LDB(B1, 0, 1); PG8_SCHED; PG8_LDA(At, 0, 0); PG8_STAGE(PG8_SA(1, 1), a1 + hstep, voffA);
            PG8_WAIT_V(8); PG8_WAIT_L(0); PG8_BAR; PG8_MMA(0, 0, At, B0); PG8_MMA(0, 1, At, B1); PG8_BAR; PG8_SCHED;
            PG8_LDA(At, 0, 1); PG8_STAGE(PG8_SB(0, 0), b2, voffB); PG8_STAGE(PG8_SB(0, 1), b2 + hstep, voffB); PG8_STAGE(PG8_SA(0, 0), a2, voffA);
            PG8_WAIT_V(8); PG8_WAIT_L(0); PG8_BAR; PG8_MMA(1, 0, At, B0); PG8_MMA(1, 1, At, B1); PG8_BAR; PG8_SCHED;
            PG8_LDB(B0, 1, 0); PG8_LDB(B1, 1, 1); PG8_SCHED; PG8_LDA(At, 1, 0); PG8_STAGE(PG8_SA(0, 1), a2 + hstep, voffA);
            PG8_WAIT_V(8); PG8_WAIT_L(0); PG8_BAR; PG8_MMA(0, 0, At, B0); PG8_MMA(0, 1, At, B1); PG8_BAR; PG8_SCHED;
            PG8_LDA(At, 1, 1); PG8_STAGE(PG8_SB(1, 0), b3, voffB); PG8_STAGE(PG8_SB(1, 1), b3 + hstep, voffB); PG8_STAGE(PG8_SA(1, 0), a3, voffA);
            PG8_WAIT_V(8); PG8_WAIT_L(0); PG8_BAR; PG8_MMA(1, 0, At, B0); PG8_MMA(1, 1, At, B1); PG8_BAR; PG8_SCHED;
            } else {
            PG8_LDB(B0, 0, 0); PG8_SCHED; PG8_LDA(At, 0, 0); PG8_STAGE(PG8_SA(1, 1), a1 + hstep, voffA);
            PG8_WAIT_L(8); PG8_BAR; PG8_WAIT_L(0); PG8_MMA(0, 0, At, B0); PG8_BAR; PG8_SCHED;
            PG8_LDB(B1, 0, 1); PG8_STAGE(PG8_SB(0, 0), b2, voffB);
            PG8_BAR; PG8_WAIT_L(0); PG8_MMA(0, 1, At, B1); PG8_BAR;
            PG8_LDA(At, 0, 1); PG8_STAGE(PG8_SA(0, 0), a2, voffA);
            PG8_BAR; PG8_WAIT_L(0); PG8_MMA(1, 0, At, B0); PG8_BAR; PG8_SCHED;
            PG8_STAGE(PG8_SB(0, 1), b2 + hstep, voffB);
            PG8_WAIT_V(6); PG8_BAR; PG8_MMA(1, 1, At, B1); PG8_BAR;
            PG8_LDB(B0, 1, 0); PG8_SCHED; PG8_LDA(At, 1, 0); PG8_STAGE(PG8_SA(0, 1), a2 + hstep, voffA);
            PG8_WAIT_L(8); PG8_BAR; PG8_WAIT_L(0); PG8_MMA(0, 0, At, B0); PG8_BAR; PG8_SCHED;
            PG8_LDB(B1, 1, 1); PG8_STAGE(PG8_SB(1, 0), b3, voffB);
            PG8_BAR; PG8_WAIT_L(0); PG8_MMA(0, 1, At, B1); PG8_BAR;
            PG8_LDA(At, 1, 1); PG8_STAGE(PG8_SA(1, 0), a3, voffA);
            PG8_BAR; PG8_WAIT_L(0); PG8_MMA(1, 0, At, B0); PG8_BAR; PG8_SCHED;
            PG8_STAGE(PG8_SB(1, 1), b3 + hstep, voffB);
            PG8_WAIT_V(6); PG8_BAR; PG8_MMA(1, 1, At, B1); PG8_BAR;
            }
        }
        if constexpr (ALIGN_EPI) { if (wr == 0) PG8_BAR; }
        if constexpr (!Epi::AFTER_DRAIN) { E(acc, cur, wr, wc, fr, fq); S.done(cur); }
        if (!has_next) break;
#pragma unroll
        for (int a = 0; a < 2; ++a)
#pragma unroll
            for (int b = 0; b < 2; ++b)
#pragma unroll
                for (int m = 0; m < 4; ++m)
#pragma unroll
                    for (int n = 0; n < 2; ++n) acc[a][b][m][n] = (f32x4){0.f, 0.f, 0.f, 0.f};
        cur = nxt; cA = nA; cB = nB; ++ui;
        if constexpr (ALIGN_EPI) { if (wr == 1) PG8_BAR; }
    }
    PG8_WAIT_V(0);
    if constexpr (!ALIGN_EPI) { if (wr == 0) PG8_BAR; }
    PG8_BAR;
    if constexpr (Epi::AFTER_DRAIN) { E.fused(acc, cur, wr, wc, fr, fq, lds, wid, lane); S.done(cur); }
#undef PG8_SA
#undef PG8_SB
#undef PG8_STAGE
#undef PG8_LDA
#undef PG8_LDB
#undef PG8_MMA
#undef PG8_WAIT_V
#undef PG8_WAIT_L
#undef PG8_BAR
#undef PG8_SCHED
}
}

namespace pg8 {
typedef float f32x2e __attribute__((ext_vector_type(2))); typedef __bf16 bf16x2e __attribute__((ext_vector_type(2))); typedef unsigned u32x2e __attribute__((ext_vector_type(2)));
__device__ __forceinline__ unsigned pkbf(float lo, float hi) { f32x2e v = {lo, hi}; bf16x2e b = __builtin_convertvector(v, bf16x2e); return __builtin_bit_cast(unsigned, b); }
struct EpiStore {
    static constexpr bool PERM = true, AFTER_DRAIN = false;
    bf16_t* O; int ldc;
    __device__ __forceinline__ void operator()(const f32x4 (&acc)[2][2][4][2], const Unit& u, int wr, int wc, int fr, int fq) const {
        const int row0 = u.pm * BM + wr * 64 + fr, col0 = u.pn * BM + wc * 32 + 8 * fq;
#pragma unroll
        for (int ai = 0; ai < 2; ++ai)
#pragma unroll
            for (int m = 0; m < 4; ++m) { bf16_t* rowp = O + (size_t)(row0 + ai * HALF + m * 16) * ldc + col0;
#pragma unroll
                for (int bj = 0; bj < 2; ++bj) { const f32x4 v0 = acc[ai][bj][m][0], v1 = acc[ai][bj][m][1];
                    u32x4 w; w.x = pkbf(v0[0], v0[1]); w.y = pkbf(v0[2], v0[3]); w.z = pkbf(v1[0], v1[1]); w.w = pkbf(v1[2], v1[3]);
                    *(u32x4*)(rowp + bj * HALF) = w; } }
    }
};
struct EpiResid1 {
    static constexpr bool PERM = false, AFTER_DRAIN = false;
    const float* xp; const float* xs; float* out; bf16_t* hb; float* ssq;
    __device__ __forceinline__ void operator()(const f32x4 (&acc)[2][2][4][2], const Unit& u, int wr, int wc, int fr, int fq) const {
        const int rbase = u.pm * BM;
        const float* xb = rbase < 65536 ? xp + (size_t)rbase * 1024 : xs + (size_t)(rbase - 65536) * 1024;
        float* ob = out + (size_t)rbase * 1024; bf16_t* hbb = hb + (size_t)rbase * 1024;
        const int col0 = u.pn * BM + wc * 32 + 4 * fq;
#pragma unroll
        for (int ai = 0; ai < 2; ++ai)
#pragma unroll
            for (int m = 0; m < 4; ++m) { const int r = ai * HALF + wr * 64 + m * 16 + fr; float s = 0.f;
#pragma unroll
                for (int bj = 0; bj < 2; ++bj)
#pragma unroll
                    for (int n = 0; n < 2; ++n) { const size_t off = (size_t)r * 1024 + col0 + bj * HALF + n * 16;
                        const f32x4 h = *(const f32x4*)(xb + off) + acc[ai][bj][m][n];
                        *(f32x4*)(ob + off) = h; u32x2e w; w.x = pkbf(h[0], h[1]); w.y = pkbf(h[2], h[3]); *(u32x2e*)(hbb + off) = w;
                        s += (h[0] * h[0] + h[1] * h[1]) + (h[2] * h[2] + h[3] * h[3]); }
                s += __shfl_xor(s, 16); s += __shfl_xor(s, 32);
                if (fq == 0) ssq[(size_t)(rbase + r) * 16 + u.pn * 4 + wc] = s; }
    }
};
struct EpiSwiglu {
    static constexpr bool PERM = true, AFTER_DRAIN = false;
    bf16_t* H; int ldh; const float* ssq;
    __device__ __forceinline__ void operator()(const f32x4 (&acc)[2][2][4][2], const Unit& u, int wr, int wc, int fr, int fq) const {
        const int col0 = u.pn * HALF + wc * 32 + 8 * fq;
#pragma unroll
        for (int ai = 0; ai < 2; ++ai)
#pragma unroll
            for (int m = 0; m < 4; ++m) { const int row = u.pm * BM + ai * HALF + wr * 64 + m * 16 + fr;
                const f32x4* sp = (const f32x4*)(ssq + (size_t)row * 16); const f32x4 a = sp[0], b = sp[1], c = sp[2], d = sp[3];
                const float tot = (((a[0] + a[1]) + (a[2] + a[3])) + ((b[0] + b[1]) + (b[2] + b[3]))) + (((c[0] + c[1]) + (c[2] + c[3])) + ((d[0] + d[1]) + (d[2] + d[3])));
                const float rstd = __builtin_amdgcn_rsqf(tot * (1.0f / 1024.0f) + 1e-6f);
                float hv[8];
#pragma unroll
                for (int n = 0; n < 2; ++n)
#pragma unroll
                    for (int i = 0; i < 4; ++i) { const float g = acc[ai][0][m][n][i] * rstd, uu = acc[ai][1][m][n][i] * rstd;
                        const float sg = g * __builtin_amdgcn_rcpf(1.0f + __builtin_amdgcn_exp2f(g * -1.4426950408889634f)); hv[n * 4 + i] = sg * uu; }
                u32x4 w; w.x = pkbf(hv[0], hv[1]); w.y = pkbf(hv[2], hv[3]); w.z = pkbf(hv[4], hv[5]); w.w = pkbf(hv[6], hv[7]);
                *(u32x4*)(H + (size_t)row * ldh + col0) = w; }
    }
};
struct EpiResid2 {
    static constexpr bool PERM = false, AFTER_DRAIN = false;
    float* out; float* ssq;
    __device__ __forceinline__ void operator()(const f32x4 (&acc)[2][2][4][2], const Unit& u, int wr, int wc, int fr, int fq) const {
        const int rbase = u.pm * BM; float* ob = out + (size_t)rbase * 1024;
        const int col0 = u.pn * BM + wc * 32 + 4 * fq;
#pragma unroll
        for (int ai = 0; ai < 2; ++ai)
#pragma unroll
            for (int m = 0; m < 4; ++m) { const int r = ai * HALF + wr * 64 + m * 16 + fr; float s = 0.f;
#pragma unroll
                for (int bj = 0; bj < 2; ++bj)
#pragma unroll
                    for (int n = 0; n < 2; ++n) { const size_t off = (size_t)r * 1024 + col0 + bj * HALF + n * 16;
                        const f32x4 h = *(const f32x4*)(ob + off) + acc[ai][bj][m][n];
                        *(f32x4*)(ob + off) = h;
                        s += (h[0] * h[0] + h[1] * h[1]) + (h[2] * h[2] + h[3] * h[3]); }
                s += __shfl_xor(s, 16); s += __shfl_xor(s, 32);
                if (fq == 0) ssq[(size_t)(rbase + r) * 16 + u.pn * 4 + wc] = s; }
    }
};
}

#include <hip/hip_bf16.h>
#include <cmath>
namespace attn_body {
using bf16=__hip_bfloat16;
using bf16x8=__attribute__((ext_vector_type(8)))short;
using s16x4=__attribute__((ext_vector_type(4)))short;
using f32x16=__attribute__((ext_vector_type(16)))float;
using u32x4=__attribute__((ext_vector_type(4)))unsigned;
constexpr int D=64,QP=1792,OP=1024;
constexpr int NW=8,QBLK=32,QB=QBLK*NW,KVBLK=64,NT=129;
__device__ __forceinline__ int crow(int r,int hi){return (r&3)+8*(r>>2)+4*hi;}
#define SBAR() __builtin_amdgcn_sched_barrier(0)
__device__ __forceinline__ void tmask(f32x16&p0,f32x16&p1){
  const float NEG=-INFINITY;
  #pragma unroll
  for(int r=0;r<16;++r){ if(r>=8)p0[r]=NEG; p1[r]=NEG; }
}

constexpr int NSLOT=3, SLOTB=8192;
constexpr int LDS_K=0, LDS_V=NSLOT*SLOTB, LDS_WS=2*NSLOT*SLOTB, LDS_OST=LDS_WS+NW*64*4, LDS_BYTES=LDS_OST+NW*4096;
constexpr float C2=0.125f*1.4426950408889634f;
__device__ __forceinline__ void glds16(const void*gsrc,unsigned lds_dst){unsigned keep;
  asm volatile("s_mov_b32 %0, m0\n\ts_mov_b32 m0, %2\n\ts_nop 0\n\tglobal_load_lds_dwordx4 %1, off\n\ts_mov_b32 m0, %0":"=&s"(keep):"v"(gsrc),"s"(lds_dst):"memory");}
__device__ __forceinline__ float max3f(float a,float b,float c){float r;asm("v_max3_f32 %0, %1, %2, %3":"=v"(r):"v"(a),"v"(b),"v"(c));return r;}
__device__ __forceinline__ float max2f(float a,float b){float r;asm("v_max_f32_e32 %0, %1, %2":"=v"(r):"v"(a),"v"(b));return r;}
__device__ __forceinline__ float fadd_s(float a,float b){float r;asm("v_add_f32_e32 %0, %1, %2":"=v"(r):"v"(a),"v"(b));return r;}
__device__ __forceinline__ float fsub_s(float a,float b){float r;asm("v_sub_f32_e32 %0, %1, %2":"=v"(r):"v"(a),"v"(b));return r;}
typedef float f32x2_t __attribute__((ext_vector_type(2))); typedef __bf16 bf16x2_t __attribute__((ext_vector_type(2)));
__device__ __forceinline__ unsigned cvtpk_s(float lo,float hi){f32x2_t v={lo,hi};bf16x2_t b=__builtin_convertvector(v,bf16x2_t);return __builtin_bit_cast(unsigned,b);}
#define WAIT_BAR(N) asm volatile("s_waitcnt vmcnt(" #N ") lgkmcnt(0)\n\ts_barrier":::"memory")

__device__ __forceinline__ void qkt(f32x16&p0,f32x16&p1,const char*Kslot,const bf16x8*qr,const f32x16&negm,int r32,int hi){
  const char*kb=Kslot+hi*1024+r32*16;
  #pragma unroll
  for(int d0=0;d0<4;++d0){
    const bf16x8 b0=*reinterpret_cast<const bf16x8*>(kb+d0*2048);
    const bf16x8 b1=*reinterpret_cast<const bf16x8*>(kb+d0*2048+512);
    if(d0==0){p0=__builtin_amdgcn_mfma_f32_32x32x16_bf16(b0,qr[0],negm,0,0,0);p1=__builtin_amdgcn_mfma_f32_32x32x16_bf16(b1,qr[0],negm,0,0,0);}
    else{p0=__builtin_amdgcn_mfma_f32_32x32x16_bf16(b0,qr[d0],p0,0,0,0);p1=__builtin_amdgcn_mfma_f32_32x32x16_bf16(b1,qr[d0],p1,0,0,0);}}
}
typedef __attribute__((address_space(3))) const char* lds_cptr;
typedef short v4i16_t __attribute__((ext_vector_type(4)));
__device__ __forceinline__ void kload8(bf16x8*kf,lds_cptr kp){
  kf[0]=*(const __attribute__((address_space(3))) bf16x8*)(kp);      kf[1]=*(const __attribute__((address_space(3))) bf16x8*)(kp+512);
  kf[2]=*(const __attribute__((address_space(3))) bf16x8*)(kp+2048); kf[3]=*(const __attribute__((address_space(3))) bf16x8*)(kp+2560);
  kf[4]=*(const __attribute__((address_space(3))) bf16x8*)(kp+4096); kf[5]=*(const __attribute__((address_space(3))) bf16x8*)(kp+4608);
  kf[6]=*(const __attribute__((address_space(3))) bf16x8*)(kp+6144); kf[7]=*(const __attribute__((address_space(3))) bf16x8*)(kp+6656);
}
__device__ __forceinline__ void kload2(bf16x8*kf,lds_cptr kp,int j){ kf[2*j]=*(const __attribute__((address_space(3))) bf16x8*)(kp+j*2048); kf[2*j+1]=*(const __attribute__((address_space(3))) bf16x8*)(kp+j*2048+512); }
__device__ __forceinline__ s16x4 vtr(lds_cptr p){ return __builtin_bit_cast(s16x4,__builtin_amdgcn_ds_read_tr16_b64_v4i16((__attribute__((address_space(3))) v4i16_t*)p)); }
__device__ __forceinline__ float rowmax(const f32x16&p0,const f32x16&p1){
  float a=max3f(p0[0],p0[1],p1[0]),b=max3f(p0[2],p0[3],p1[1]);a=max3f(a,p1[2],p1[3]);
  #pragma unroll
  for(int r=4;r<16;r+=4){a=max3f(a,p0[r],p0[r+1]);b=max3f(b,p0[r+2],p0[r+3]);a=max3f(a,p1[r],p1[r+1]);b=max3f(b,p1[r+2],p1[r+3]);}
  const float m=max2f(a,b);
  auto rr=__builtin_amdgcn_permlane32_swap(__float_as_uint(m),__float_as_uint(m),false,false);
  return max2f(__uint_as_float(rr[0]),__uint_as_float(rr[1]));
}
__device__ __forceinline__ void pv(f32x16*o,int vb,bf16x8 pa0,bf16x8 pa1,bf16x8 pa2,bf16x8 pa3){
  #pragma unroll
  for(int d0=0;d0<2;++d0){s16x4 lo[4],hi[4];
    #pragma unroll
    for(int ks=0;ks<4;++ks){
      asm volatile("ds_read_b64_tr_b16 %0,%1 offset:%c2":"=&v"(lo[ks]):"v"(vb),"i"(d0*4096+ks*1024):"memory");
      asm volatile("ds_read_b64_tr_b16 %0,%1 offset:%c2":"=&v"(hi[ks]):"v"(vb),"i"(d0*4096+ks*1024+512):"memory");}
    asm volatile("s_waitcnt lgkmcnt(0)":::"memory");SBAR();
    #define PK(k) (bf16x8){lo[k][0],lo[k][1],lo[k][2],lo[k][3],hi[k][0],hi[k][1],hi[k][2],hi[k][3]}
    o[d0]=__builtin_amdgcn_mfma_f32_32x32x16_bf16(pa0,PK(0),o[d0],0,0,0);
    o[d0]=__builtin_amdgcn_mfma_f32_32x32x16_bf16(pa1,PK(1),o[d0],0,0,0);
    o[d0]=__builtin_amdgcn_mfma_f32_32x32x16_bf16(pa2,PK(2),o[d0],0,0,0);
    o[d0]=__builtin_amdgcn_mfma_f32_32x32x16_bf16(pa3,PK(3),o[d0],0,0,0);
    #undef PK
  }
}

#ifndef ATTN_STORE16
#define ATTN_STORE16(p,v) (*(u32x4*)(p)=(v))
#endif
template<int THRL> __device__ __forceinline__ void attn_unit(const bf16*Qw0,const bf16*__restrict__ Kh,const bf16*__restrict__ Vh,bf16*Ow0,char*shm,const float negM){
  const int tid=threadIdx.x,lane=tid&63,r32=lane&31,hi=lane>>5; const int wid=__builtin_amdgcn_readfirstlane(tid>>6);
  const bf16*Qw=Qw0+(long)(wid*QBLK)*QP;
  const unsigned lds0=(unsigned)(uintptr_t)shm;
  float*wsf=(float*)(shm+LDS_WS)+wid*64;
  const bf16*ksrc=Kh+(long)lane*QP+wid*8;
  const bf16*vsrc=Vh+(long)(16*(wid&3)+(lane>>2))*QP+(wid>>2)*32+(lane&3)*8;
  const unsigned kdst=lds0+LDS_K+wid*1024, vdst=lds0+LDS_V+wid*1024;
  #define DMA_K(t,slot) glds16(ksrc+(long)(t)*KVBLK*QP,(unsigned)__builtin_amdgcn_readfirstlane(kdst+(slot)))
  #define DMA_V(t,slot) glds16(vsrc+(long)(t)*KVBLK*QP,(unsigned)__builtin_amdgcn_readfirstlane(vdst+(slot)))
  const int vb0=(int)(lds0+LDS_V)+((lane>>4)&1)*32+(lane&3)*8+(4*hi+((lane&15)>>2))*64;
  const char*Kbase=shm+LDS_K; bf16x8 kf[8];
  const lds_cptr shm3=(lds_cptr)shm; const lds_cptr kp0=shm3+LDS_K+hi*1024+r32*16; const lds_cptr vp0=shm3+LDS_V+((lane>>4)&1)*32+(lane&3)*8+(4*hi+((lane&15)>>2))*64;
  DMA_K(0,0);DMA_V(0,0);DMA_K(1,SLOTB);
  bf16x8 qr[4];
  #pragma unroll
  for(int d0=0;d0<4;++d0)qr[d0]=*reinterpret_cast<const bf16x8*>(&Qw[(long)r32*QP+d0*16+hi*8]);
  f32x16 o[2];o[0]=f32x16{};o[1]=f32x16{};f32x16 lacc=f32x16{};const f32x16 negm=f32x16{};(void)negM;
  bf16x8 ones={(short)0x3F80,(short)0x3F80,(short)0x3F80,(short)0x3F80,(short)0x3F80,(short)0x3F80,(short)0x3F80,(short)0x3F80}; asm volatile("":"+v"(ones));
  #define CMASK(P0,P1,t) do{ if((t)==NT-1)tmask(P0,P1); }while(0)
  #define START(P0,P1) do{ _Pragma("unroll") for(int r=0;r<16;++r)P0[r]=__builtin_amdgcn_exp2f(P0[r]); }while(0)
  #define RESC() do{}while(0)
  f32x16 pA0,pA1,pB0,pB1;
  int sl_prev=0,sl_cur=0,sl_next=SLOTB;
  #define ROT() do{sl_prev=sl_cur;sl_cur=sl_next;sl_next=(sl_next==(NSLOT-1)*SLOTB)?0:sl_next+SLOTB;}while(0)
  DMA_K(2,2*SLOTB);
  WAIT_BAR(3);
  qkt(pA0,pA1,Kbase,qr,negm,r32,hi);asm volatile("s_nop 15\n\ts_nop 7":"+v"(pA0),"+v"(pA1));CMASK(pA0,pA1,0);
  START(pA0,pA1);
  _Pragma("unroll") for(int r=0;r<16;++r)pA1[r]=__builtin_amdgcn_exp2f(pA1[r]);
  WAIT_BAR(0);
  DMA_K(3,0);DMA_V(1,SLOTB);
  ROT();
  kload8(kf,kp0+sl_cur);
  WAIT_BAR(2);
  s16x4 vlo[8],vhi[8]; u32x4 pw0,pw1,pw2,pw3;
  #define PKW(P,B) cvtpk_s(P[B],P[B+1])
  #define PAF(k) __builtin_bit_cast(bf16x8,pw##k)
  #define VFR(i) (bf16x8){vlo[i][0],vlo[i][1],vlo[i][2],vlo[i][3],vhi[i][0],vhi[i][1],vhi[i][2],vhi[i][3]}
  #define PIN(x) asm volatile("":"+v"(x))
  #define MX3(a,b,c) __builtin_fmaxf(__builtin_fmaxf((a),(b)),(c))
  #define GAPA(MF,W0,W1,PW) do{ MF; W0; W1; PIN(PW); SBAR(); }while(0)
  #define EX(v) __builtin_amdgcn_exp2f(v)
  #define GAPB3(MF,X,B) do{ MF; X[B]=EX(X[B]); X[B+1]=EX(X[B+1]); X[B+2]=EX(X[B+2]); PIN(X); SBAR(); }while(0)
  #define GAPB2(MF,X,B) do{ MF; X[B]=EX(X[B]); X[B+1]=EX(X[B+1]); PIN(X); SBAR(); }while(0)
  #define LSUM(k) lacc=__builtin_amdgcn_mfma_f32_32x32x16_bf16(PAF(k),ones,lacc,0,0,0)
  #define VRD(i) do{ vlo[i]=vtr(vp_+(((i)>>2)*4096+((i)&3)*1024)); vhi[i]=vtr(vp_+(((i)>>2)*4096+((i)&3)*1024+512)); }while(0)
  #define KRD(G,j) do{ if(G){ kload2(kf,kp0+sl_next,j); SBAR(); } }while(0)
  #define STEP(C0,C1,P0,P1,t,GK,GV,GL) do{ SBAR(); \
    const lds_cptr vp_=vp0+sl_prev; \
    VRD(0); SBAR(); \
    GAPA(C0=__builtin_amdgcn_mfma_f32_32x32x16_bf16(kf[0],qr[0],negm,0,0,0), pw0[0]=PKW(P0,0), pw0[1]=PKW(P0,2), pw0); \
    VRD(4); SBAR(); GAPA(C1=__builtin_amdgcn_mfma_f32_32x32x16_bf16(kf[1],qr[0],negm,0,0,0), pw0[2]=PKW(P0,4), pw0[3]=PKW(P0,6), pw0); \
    VRD(1); SBAR(); GAPA(C0=__builtin_amdgcn_mfma_f32_32x32x16_bf16(kf[2],qr[1],C0,0,0,0),   pw1[0]=PKW(P0,8), pw1[1]=PKW(P0,10), pw1); \
    VRD(5); SBAR(); GAPA(C1=__builtin_amdgcn_mfma_f32_32x32x16_bf16(kf[3],qr[1],C1,0,0,0),   pw1[2]=PKW(P0,12),pw1[3]=PKW(P0,14), pw1); \
    VRD(2); SBAR(); GAPA(C0=__builtin_amdgcn_mfma_f32_32x32x16_bf16(kf[4],qr[2],C0,0,0,0),   pw2[0]=PKW(P1,0), pw2[1]=PKW(P1,2), pw2); \
    VRD(6); SBAR(); GAPA(C1=__builtin_amdgcn_mfma_f32_32x32x16_bf16(kf[5],qr[2],C1,0,0,0),   pw2[2]=PKW(P1,4), pw2[3]=PKW(P1,6), pw2); \
    VRD(3); SBAR(); GAPA(C0=__builtin_amdgcn_mfma_f32_32x32x16_bf16(kf[6],qr[3],C0,0,0,0),   pw3[0]=PKW(P1,8), pw3[1]=PKW(P1,10), pw3); \
    VRD(7); SBAR(); GAPA(C1=__builtin_amdgcn_mfma_f32_32x32x16_bf16(kf[7],qr[3],C1,0,0,0),   pw3[2]=PKW(P1,12),pw3[3]=PKW(P1,14), pw3); \
    if(GK){DMA_K((t)+3,sl_cur);} if(GV){DMA_V((t)+1,sl_next);} \
    CMASK(C0,C1,t); \
    SBAR(); \
    GAPB3(o[0]=__builtin_amdgcn_mfma_f32_32x32x16_bf16(PAF(0),VFR(0),o[0],0,0,0), C0,0); \
    GAPB3(o[1]=__builtin_amdgcn_mfma_f32_32x32x16_bf16(PAF(0),VFR(4),o[1],0,0,0), C0,3); \
    GAPB2(LSUM(0), C0,6); \
    KRD(GL,0); GAPB3(o[0]=__builtin_amdgcn_mfma_f32_32x32x16_bf16(PAF(1),VFR(1),o[0],0,0,0), C0,8); \
    KRD(GL,1); GAPB3(o[1]=__builtin_amdgcn_mfma_f32_32x32x16_bf16(PAF(1),VFR(5),o[1],0,0,0), C0,11); \
    GAPB2(LSUM(1), C0,14); \
    KRD(GL,2); GAPB3(o[0]=__builtin_amdgcn_mfma_f32_32x32x16_bf16(PAF(2),VFR(2),o[0],0,0,0), C1,0); \
    KRD(GL,3); GAPB3(o[1]=__builtin_amdgcn_mfma_f32_32x32x16_bf16(PAF(2),VFR(6),o[1],0,0,0), C1,3); \
    GAPB2(LSUM(2), C1,6); \
    GAPB3(o[0]=__builtin_amdgcn_mfma_f32_32x32x16_bf16(PAF(3),VFR(3),o[0],0,0,0), C1,8); \
    GAPB3(o[1]=__builtin_amdgcn_mfma_f32_32x32x16_bf16(PAF(3),VFR(7),o[1],0,0,0), C1,11); \
    GAPB2(LSUM(3), C1,14); \
    }while(0)
  int t=1;
  #define ENDW(tt) do{ if((tt)+3<NT){WAIT_BAR(2);} else if((tt)+2<NT){WAIT_BAR(1);} else {WAIT_BAR(0);} }while(0)
  #undef CMASK
  #define CMASK(P0,P1,t) do{}while(0)
  for(;t+4<NT;t+=2){
    STEP(pB0,pB1,pA0,pA1,t,true,true,true);     WAIT_BAR(2); RESC(); ROT();
    STEP(pA0,pA1,pB0,pB1,t+1,true,true,true);   WAIT_BAR(2); RESC(); ROT();
  }
  for(;t+2<NT;t+=2){
    STEP(pB0,pB1,pA0,pA1,t,(t+3<NT),(t+1<NT),(t+1<NT));       ENDW(t);   RESC(); ROT();
    STEP(pA0,pA1,pB0,pB1,t+1,(t+4<NT),(t+2<NT),(t+2<NT));     ENDW(t+1); RESC(); ROT();
  }
  STEP(pB0,pB1,pA0,pA1,NT-2,false,true,true); WAIT_BAR(0); RESC(); ROT();
  #undef CMASK
  #define CMASK(P0,P1,t) tmask(P0,P1)
  STEP(pA0,pA1,pB0,pB1,NT-1,false,false,false); RESC();
  { pw0=(u32x4){PKW(pA0,0),PKW(pA0,2),PKW(pA0,4),PKW(pA0,6)};pw1=(u32x4){PKW(pA0,8),PKW(pA0,10),PKW(pA0,12),PKW(pA0,14)};pw2=(u32x4){PKW(pA1,0),PKW(pA1,2),PKW(pA1,4),PKW(pA1,6)};pw3=(u32x4){PKW(pA1,8),PKW(pA1,10),PKW(pA1,12),PKW(pA1,14)};
    SBAR(); pv(o,vb0+sl_cur,PAF(0),PAF(1),PAF(2),PAF(3)); LSUM(0); LSUM(1); LSUM(2); LSUM(3); }
  #undef PKW
  #undef PAF
  #undef VFR
  #undef PIN
  #undef MX3
  #undef GAPA
  #undef GAPB3
  #undef GAPB2
  #undef LSUM
  #undef EX
  #undef VRD
  #undef KRD
  #undef STEP
  #undef ENDW
  float rli[16];
  #pragma unroll
  for(int r=0;r<16;++r)rli[r]=__builtin_amdgcn_rcpf(lacc[r]);
  bf16*Ow=Ow0+(long)(wid*QBLK)*OP;
  { bf16*stg=(bf16*)(shm+LDS_OST)+wid*2048;
    #pragma unroll
    for(int r=0;r<16;++r){const int orow=crow(r,hi);
      #pragma unroll
      for(int d0=0;d0<2;++d0)stg[orow*64+d0*32+r32]=__float2bfloat16(o[d0][r]*rli[r]);}
    asm volatile("s_waitcnt lgkmcnt(0)":::"memory");
    #pragma unroll
    for(int i=0;i<4;++i){const int row=i*8+(lane>>3),ch=lane&7; const u32x4 v=*(const u32x4*)(stg+row*64+ch*8); ATTN_STORE16(Ow+(long)row*OP+ch*8,v);} }
  asm volatile("s_waitcnt lgkmcnt(0)\n\ts_barrier":::"memory");
  #undef DMA_K
  #undef DMA_V
  #undef CMASK
  #undef START
  #undef RESC
  #undef ROT
}
constexpr int ATTN_LDS_BYTES=LDS_BYTES;
#undef SBAR
#undef WAIT_BAR
}

#ifndef MK_N_LAUNCHES
#define MK_N_LAUNCHES 1
#endif
constexpr int NWAVES = 8, NPHASE = 9;
constexpr int DM = 1024, NSEQ = 12, SEQ = 8192, NMETA = 16, LSEQ = SEQ + NMETA;
constexpr int TNAT = NSEQ * LSEQ, MP = 98560, MC = NSEQ * SEQ;
constexpr int INW = 1792, FFH = 2816, LRUW = 512;
constexpr int COL_K = 512, COL_V = 640, COL_LIN = 768, COL_LG = 1280;
constexpr int CT = 32, NCH = 257, NLU = NSEQ * NCH;
constexpr float QSCALE = 0.125f * 1.4426950408889634f;
constexpr size_t MiB = 1u << 20;
constexpr size_t WS_WIN = 2 * MiB, WS_WOUT = 6 * MiB, WS_WGU = 8 * MiB, WS_WDN = 20 * MiB, WS_WLRU = 26 * MiB, WS_NL = 26 * MiB + 512 * 1024;
constexpr size_t WS_COS = 27 * MiB, WS_SIN = 28 * MiB, WS_NEGM = 29 * MiB;
constexpr size_t WS_AGG = 32 * MiB, WS_CARRY = 60 * MiB, WS_SSQ1 = 74 * MiB, WS_SSQ2 = 82 * MiB;
constexpr size_t WS_XN = 96 * MiB;
constexpr size_t WS_PROJ = 300 * MiB;
constexpr size_t WS_HID = 96 * MiB;
constexpr size_t WS_H1B = 656 * MiB;
constexpr size_t WS_END = 860 * MiB;
static_assert(WS_AGG + (size_t)NLU * 2048 * 4 <= WS_CARRY && WS_CARRY + (size_t)NLU * 1024 * 4 <= WS_SSQ1 && WS_SSQ1 + (size_t)MC * 64 <= WS_SSQ2 && WS_SSQ2 + (size_t)MC * 64 <= WS_XN, "ws map 1");
static_assert(WS_XN + (size_t)MP * 1024 * 2 <= WS_PROJ && WS_PROJ + (size_t)MP * INW * 2 <= WS_H1B && WS_HID + (size_t)MC * FFH * 2 <= WS_H1B && WS_H1B + (size_t)MC * 1024 * 2 <= WS_END, "ws map 2");
constexpr int LDS_BYTES = 147456;

#define GAS __attribute__((address_space(1)))
#define LAS __attribute__((address_space(3)))
typedef unsigned short bf16;
typedef unsigned v4u __attribute__((ext_vector_type(4)));
typedef unsigned v2u __attribute__((ext_vector_type(2)));
typedef float f32x4 __attribute__((ext_vector_type(4)));
typedef short bf16x8 __attribute__((ext_vector_type(8)));
using pg8::pkbf;
__device__ __forceinline__ float bflo(unsigned w) { return __uint_as_float(w << 16); }
__device__ __forceinline__ float bfhi(unsigned w) { return __uint_as_float(w & 0xffff0000u); }
__device__ __forceinline__ float wave_sum(float v) {
#pragma unroll
    for (int o = 1; o < 64; o <<= 1) v += __shfl_xor(v, o);
    return v;
}
template <int CTRL> __device__ __forceinline__ float dppf(float old, float v) { return __builtin_bit_cast(float, __builtin_amdgcn_update_dpp(__builtin_bit_cast(int, old), __builtin_bit_cast(int, v), CTRL, 0xf, 0xf, false)); }
__device__ __forceinline__ void scan_fwd16(float& A, float& B) {
#define SF(S) { const float Ap = dppf<0x110 + S>(1.f, A), Bp = dppf<0x110 + S>(0.f, B); B = fmaf(A, Bp, B); A = A * Ap; }
    SF(1) SF(2) SF(4) SF(8)
#undef SF
}
__device__ __forceinline__ void scan_bwd16(float& A, float& B) {
#define SB(S) { const float Ap = dppf<0x100 + S>(1.f, A), Bp = dppf<0x100 + S>(0.f, B); B = fmaf(A, Bp, B); A = A * Ap; }
    SB(1) SB(2) SB(4) SB(8)
#undef SB
}

struct Args {
    const float *x_prompt, *x_sample, *meta, *norm_mix_g, *w_in, *q_norm_g, *k_norm_g, *conv_w, *conv_b, *lru_w_a, *lru_b_a, *lru_w_x, *lru_b_x, *lru_lam,
                *attn_out_g, *lru_out_g, *w_out, *norm_ffn_g, *w_gate_up, *w_down, *final_norm_g;
    float* out; unsigned char* ws; int ph_lo, ph_hi;
};

__device__ __forceinline__ void p0_transpose_item(const float* W, int K, int N, bf16* WT, int mode, const float* kscale, LAS float* scr, int item, int lane) {
    const int nblk = N / 32, kb = item / nblk, nb = item % nblk, k0 = 64 * kb, n0 = 32 * nb;
#pragma unroll 8
    for (int i = 0; i < 32; ++i) { const int kk = 2 * i + (lane >> 5); float v = W[(size_t)(k0 + kk) * N + n0 + (lane & 31)]; if (kscale) v *= kscale[k0 + kk]; scr[kk * 33 + (lane & 31)] = v; }
    asm volatile("s_waitcnt lgkmcnt(0)" ::: "memory");
    int rbase = n0;
    if (mode == 1) { if (n0 < FFH) rbase = (n0 / 128) * 256 + (n0 % 128); else { const int j = n0 - FFH; rbase = (j / 128) * 256 + 128 + (j % 128); } }
    const int c = lane & 7;
#pragma unroll
    for (int j = 0; j < 4; ++j) { const int n = (lane >> 3) + 8 * j; const LAS float* s = scr + (8 * c) * 33 + n;
        v4u o; o.x = pkbf(s[0 * 33], s[1 * 33]); o.y = pkbf(s[2 * 33], s[3 * 33]); o.z = pkbf(s[4 * 33], s[5 * 33]); o.w = pkbf(s[6 * 33], s[7 * 33]);
        *(GAS v4u*)(WT + (size_t)(rbase + n) * K + k0 + 8 * c) = o; }
    asm volatile("s_waitcnt lgkmcnt(0)" ::: "memory");
}

__device__ __forceinline__ void phase0(const Args& a, LAS unsigned char* lds, int vcu, int G, int wave, int lane, int tid) {
    unsigned char* ws = a.ws;
    LAS float* scr = (LAS float*)(lds + wave * 16384);
    const int gw = vcu * NWAVES + wave, NGW = G * NWAVES;
    constexpr int I_IN = (DM / 64) * (INW / 32), I_OUT = (DM / 64) * (DM / 32), I_GU = (DM / 64) * (2 * FFH / 32), I_DN = (FFH / 64) * (DM / 32);
    constexpr int NITEMS = I_IN + I_OUT + I_GU + I_DN;
    for (int it = gw; it < NITEMS; it += NGW) {
        int r = it;
        if (r < I_IN) { p0_transpose_item(a.w_in, DM, INW, (bf16*)(ws + WS_WIN), 0, nullptr, scr, r, lane); continue; } r -= I_IN;
        if (r < I_OUT) { p0_transpose_item(a.w_out, DM, DM, (bf16*)(ws + WS_WOUT), 0, nullptr, scr, r, lane); continue; } r -= I_OUT;
        if (r < I_GU) { p0_transpose_item(a.w_gate_up, DM, 2 * FFH, (bf16*)(ws + WS_WGU), 1, a.norm_ffn_g, scr, r, lane); continue; } r -= I_GU;
        p0_transpose_item(a.w_down, FFH, DM, (bf16*)(ws + WS_WDN), 0, nullptr, scr, r, lane);
    }
    const int gt = vcu * (NWAVES * 64) + tid, NGT = G * NWAVES * 64;
    { bf16* Wl = (bf16*)(ws + WS_WLRU);
      for (int e = gt; e < 8 * 256 * 64; e += NGT) { const int h = e >> 14, o = (e >> 6) & 255, i = e & 63, g4 = o >> 6, j = o & 63, d = g4 >> 1;
          const float* src = (g4 & 1) ? a.lru_w_x : a.lru_w_a; Wl[e] = (bf16)(pkbf(src[((size_t)(d * 8 + h) * 64 + i) * 64 + j], 0.f) & 0xffffu); } }
    if (gt == 0) { float mq = 0.f, mk = 0.f; for (int e = 0; e < 64; ++e) { mq = fmaxf(mq, fabsf(a.q_norm_g[e])); mk = fmaxf(mk, fabsf(a.k_norm_g[e])); }
        *(float*)(ws + WS_NEGM) = -(8.0f * 1.4426950408889634f * mq * mk * 1.02f + 0.5f); }
    { float* nl = (float*)(ws + WS_NL); for (int e = gt; e < 2 * LRUW; e += NGT) nl[e] = -8.0f * log1pf(expf(-a.lru_lam[e])); }
    { float* ct = (float*)(ws + WS_COS); float* st = (float*)(ws + WS_SIN);
      for (int e = gt; e < SEQ * 32; e += NGT) { const int t = e >> 5, k = e & 31, pos = (k < 16) ? (t >> 6) : (t & 63), i = k & 15;
          const float freq = __builtin_amdgcn_exp2f(-(float)i * (13.287712379549449f / 16.0f));
          const float rev = (float)pos * freq * 0.15915494309189535f; const float fr = rev - rintf(rev);
          ct[e] = __builtin_amdgcn_cosf(fr); st[e] = __builtin_amdgcn_sinf(fr); } }
    { bf16* XN = (bf16*)(ws + WS_XN);
      f32x4 g4[4];
#pragma unroll
      for (int j = 0; j < 4; ++j) g4[j] = *((const f32x4*)a.norm_mix_g + lane + 64 * j);
      for (int r = gw; r < MP; r += NGW) {
          GAS unsigned long long* o8 = (GAS unsigned long long*)(XN + (size_t)r * DM) + lane;
          if (r >= TNAT) {
#pragma unroll
              for (int j = 0; j < 4; ++j) o8[64 * j] = 0ull;
              continue; }
          const int b = r / LSEQ, p = r - b * LSEQ;
          const float* src = (p < NMETA) ? a.meta + (size_t)p * DM : (b < 8 ? a.x_prompt + ((size_t)b * SEQ + (p - NMETA)) * DM : a.x_sample + ((size_t)(b - 8) * SEQ + (p - NMETA)) * DM);
          const f32x4* xr = (const f32x4*)src + lane; f32x4 v[4]; float s = 0.f;
#pragma unroll
          for (int j = 0; j < 4; ++j) { v[j] = xr[64 * j]; s += (v[j][0] * v[j][0] + v[j][1] * v[j][1]) + (v[j][2] * v[j][2] + v[j][3] * v[j][3]); }
          const float rstd = __builtin_amdgcn_rsqf(wave_sum(s) * (1.0f / DM) + 1e-6f);
#pragma unroll
          for (int j = 0; j < 4; ++j) { const f32x4 y = v[j] * rstd * g4[j]; o8[64 * j] = (unsigned long long)pkbf(y[0], y[1]) | ((unsigned long long)pkbf(y[2], y[3]) << 32); }
      } }
}

__device__ __forceinline__ void phase_qk(const Args& a, int vcu, int G, int wave, int lane) {
    bf16* proj = (bf16*)(a.ws + WS_PROJ); const float* ct = (const float*)(a.ws + WS_COS); const float* st = (const float*)(a.ws + WS_SIN);
    const int gw = vcu * NWAVES + wave, NGW = G * NWAVES; const int sub = lane >> 3, j = lane & 7;
    constexpr int NGRP = TNAT * 10 / 8;
    for (int grp = gw; grp < NGRP; grp += NGW) {
        const int item = grp * 8 + sub, row = item / 10, hh = item - row * 10;
        bf16* ptr = proj + (size_t)row * INW + hh * 64 + j * 8;
        const v4u raw = *(const v4u*)ptr;
        float x[8] = {bflo(raw.x), bfhi(raw.x), bflo(raw.y), bfhi(raw.y), bflo(raw.z), bfhi(raw.z), bflo(raw.w), bfhi(raw.w)};
        float ss = 0.f;
#pragma unroll
        for (int e = 0; e < 8; ++e) ss += x[e] * x[e];
        ss += __shfl_xor(ss, 1); ss += __shfl_xor(ss, 2); ss += __shfl_xor(ss, 4);
        const float rstd = __builtin_amdgcn_rsqf(ss * (1.0f / 64.0f) + 1e-6f);
        const float* gp = (hh < 8 ? a.q_norm_g : a.k_norm_g) + j * 8;
        const f32x4 g0 = *(const f32x4*)gp, g1 = *(const f32x4*)(gp + 4);
        float y[8];
#pragma unroll
        for (int e = 0; e < 8; ++e) y[e] = x[e] * rstd * (e < 4 ? g0[e] : g1[e - 4]);
        const int b = row / LSEQ, p = row - b * LSEQ;
        float c[8], s[8];
        if (p >= NMETA) { const int toff = (p - NMETA) * 32 + (j >> 2) * 16 + (j & 1) * 8;
            const f32x4 c0 = *(const f32x4*)(ct + toff), c1 = *(const f32x4*)(ct + toff + 4), s0 = *(const f32x4*)(st + toff), s1 = *(const f32x4*)(st + toff + 4);
#pragma unroll
            for (int e = 0; e < 4; ++e) { c[e] = c0[e]; c[e + 4] = c1[e]; s[e] = s0[e]; s[e + 4] = s1[e]; }
        } else {
#pragma unroll
            for (int e = 0; e < 8; ++e) { c[e] = 1.f; s[e] = 0.f; } }
        const float sgn = (j & 2) ? 1.f : -1.f, sc = (hh < 8) ? QSCALE : 1.f;
        float o[8];
#pragma unroll
        for (int e = 0; e < 8; ++e) { const float py = __shfl_xor(y[e], 2); o[e] = (y[e] * c[e] + sgn * py * s[e]) * sc; }
        v4u w; w.x = pkbf(o[0], o[1]); w.y = pkbf(o[2], o[3]); w.z = pkbf(o[4], o[5]); w.w = pkbf(o[6], o[7]);
        *(v4u*)ptr = w;
    }
}

constexpr int CB_ROW = 144, CB_WAVE = CT * CB_ROW, LRU_CB = 0, LRU_Y = NWAVES * CB_WAVE, Y_ROW = 2064, LRU_PART = LRU_Y + CT * Y_ROW, LRU_CONST = LRU_PART + CT * 8 * 4;
static_assert(LRU_CONST + 6 * 512 * 4 <= 131072, "lru lds");
#define LRU_LOADW(dst, cgi_) do { _Pragma("unroll") for (int g4 = 0; g4 < 4; ++g4) _Pragma("unroll") for (int ks = 0; ks < 2; ++ks) \
    dst[g4][ks] = *(const bf16x8*)(Wl + (size_t)(g4 * 64 + (cgi_) * 16 + fr) * 64 + ks * 32 + 8 * fq); } while (0)
template <bool FINAL> __device__ __forceinline__ void lru_phase(const Args& a, LAS unsigned char* lds, int bx, int G, int wave, int lane, int tid) {
    const bf16* proj = (const bf16*)(a.ws + WS_PROJ);
    const int fr = lane & 15, fq = lane >> 4;
    constexpr float L2E = 1.4426950408889634f;
    { LAS float* cst = (LAS float*)(lds + LRU_CONST); const float* nl = (const float*)(a.ws + WS_NL); const int e = tid;
      cst[0 * 512 + e] = -a.lru_b_a[e] * L2E; cst[1 * 512 + e] = -a.lru_b_x[e] * L2E; cst[2 * 512 + e] = -a.lru_b_a[LRUW + e] * L2E; cst[3 * 512 + e] = -a.lru_b_x[LRUW + e] * L2E;
      cst[4 * 512 + e] = nl[e] * L2E; cst[5 * 512 + e] = nl[LRUW + e] * L2E; }
    __syncthreads();
    LAS unsigned char* cb = lds + LRU_CB + wave * CB_WAVE;
    const bf16* Wl = (const bf16*)(a.ws + WS_WLRU) + (size_t)wave * 256 * 64;
    bf16x8 wcur[4][2];
    LRU_LOADW(wcur, 0);
    for (int unit = bx; unit < NLU; unit += G) {
        const int b = unit / NCH, ci = unit - b * NCH, p0 = ci * CT; const size_t rowbase = (size_t)b * LSEQ;
        const bool lastc = (ci == NCH - 1);
        { const int j8 = lane & 7, ch = 64 * wave + 8 * j8;
          v4u raw[4][4];
#pragma unroll
          for (int stp = 0; stp < 4; ++stp)
#pragma unroll
              for (int jj = 0; jj < 4; ++jj) { const int pp = p0 + stp * 8 + (lane >> 3) + jj - 2;
                  raw[stp][jj] = (pp >= 0 && pp < LSEQ) ? *(const v4u*)(proj + (rowbase + pp) * INW + COL_LIN + ch) : (v4u){0u, 0u, 0u, 0u}; }
          float cw[4][8], cbias[8];
#pragma unroll
          for (int jj = 0; jj < 4; ++jj) { const f32x4 w0 = *(const f32x4*)(a.conv_w + jj * LRUW + ch), w1 = *(const f32x4*)(a.conv_w + jj * LRUW + ch + 4);
#pragma unroll
              for (int e = 0; e < 4; ++e) { cw[jj][e] = w0[e]; cw[jj][e + 4] = w1[e]; } }
          { const f32x4 b0 = *(const f32x4*)(a.conv_b + ch), b1 = *(const f32x4*)(a.conv_b + ch + 4);
#pragma unroll
            for (int e = 0; e < 4; ++e) { cbias[e] = b0[e]; cbias[e + 4] = b1[e]; } }
#pragma unroll
          for (int stp = 0; stp < 4; ++stp) { const int tok = stp * 8 + (lane >> 3);
              float acc[8];
#pragma unroll
              for (int e = 0; e < 8; ++e) acc[e] = cbias[e];
#pragma unroll
              for (int jj = 0; jj < 4; ++jj) { const v4u r = raw[stp][jj];
                  acc[0] += cw[jj][0] * bflo(r.x); acc[1] += cw[jj][1] * bfhi(r.x); acc[2] += cw[jj][2] * bflo(r.y); acc[3] += cw[jj][3] * bfhi(r.y);
                  acc[4] += cw[jj][4] * bflo(r.z); acc[5] += cw[jj][5] * bfhi(r.z); acc[6] += cw[jj][6] * bflo(r.w); acc[7] += cw[jj][7] * bfhi(r.w); }
              v4u w; w.x = pkbf(acc[0], acc[1]); w.y = pkbf(acc[2], acc[3]); w.z = pkbf(acc[4], acc[5]); w.w = pkbf(acc[6], acc[7]);
              *(LAS v4u*)(cb + tok * CB_ROW + j8 * 16) = w; }
        }
        asm volatile("s_waitcnt lgkmcnt(0)" ::: "memory");
        float ssq[2] = {0.f, 0.f};
#pragma unroll 1
        for (int cgi = 0; cgi < 4; ++cgi) {
            const int chl = cgi * 16 + 4 * fq, ch = 64 * wave + chl;
            bf16x8 wnxt[4][2];
            LRU_LOADW(wnxt, (cgi + 1) & 3);
            f32x4 cf, cbk; v2u graw[2];
            if constexpr (FINAL) { const float* carry = (const float*)(a.ws + WS_CARRY) + (size_t)unit * 1024; cf = *(const f32x4*)(carry + ch); cbk = *(const f32x4*)(carry + LRUW + ch);
#pragma unroll
                for (int tt = 0; tt < 2; ++tt) { const int p = p0 + tt * 16 + fr; graw[tt] = (p < LSEQ) ? *(const v2u*)(proj + (rowbase + p) * INW + COL_LG + ch) : (v2u){0u, 0u}; } }
            const LAS float* cst = (const LAS float*)(lds + LRU_CONST) + ch;
            const f32x4 baf = *(const LAS f32x4*)(cst), bxf = *(const LAS f32x4*)(cst + 512), bab = *(const LAS f32x4*)(cst + 1024), bxb = *(const LAS f32x4*)(cst + 1536), nlf = *(const LAS f32x4*)(cst + 2048), nlb = *(const LAS f32x4*)(cst + 2560);
            float AF[2][4], UF[2][4], AB[2][4], UB[2][4];
#pragma unroll
            for (int tt = 0; tt < 2; ++tt) {
                const LAS unsigned char* crow = cb + (tt * 16 + fr) * CB_ROW;
                const bf16x8 b0 = *(const LAS bf16x8*)(crow + fq * 16), b1 = *(const LAS bf16x8*)(crow + 64 + fq * 16);
                f32x4 pre[4];
#pragma unroll
                for (int g4 = 0; g4 < 4; ++g4) { pre[g4] = __builtin_amdgcn_mfma_f32_16x16x32_bf16(wcur[g4][0], b0, (f32x4){0.f, 0.f, 0.f, 0.f}, 0, 0, 0);
                    pre[g4] = __builtin_amdgcn_mfma_f32_16x16x32_bf16(wcur[g4][1], b1, pre[g4], 0, 0, 0); }
                const v2u craw = *(const LAS v2u*)(crow + chl * 2);
                const float cv[4] = {bflo(craw.x), bfhi(craw.x), bflo(craw.y), bfhi(craw.y)};
#pragma unroll
                for (int i = 0; i < 4; ++i) {
                    const float rf = __builtin_amdgcn_rcpf(1.0f + __builtin_amdgcn_exp2f(fmaf(pre[0][i], -L2E, baf[i])));
                    const float xf = __builtin_amdgcn_rcpf(1.0f + __builtin_amdgcn_exp2f(fmaf(pre[1][i], -L2E, bxf[i])));
                    const float rb = __builtin_amdgcn_rcpf(1.0f + __builtin_amdgcn_exp2f(fmaf(pre[2][i], -L2E, bab[i])));
                    const float xb = __builtin_amdgcn_rcpf(1.0f + __builtin_amdgcn_exp2f(fmaf(pre[3][i], -L2E, bxb[i])));
                    const float af = __builtin_amdgcn_exp2f(nlf[i] * rf), ab = __builtin_amdgcn_exp2f(nlb[i] * rb);
                    AF[tt][i] = af; AB[tt][i] = ab;
                    UF[tt][i] = __builtin_amdgcn_sqrtf(fmaf(-af, af, 1.0f)) * (xf * cv[i]); UB[tt][i] = __builtin_amdgcn_sqrtf(fmaf(-ab, ab, 1.0f)) * (xb * cv[i]);
                }
                if (lastc) { const bool valid = (p0 + tt * 16 + fr) < LSEQ;
#pragma unroll
                    for (int i = 0; i < 4; ++i) { AF[tt][i] = valid ? AF[tt][i] : 1.f; UF[tt][i] = valid ? UF[tt][i] : 0.f; AB[tt][i] = valid ? AB[tt][i] : 1.f; UB[tt][i] = valid ? UB[tt][i] : 0.f; } }
#pragma unroll
                for (int i = 0; i < 4; ++i) { scan_fwd16(AF[tt][i], UF[tt][i]); scan_bwd16(AB[tt][i], UB[tt][i]); }
            }
            if constexpr (!FINAL) {
                float* agg = (float*)(a.ws + WS_AGG) + (size_t)unit * 2048;
                if (fr == 15) { f32x4 A, B;
#pragma unroll
                    for (int i = 0; i < 4; ++i) { A[i] = AF[0][i] * AF[1][i]; B[i] = fmaf(AF[1][i], UF[0][i], UF[1][i]); }
                    *(f32x4*)(agg + ch) = A; *(f32x4*)(agg + 1024 + ch) = B; }
                if (fr == 0) { f32x4 A, B;
#pragma unroll
                    for (int i = 0; i < 4; ++i) { A[i] = AB[0][i] * AB[1][i]; B[i] = fmaf(AB[0][i], UB[1][i], UB[0][i]); }
                    *(f32x4*)(agg + LRUW + ch) = A; *(f32x4*)(agg + 1024 + LRUW + ch) = B; }
            } else {
                float hs[2][4];
#pragma unroll
                for (int i = 0; i < 4; ++i) {
                    const float hf0 = fmaf(AF[0][i], cf[i], UF[0][i]); const float c1 = __shfl(hf0, 15, 16); const float hf1 = fmaf(AF[1][i], c1, UF[1][i]);
                    const float hb1 = fmaf(AB[1][i], cbk[i], UB[1][i]); const float c0 = __shfl(hb1, 0, 16); const float hb0 = fmaf(AB[0][i], c0, UB[0][i]);
                    hs[0][i] = hf0 + hb0; hs[1][i] = hf1 + hb1; }
#pragma unroll
                for (int tt = 0; tt < 2; ++tt) { const int tok = tt * 16 + fr; f32x4 y;
                    const float gv[4] = {bflo(graw[tt].x), bfhi(graw[tt].x), bflo(graw[tt].y), bfhi(graw[tt].y)};
#pragma unroll
                    for (int i = 0; i < 4; ++i) { const float g = gv[i], z = (-1.5957691216057308f * L2E) * fmaf(0.044715f * g * g, g, g);
                        y[i] = hs[tt][i] * g * __builtin_amdgcn_rcpf(1.0f + __builtin_amdgcn_exp2f(z)); }
                    ssq[tt] += (y[0] * y[0] + y[1] * y[1]) + (y[2] * y[2] + y[3] * y[3]);
                    *(LAS f32x4*)(lds + LRU_Y + tok * Y_ROW + ch * 4) = y; }
            }
#pragma unroll
            for (int g4 = 0; g4 < 4; ++g4) { wcur[g4][0] = wnxt[g4][0]; wcur[g4][1] = wnxt[g4][1]; }
        }
        if constexpr (FINAL) {
#pragma unroll
            for (int tt = 0; tt < 2; ++tt) { float s = ssq[tt]; s += __shfl_xor(s, 16); s += __shfl_xor(s, 32); if (fq == 0) *(LAS float*)(lds + LRU_PART + ((tt * 16 + fr) * 8 + wave) * 4) = s; }
            __syncthreads();
            { const int tok = tid >> 4, seg = tid & 15, p = p0 + tok;
              if (p >= NMETA && p < LSEQ) {
                  const LAS f32x4* pp = (const LAS f32x4*)(lds + LRU_PART + tok * 32); const f32x4 s0 = pp[0], s1 = pp[1];
                  const float tot = ((s0[0] + s0[1]) + (s0[2] + s0[3])) + ((s1[0] + s1[1]) + (s1[2] + s1[3]));
                  const float rstd = __builtin_amdgcn_rsqf(tot * (1.0f / LRUW) + 1e-6f);
                  bf16* orow = (bf16*)(a.ws + WS_XN) + ((size_t)b * SEQ + (p - NMETA)) * DM + LRUW;
#pragma unroll
                  for (int k = 0; k < 4; ++k) { const int ch = k * 128 + seg * 8;
                      const LAS f32x4* yp = (const LAS f32x4*)(lds + LRU_Y + tok * Y_ROW + ch * 4); const f32x4 y0 = yp[0], y1 = yp[1];
                      const f32x4 g0 = *(const f32x4*)(a.lru_out_g + ch), g1 = *(const f32x4*)(a.lru_out_g + ch + 4);
                      v4u w; w.x = pkbf(y0[0] * rstd * g0[0], y0[1] * rstd * g0[1]); w.y = pkbf(y0[2] * rstd * g0[2], y0[3] * rstd * g0[3]);
                      w.z = pkbf(y1[0] * rstd * g1[0], y1[1] * rstd * g1[1]); w.w = pkbf(y1[2] * rstd * g1[2], y1[3] * rstd * g1[3]);
                      *(v4u*)(orow + ch) = w; } } }
            __syncthreads();
        }
    }
    __syncthreads();
}

__device__ __forceinline__ void lru_carry(const Args& a, LAS unsigned char* lds, int g, int tid) {
    const float* __restrict__ agg = (const float*)(a.ws + WS_AGG); float* __restrict__ carry = (float*)(a.ws + WS_CARRY);
    const int b = g >> 4, dc0 = (g & 15) * 64, dir = dc0 >> 9;
    LAS float* sm = (LAS float*)lds;
    for (int e = tid; e < NCH * 128; e += NWAVES * 64) { const int ci = e >> 7, r = e & 127;
        sm[e] = agg[(size_t)(b * NCH + ci) * 2048 + (r >> 6) * 1024 + dc0 + (r & 63)]; }
    __syncthreads();
    if (tid < 64) { float h = 0.f; float* cp = carry + (size_t)b * NCH * 1024 + dc0 + tid;
        if (!dir) {
#pragma unroll 8
            for (int ci = 0; ci < NCH; ++ci) { const float A = sm[ci * 128 + tid], B = sm[ci * 128 + 64 + tid]; cp[(size_t)ci * 1024] = h; h = fmaf(A, h, B); }
        } else {
#pragma unroll 8
            for (int ci = NCH - 1; ci >= 0; --ci) { const float A = sm[ci * 128 + tid], B = sm[ci * 128 + 64 + tid]; cp[(size_t)ci * 1024] = h; h = fmaf(A, h, B); }
        } }
    __syncthreads();
}

__global__ void __launch_bounds__(NWAVES * 64, 2) hymba_fwd(Args a) {
    extern __shared__ __attribute__((aligned(16))) unsigned char lds_raw[];
    LAS unsigned char* lds = (LAS unsigned char*)lds_raw;
    cg::grid_group grid = cg::this_grid();
    const int tid = threadIdx.x, lane = tid & 63, wave = __builtin_amdgcn_readfirstlane(tid >> 6);
    const int G = gridDim.x, bx = blockIdx.x, vcu = (G % 8 == 0) ? (bx % 8) * (G / 8) + bx / 8 : bx;
    unsigned char* ws = a.ws;
    const int lo = a.ph_lo, hi = a.ph_hi;
#define IN(k) (lo <= (k) && (k) < hi)
#define SEAM(k) do { if (IN(k) && IN((k) + 1)) grid.sync(); } while (0)

    if (IN(0)) { phase0(a, lds, vcu, G, wave, lane, tid); }
    SEAM(0);
    if (IN(1)) {
        pg8::Gemm g{(const pg8::bf16_t*)(ws + WS_XN), (const pg8::bf16_t*)(ws + WS_WIN), MP, INW, DM}; pg8::StaticOrder S; S.init(MP, INW, G, bx);
        pg8::EpiStore E{(pg8::bf16_t*)(ws + WS_PROJ), INW};
        pg8::gemm_phase<pg8::EpiStore, pg8::StaticOrder, true, true>(lds, g, S, E);
    }
    SEAM(1);
    if (IN(2)) {
        phase_qk(a, vcu, G, wave, lane);
        lru_phase<false>(a, lds, bx, G, wave, lane, tid);
    }
    SEAM(2);
    if (IN(3)) {
        if (bx < 192) lru_carry(a, lds, bx, tid);
        const float negM = *(const float*)(ws + WS_NEGM);
        const attn_body::bf16* proj = (const attn_body::bf16*)(ws + WS_PROJ); attn_body::bf16* mix = (attn_body::bf16*)(ws + WS_XN);
        if (G == 256) {
            const int x = bx & 7, jl = bx >> 3;
            for (int i = 0; i < 12; ++i) { const int pi = x + 8 * (i >> 2), w = jl * 4 + (i & 3), b = pi >> 1, kvh = pi & 1, h = kvh * 4 + (w >> 5), qb = w & 31;
                attn_body::attn_unit<8>(proj + ((size_t)b * LSEQ + NMETA + qb * 256) * INW + h * 64, proj + (size_t)b * LSEQ * INW + COL_K + kvh * 64, proj + (size_t)b * LSEQ * INW + COL_V + kvh * 64,
                                        mix + ((size_t)b * SEQ + qb * 256) * DM + h * 64, (char*)lds_raw, negM); }
        } else {
            for (int u = bx; u < NSEQ * 8 * 32; u += G) { const int b = u >> 8, h = (u >> 5) & 7, qb = u & 31, kvh = h >> 2;
                attn_body::attn_unit<8>(proj + ((size_t)b * LSEQ + NMETA + qb * 256) * INW + h * 64, proj + (size_t)b * LSEQ * INW + COL_K + kvh * 64, proj + (size_t)b * LSEQ * INW + COL_V + kvh * 64,
                                        mix + ((size_t)b * SEQ + qb * 256) * DM + h * 64, (char*)lds_raw, negM); }
        }
    }
    SEAM(3);
    if (IN(4)) {
        { bf16* mix = (bf16*)(ws + WS_XN); const int gw = vcu * NWAVES + wave, NGW = G * NWAVES;
          const f32x4 g0 = *(const f32x4*)(a.attn_out_g + lane * 8), g1 = *(const f32x4*)(a.attn_out_g + lane * 8 + 4);
          for (int r = gw; r < MC; r += NGW) { bf16* ptr = mix + (size_t)r * DM + lane * 8; const v4u raw = *(const v4u*)ptr;
              float x[8] = {bflo(raw.x), bfhi(raw.x), bflo(raw.y), bfhi(raw.y), bflo(raw.z), bfhi(raw.z), bflo(raw.w), bfhi(raw.w)};
              float s = 0.f;
#pragma unroll
              for (int e = 0; e < 8; ++e) s += x[e] * x[e];
              const float rstd = __builtin_amdgcn_rsqf(wave_sum(s) * (1.0f / 512.0f) + 1e-6f);
              v4u w; w.x = pkbf(x[0] * rstd * g0[0], x[1] * rstd * g0[1]); w.y = pkbf(x[2] * rstd * g0[2], x[3] * rstd * g0[3]);
              w.z = pkbf(x[4] * rstd * g1[0], x[5] * rstd * g1[1]); w.w = pkbf(x[6] * rstd * g1[2], x[7] * rstd * g1[3]);
              *(v4u*)ptr = w; } }
        lru_phase<true>(a, lds, bx, G, wave, lane, tid);
    }
    SEAM(4);
    if (IN(5)) {
        pg8::Gemm g{(const pg8::bf16_t*)(ws + WS_XN), (const pg8::bf16_t*)(ws + WS_WOUT), MC, DM, DM}; pg8::StaticOrder S; S.init(MC, DM, G, bx);
        pg8::EpiResid1 E{a.x_prompt, a.x_sample, a.out, (pg8::bf16_t*)(ws + WS_H1B), (float*)(ws + WS_SSQ1)};
        pg8::gemm_phase<pg8::EpiResid1, pg8::StaticOrder, true, true>(lds, g, S, E);
    }
    SEAM(5);
    if (IN(6)) {
        pg8::Gemm g{(const pg8::bf16_t*)(ws + WS_H1B), (const pg8::bf16_t*)(ws + WS_WGU), MC, 2 * FFH, DM}; pg8::StaticOrder S; S.init(MC, 2 * FFH, G, bx);
        pg8::EpiSwiglu E{(pg8::bf16_t*)(ws + WS_HID), FFH, (const float*)(ws + WS_SSQ1)};
        pg8::gemm_phase<pg8::EpiSwiglu, pg8::StaticOrder, true, true>(lds, g, S, E);
    }
    SEAM(6);
    if (IN(7)) {
        pg8::Gemm g{(const pg8::bf16_t*)(ws + WS_HID), (const pg8::bf16_t*)(ws + WS_WDN), MC, DM, FFH}; pg8::StaticOrder S; S.init(MC, DM, G, bx);
        pg8::EpiResid2 E{a.out, (float*)(ws + WS_SSQ2)};
        pg8::gemm_phase<pg8::EpiResid2, pg8::StaticOrder, true, true>(lds, g, S, E);
    }
    SEAM(7);
    if (IN(8)) {
        const int gw = vcu * NWAVES + wave, NGW = G * NWAVES; const float* ssq = (const float*)(ws + WS_SSQ2);
        f32x4 g4[4];
#pragma unroll
        for (int j = 0; j < 4; ++j) g4[j] = *((const f32x4*)a.final_norm_g + lane + 64 * j);
        for (int r = gw; r < MC; r += NGW) { f32x4* xr = (f32x4*)(a.out + (size_t)r * DM) + lane;
            const f32x4* sp = (const f32x4*)(ssq + (size_t)r * 16); const f32x4 s0 = sp[0], s1 = sp[1], s2 = sp[2], s3 = sp[3];
            const float tot = (((s0[0] + s0[1]) + (s0[2] + s0[3])) + ((s1[0] + s1[1]) + (s1[2] + s1[3]))) + (((s2[0] + s2[1]) + (s2[2] + s2[3])) + ((s3[0] + s3[1]) + (s3[2] + s3[3])));
            const float rstd = __builtin_amdgcn_rsqf(tot * (1.0f / DM) + 1e-6f);
#pragma unroll
            for (int j = 0; j < 4; ++j) xr[64 * j] = xr[64 * j] * rstd * g4[j]; }
    }
#undef IN
#undef SEAM
}

extern "C" void kernel_launch(void* const* d_in, const int* in_sizes, int n_in, void* d_out, int out_size, void* d_ws, size_t ws_size, hipStream_t stream) {
    static int grid = 0;
    if (grid == 0) {
        if (n_in != 21 || out_size != MC * DM || ws_size < WS_END) { fprintf(stderr, "kernel_launch: unexpected shapes (n_in %d out %d ws %zu)\n", n_in, out_size, ws_size); grid = -1; return; }
        int dev = 0, cus = 0, per_cu = 0;
        (void)hipGetDevice(&dev); (void)hipDeviceGetAttribute(&cus, hipDeviceAttributeMultiprocessorCount, dev);
        if (hipFuncSetAttribute((const void*)hymba_fwd, hipFuncAttributeMaxDynamicSharedMemorySize, LDS_BYTES) != hipSuccess) { fprintf(stderr, "kernel_launch: hipFuncSetAttribute failed\n"); grid = -1; return; }
        if (hipOccupancyMaxActiveBlocksPerMultiprocessor(&per_cu, (const void*)hymba_fwd, NWAVES * 64, LDS_BYTES) != hipSuccess || per_cu < 1) { fprintf(stderr, "kernel_launch: occupancy query says %d\n", per_cu); per_cu = 1; }
        (void)hipGetLastError();
        grid = cus * 1;
        if (grid <= 0) grid = 256;
    }
    if (grid < 0) return;
    Args a{};
    const float** slots[21] = {&a.x_prompt, &a.x_sample, &a.meta, &a.norm_mix_g, &a.w_in, &a.q_norm_g, &a.k_norm_g, &a.conv_w, &a.conv_b, &a.lru_w_a, &a.lru_b_a, &a.lru_w_x, &a.lru_b_x, &a.lru_lam,
                               &a.attn_out_g, &a.lru_out_g, &a.w_out, &a.norm_ffn_g, &a.w_gate_up, &a.w_down, &a.final_norm_g};
    for (int i = 0; i < 21; ++i) *slots[i] = (const float*)d_in[i];
    a.out = (float*)d_out; a.ws = (unsigned char*)d_ws;
#if MK_N_LAUNCHES == 1
    a.ph_lo = 0; a.ph_hi = NPHASE;
    void* args[] = {&a};
    hipError_t e = hipLaunchCooperativeKernel((const void*)hymba_fwd, dim3(grid), dim3(NWAVES * 64), args, LDS_BYTES, stream);
    if (e != hipSuccess) fprintf(stderr, "kernel_launch: cooperative launch failed: %s (grid %d)\n", hipGetErrorString(e), grid);
#else
    for (int p = 0; p < NPHASE; ++p) { a.ph_lo = p; a.ph_hi = p + 1; hipLaunchKernelGGL(hymba_fwd, dim3(grid), dim3(NWAVES * 64), LDS_BYTES, stream, a); }
#endif
}
```

```cpp
#include <hip/hip_runtime.h>
#include <hip/hip_cooperative_groups.h>
#include <hip/hip_bf16.h>
#include <cstdio>
#include <cstdint>
#include <cmath>
namespace cg = cooperative_groups;
__device__ __forceinline__ int fresh_lane() { int l; asm volatile("v_mbcnt_lo_u32_b32 %0, -1, 0\n\tv_mbcnt_hi_u32_b32 %0, -1, %0" : "=v"(l)); return l; }

namespace pg8 {
#define PG8_LAS __attribute__((address_space(3)))
typedef unsigned short bf16_t;
typedef short bf16x8 __attribute__((ext_vector_type(8)));
typedef float f32x4 __attribute__((ext_vector_type(4)));
typedef unsigned u32x4 __attribute__((ext_vector_type(4)));
constexpr int BM = 256, BK = 64, HALF = 128, HTB = HALF * BK * 2  , STAGE_BYTES = 8 * HTB, NXCD = 8, WGM = 8;

__host__ __device__ __forceinline__ int lds_byte(int r, int c) { const int st = (r >> 4) * 2 + (c >> 5), rr = r & 15, cc = c & 31, ob = rr * 64 + cc * 2; return st * 1024 + (ob ^ (((ob >> 9) & 1) << 5)); }
__host__ __device__ __forceinline__ void stage_rc(int b, int& R, int& C) { const int st = b / 1024, sb = b % 1024, swz = sb ^ (((sb >> 9) & 1) << 5); R = (st >> 1) * 16 + swz / 64; C = (st & 1) * 32 + (swz % 64) / 2; }
__host__ __device__ __forceinline__ int perm32(int rho) { const int n = rho >> 4, i = rho & 15; return 8 * (i >> 2) + 4 * n + (i & 3); }

struct Unit { int pm, pn; };
struct Gemm { const bf16_t* A; const bf16_t* Bt; int M, N, K; };

struct StaticOrder {
    int nM, nN, nwg, G, c;
    __host__ __device__ void init(int M, int N, int G_, int c_) { nM = M / BM; nN = N / BM; nwg = nM * nN; G = G_; c = c_; }
    __host__ __device__ bool next(int i, Unit& u) const {
        const long L = (long)i * G + c; if (L >= nwg) return false;
        int wgid = (int)L; { const int q = nwg / NXCD, r = nwg % NXCD, xcd = wgid % NXCD, off = wgid / NXCD; wgid = (xcd < r ? xcd * (q + 1) : r * (q + 1) + (xcd - r) * q) + off; }
        const int nig = WGM * nN, gid = wgid / nig, fm = gid * WGM, gsz = (nM - fm) < WGM ? (nM - fm) : WGM;
        u.pm = fm + ((wgid % nig) % gsz); u.pn = (wgid % nig) / gsz; return true;
    }
    __device__ __forceinline__ void a_ready(const Unit&) const {}
    __device__ __forceinline__ void done(const Unit&) const {}
};


template <class Epi, class Sched, bool ALIGN_EPI = false, bool SP2 = false>
__device__ __forceinline__ void gemm_phase(PG8_LAS unsigned char* lds, const Gemm g, const Sched& S, const Epi& E, const int wid) {
    const int lane = fresh_lane(), tid = wid * 64 + lane, wr = wid >> 2, wc = wid & 3, fr = lane & 15, fq = lane >> 4;
    const int K = g.K, nt = K / BK;
    unsigned voffA[2], voffB[2];
#pragma unroll
    for (int i = 0; i < 2; ++i) { int R, C; stage_rc(tid * 16 + i * 8192, R, C); const int Rb = Epi::PERM ? ((R & ~31) + perm32(R & 31)) : R;
        voffA[i] = (unsigned)(R * K + C) * 2u; voffB[i] = (unsigned)(Rb * K + C) * 2u; }
    const size_t kstep = (size_t)(BK * 2);
    const size_t hstep = (size_t)HALF * K * 2;
    const size_t tstep = 2 * hstep;
    const unsigned ldsw = (unsigned)wid * 1024u;
    const int aoff = lds_byte(wr * 64 + fr, fq * 8), boff = lds_byte(wc * 32 + fr, fq * 8);
#define PG8_SA(b, h) (((b) * 2 + (h)) * HTB)
#define PG8_SB(b, h) ((4 + (b) * 2 + (h)) * HTB)
#define PG8_STAGE(bufoff, gbase, voff) do { _Pragma("unroll") for (int _i = 0; _i < 2; ++_i) \
        __builtin_amdgcn_global_load_lds((const unsigned*)((const char*)(gbase) + (voff)[_i]), (PG8_LAS unsigned*)(lds + (bufoff) + ldsw + _i * 8192), 16, 0, 0); } while (0)
#define PG8_LDA(dst, b, h) do { _Pragma("unroll") for (int m = 0; m < 4; ++m) _Pragma("unroll") for (int k = 0; k < 2; ++k) dst[m][k] = *(const PG8_LAS bf16x8*)(lds + PG8_SA(b, h) + aoff + m * 2048 + k * 1024); } while (0)
#define PG8_LDB(dst, b, h) do { _Pragma("unroll") for (int n = 0; n < 2; ++n) _Pragma("unroll") for (int k = 0; k < 2; ++k) dst[n][k] = *(const PG8_LAS bf16x8*)(lds + PG8_SB(b, h) + boff + n * 2048 + k * 1024); } while (0)
#define PG8_MMA(ai, bj, At, Bt) do { __builtin_amdgcn_s_setprio(1); _Pragma("unroll") for (int m = 0; m < 4; ++m) _Pragma("unroll") for (int n = 0; n < 2; ++n) _Pragma("unroll") for (int k = 0; k < 2; ++k) \
        acc[ai][bj][m][n] = __builtin_amdgcn_mfma_f32_16x16x32_bf16(Bt[n][k], At[m][k], acc[ai][bj][m][n], 0, 0, 0); __builtin_amdgcn_s_setprio(0); } while (0)
#define PG8_WAIT_V(n) asm volatile("s_waitcnt vmcnt(" #n ")" ::: "memory")
#define PG8_WAIT_L(n) asm volatile("s_waitcnt lgkmcnt(" #n ")" ::: "memory")
#define PG8_BAR __builtin_amdgcn_s_barrier()
#define PG8_SCHED __builtin_amdgcn_sched_barrier(0)
    Unit cur, nxt; int ui = 0;
    if (!S.next(0, cur)) return;
    f32x4 acc[2][2][4][2];
#pragma unroll
    for (int a = 0; a < 2; ++a)
#pragma unroll
        for (int b = 0; b < 2; ++b)
#pragma unroll
            for (int m = 0; m < 4; ++m)
#pragma unroll
                for (int n = 0; n < 2; ++n) acc[a][b][m][n] = (f32x4){0.f, 0.f, 0.f, 0.f};
    bf16x8 At[4][2], B0[2][2], B1[2][2];
    const char* cA = (const char*)g.A + (size_t)cur.pm * tstep; const char* cB = (const char*)g.Bt + (size_t)cur.pn * tstep;
    S.a_ready(cur);
    if constexpr (SP2) {
        PG8_STAGE(PG8_SB(0, 0), cB, voffB); PG8_STAGE(PG8_SB(0, 1), cB + hstep, voffB); PG8_STAGE(PG8_SA(0, 0), cA, voffA); PG8_STAGE(PG8_SA(0, 1), cA + hstep, voffA);
        if (wr == 1) PG8_BAR;
        PG8_WAIT_V(2); PG8_BAR;
        PG8_STAGE(PG8_SB(1, 0), cB + kstep, voffB); PG8_STAGE(PG8_SA(1, 0), cA + kstep, voffA); PG8_STAGE(PG8_SB(1, 1), cB + hstep + kstep, voffB);
        PG8_WAIT_V(6); PG8_BAR;
    } else {
        PG8_STAGE(PG8_SB(0, 0), cB, voffB); PG8_STAGE(PG8_SA(0, 0), cA, voffA); PG8_STAGE(PG8_SB(0, 1), cB + hstep, voffB); PG8_STAGE(PG8_SA(0, 1), cA + hstep, voffA);
        if (wr == 1) PG8_BAR;
        PG8_WAIT_V(4); PG8_BAR;
        PG8_STAGE(PG8_SB(1, 0), cB + kstep, voffB); PG8_STAGE(PG8_SA(1, 0), cA + kstep, voffA); PG8_STAGE(PG8_SB(1, 1), cB + hstep + kstep, voffB);
        PG8_WAIT_V(6); PG8_BAR;
    }
    for (;;) {
        const bool has_next = S.next(ui + 1, nxt);
        const char* nA = has_next ? (const char*)g.A + (size_t)nxt.pm * tstep : cA; const char* nB = has_next ? (const char*)g.Bt + (size_t)nxt.pn * tstep : cB;
        for (int t = 0; t < nt; t += 2) {
            const bool last = (t == nt - 2);
            const char* a1 = cA + (size_t)(t + 1) * kstep;
            const char* a2 = last ? nA : cA + (size_t)(t + 2) * kstep; const char* b2 = last ? nB : cB + (size_t)(t + 2) * kstep;
            const char* a3 = a2 + kstep; const char* b3 = b2 + kstep;
            if (last && has_next) S.a_ready(nxt);
            if constexpr (SP2) {
            PG8_LDB(B0, 0, 0); PG8_LDB(B1, 0, 1); PG8_SCHED; PG8_LDA(At, 0, 0); PG8_STAGE(PG8_SA(1, 1), a1 + hstep, voffA);
            PG8_WAIT_V(8); PG8_WAIT_L(0); PG8_BAR; PG8_MMA(0, 0, At, B0); PG8_MMA(0, 1, At, B1); PG8_BAR; PG8_SCHED;
            PG8_LDA(At, 0, 1); PG8_STAGE(PG8_SB(0, 0), b2, voffB); PG8_STAGE(PG8_SB(0, 1), b2 + hstep, voffB); PG8_STAGE(PG8_SA(0, 0), a2, voffA);
            PG8_WAIT_V(8); PG8_WAIT_L(0); PG8_BAR; PG8_MMA(1, 0, At, B0); PG8_MMA(1, 1, At, B1); PG8_BAR; PG8_SCHED;
            PG8_LDB(B0, 1, 0); PG8_LDB(B1, 1, 1); PG8_SCHED; PG8_LDA(At, 1, 0); PG8_STAGE(PG8_SA(0, 1), a2 + hstep, voffA);
            PG8_WAIT_V(8); PG8_WAIT_L(0); PG8_BAR; PG8_MMA(0, 0, At, B0); PG8_MMA(0, 1, At, B1); PG8_BAR; PG8_SCHED;
            PG8_LDA(At, 1, 1); PG8_STAGE(PG8_SB(1, 0), b3, voffB); PG8_STAGE(PG8_SB(1, 1), b3 + hstep, voffB); PG8_STAGE(PG8_SA(1, 0), a3, voffA);
            PG8_WAIT_V(8); PG8_WAIT_L(0); PG8_BAR; PG8_MMA(1, 0, At, B0); PG8_MMA(1, 1, At, B1); PG8_BAR; PG8_SCHED;
            } else {
            PG8_LDB(B0, 0, 0); PG8_SCHED; PG8_LDA(At, 0, 0); PG8_STAGE(PG8_SA(1, 1), a1 + hstep, voffA);
            PG8_WAIT_L(8); PG8_BAR; PG8_WAIT_L(0); PG8_MMA(0, 0, At, B0); PG8_BAR; PG8_SCHED;
            PG8_LDB(B1, 0, 1); PG8_STAGE(PG8_SB(0, 0), b2, voffB);
            PG8_BAR; PG8_WAIT_L(0); PG8_MMA(0, 1, At, B1); PG8_BAR;
            PG8_LDA(At, 0, 1); PG8_STAGE(PG8_SA(0, 0), a2, voffA);
            PG8_BAR; PG8_WAIT_L(0); PG8_MMA(1, 0, At, B0); PG8_BAR; PG8_SCHED;
            PG8_STAGE(PG8_SB(0, 1), b2 + hstep, voffB);
            PG8_WAIT_V(6); PG8_BAR; PG8_MMA(1, 1, At, B1); PG8_BAR;
            PG8_LDB(B0, 1, 0); PG8_SCHED; PG8_LDA(At, 1, 0); PG8_STAGE(PG8_SA(0, 1), a2 + hstep, voffA);
            PG8_WAIT_L(8); PG8_BAR; PG8_WAIT_L(0); PG8_MMA(0, 0, At, B0); PG8_BAR; PG8_SCHED;
            PG8_LDB(B1, 1, 1); PG8_STAGE(PG8_SB(1, 0), b3, voffB);
            PG8_BAR; PG8_WAIT_L(0); PG8_MMA(0, 1, At, B1); PG8_BAR;
            PG8_LDA(At, 1, 1); PG8_STAGE(PG8_SA(1, 0), a3, voffA);
            PG8_BAR; PG8_WAIT_L(0); PG8_MMA(1, 0, At, B0); PG8_BAR; PG8_SCHED;
            PG8_STAGE(PG8_SB(1, 1), b3 + hstep, voffB);
            PG8_WAIT_V(6); PG8_BAR; PG8_MMA(1, 1, At, B1); PG8_BAR;
            }
        }
        if constexpr (ALIGN_EPI) { if (wr == 0) PG8_BAR; }
        if constexpr (!Epi::AFTER_DRAIN) { E(acc, cur, wr, wc, fr, fq); S.done(cur); }
        if (!has_next) break;
#pragma unroll
        for (int a = 0; a < 2; ++a)
#pragma unroll
            for (int b = 0; b < 2; ++b)
#pragma unroll
                for (int m = 0; m < 4; ++m)
#pragma unroll
                    for (int n = 0; n < 2; ++n) acc[a][b][m][n] = (f32x4){0.f, 0.f, 0.f, 0.f};
        cur = nxt; cA = nA; cB = nB; ++ui;
        if constexpr (ALIGN_EPI) { if (wr == 1) PG8_BAR; }
    }
    PG8_WAIT_V(0);
    if constexpr (!ALIGN_EPI) { if (wr == 0) PG8_BAR; }
    PG8_BAR;
    if constexpr (Epi::AFTER_DRAIN) { E.fused(acc, cur, wr, wc, fr, fq, lds, wid, lane); S.done(cur); }
#undef PG8_SA
#undef PG8_SB
#undef PG8_STAGE
#undef PG8_LDA
#undef PG8_LDB
#undef PG8_MMA
#undef PG8_WAIT_V
#undef PG8_WAIT_L
#undef PG8_BAR
#undef PG8_SCHED
}
}

namespace pg8 {
typedef float f32x2e __attribute__((ext_vector_type(2))); typedef __bf16 bf16x2e __attribute__((ext_vector_type(2))); typedef unsigned u32x2e __attribute__((ext_vector_type(2)));
__device__ __forceinline__ unsigned pkbf(float lo, float hi) { f32x2e v = {lo, hi}; bf16x2e b = __builtin_convertvector(v, bf16x2e); return __builtin_bit_cast(unsigned, b); }
struct EpiStore {
    static constexpr bool PERM = true, AFTER_DRAIN = false;
    bf16_t* O; int ldc;
    __device__ __forceinline__ void operator()(const f32x4 (&acc)[2][2][4][2], const Unit& u, int wr, int wc, int fr, int fq) const {
        const int row0 = u.pm * BM + wr * 64 + fr, col0 = u.pn * BM + wc * 32 + 8 * fq;
#pragma unroll
        for (int ai = 0; ai < 2; ++ai)
#pragma unroll
            for (int m = 0; m < 4; ++m) { bf16_t* rowp = O + (size_t)(row0 + ai * HALF + m * 16) * ldc + col0;
#pragma unroll
                for (int bj = 0; bj < 2; ++bj) { const f32x4 v0 = acc[ai][bj][m][0], v1 = acc[ai][bj][m][1];
                    u32x4 w; w.x = pkbf(v0[0], v0[1]); w.y = pkbf(v0[2], v0[3]); w.z = pkbf(v1[0], v1[1]); w.w = pkbf(v1[2], v1[3]);
                    *(u32x4*)(rowp + bj * HALF) = w; } }
    }
};
struct EpiResid1 {
    static constexpr bool PERM = false, AFTER_DRAIN = false;
    const float* xp; const float* xs; float* out; bf16_t* hb; float* ssq;
    __device__ __forceinline__ void operator()(const f32x4 (&acc)[2][2][4][2], const Unit& u, int wr, int wc, int fr, int fq) const {
        asm volatile("" : "+v"(fr), "+v"(fq));
        const int rbase = u.pm * BM;
        const float* xb = rbase < 65536 ? xp + (size_t)rbase * 1024 : xs + (size_t)(rbase - 65536) * 1024;
        bf16_t* hbb = hb + (size_t)rbase * 1024;
        const int col0 = u.pn * BM + wc * 32 + 4 * fq;
#pragma unroll
        for (int ai = 0; ai < 2; ++ai) {
            f32x4 xv[4][2][2];
#pragma unroll
            for (int m = 0; m < 4; ++m)
#pragma unroll
                for (int bj = 0; bj < 2; ++bj)
#pragma unroll
                    for (int n = 0; n < 2; ++n) xv[m][bj][n] = *(const f32x4*)(xb + (size_t)(ai * HALF + wr * 64 + m * 16 + fr) * 1024 + col0 + bj * HALF + n * 16);
            asm volatile("" : "+v"(xv[0][0][0]), "+v"(xv[0][0][1]), "+v"(xv[0][1][0]), "+v"(xv[0][1][1]), "+v"(xv[1][0][0]), "+v"(xv[1][0][1]), "+v"(xv[1][1][0]), "+v"(xv[1][1][1]), "+v"(xv[2][0][0]), "+v"(xv[2][0][1]), "+v"(xv[2][1][0]), "+v"(xv[2][1][1]), "+v"(xv[3][0][0]), "+v"(xv[3][0][1]), "+v"(xv[3][1][0]), "+v"(xv[3][1][1]) :: "memory");
#pragma unroll
            for (int m = 0; m < 4; ++m) { const int r = ai * HALF + wr * 64 + m * 16 + fr; float s = 0.f;
#pragma unroll
                for (int bj = 0; bj < 2; ++bj)
#pragma unroll
                    for (int n = 0; n < 2; ++n) { const size_t off = (size_t)r * 1024 + col0 + bj * HALF + n * 16;
                        const f32x4 h = xv[m][bj][n] + acc[ai][bj][m][n];
                        u32x2e w; w.x = pkbf(h[0], h[1]); w.y = pkbf(h[2], h[3]); *(u32x2e*)(hbb + off) = w;
                        s += (h[0] * h[0] + h[1] * h[1]) + (h[2] * h[2] + h[3] * h[3]); }
                s += __shfl_xor(s, 16); s += __shfl_xor(s, 32);
                if (fq == 0) ssq[(size_t)(rbase + r) * 16 + u.pn * 4 + wc] = s; }
        }
    }
};
struct EpiSwiglu {
    static constexpr bool PERM = true, AFTER_DRAIN = false;
    bf16_t* H; int ldh; const float* ssq;
    __device__ __forceinline__ void operator()(const f32x4 (&acc)[2][2][4][2], const Unit& u, int wr, int wc, int fr, int fq) const {
        const int col0 = u.pn * HALF + wc * 32 + 8 * fq;
        f32x4 part[2][4];
#pragma unroll
        for (int ai = 0; ai < 2; ++ai)
#pragma unroll
            for (int m = 0; m < 4; ++m) part[ai][m] = *(const f32x4*)(ssq + (size_t)(u.pm * BM + ai * HALF + wr * 64 + m * 16 + fr) * 16 + 4 * fq);
        asm volatile("" : "+v"(part[0][0]), "+v"(part[0][1]), "+v"(part[0][2]), "+v"(part[0][3]), "+v"(part[1][0]), "+v"(part[1][1]), "+v"(part[1][2]), "+v"(part[1][3]) :: "memory");
#pragma unroll
        for (int ai = 0; ai < 2; ++ai)
#pragma unroll
            for (int m = 0; m < 4; ++m) { const int row = u.pm * BM + ai * HALF + wr * 64 + m * 16 + fr;
                float tot = (part[ai][m][0] + part[ai][m][1]) + (part[ai][m][2] + part[ai][m][3]);
                tot += __shfl_xor(tot, 16); tot += __shfl_xor(tot, 32);
                const float rstd = __builtin_amdgcn_rsqf(tot * (1.0f / 1024.0f) + 1e-6f);
                float hv[8];
#pragma unroll
                for (int n = 0; n < 2; ++n)
#pragma unroll
                    for (int i = 0; i < 4; ++i) { const float g = acc[ai][0][m][n][i] * rstd, uu = acc[ai][1][m][n][i] * rstd;
                        const float sg = g * __builtin_amdgcn_rcpf(1.0f + __builtin_amdgcn_exp2f(g * -1.4426950408889634f)); hv[n * 4 + i] = sg * uu; }
                u32x4 w; w.x = pkbf(hv[0], hv[1]); w.y = pkbf(hv[2], hv[3]); w.z = pkbf(hv[4], hv[5]); w.w = pkbf(hv[6], hv[7]);
                *(u32x4*)(H + (size_t)row * ldh + col0) = w; }
    }
};
struct EpiResid2 {
    static constexpr bool PERM = false, AFTER_DRAIN = false;
    float* out; float* ssq; const bf16_t* hb;
    __device__ __forceinline__ void operator()(const f32x4 (&acc)[2][2][4][2], const Unit& u, int wr, int wc, int fr, int fq) const {
        const int rbase = u.pm * BM; float* ob = out + (size_t)rbase * 1024;
        const int col0 = u.pn * BM + wc * 32 + 4 * fq;
#pragma unroll
        for (int ai = 0; ai < 2; ++ai)
#pragma unroll
            for (int m = 0; m < 4; ++m) { const int r = ai * HALF + wr * 64 + m * 16 + fr; float s = 0.f;
#pragma unroll
                for (int bj = 0; bj < 2; ++bj)
#pragma unroll
                    for (int n = 0; n < 2; ++n) { const size_t off = (size_t)r * 1024 + col0 + bj * HALF + n * 16;
                        const u32x2e hw = *(const u32x2e*)(hb + (size_t)rbase * 1024 + off);
                        const f32x4 h = (f32x4){__uint_as_float(hw.x << 16), __uint_as_float(hw.x & 0xffff0000u), __uint_as_float(hw.y << 16), __uint_as_float(hw.y & 0xffff0000u)} + acc[ai][bj][m][n];
                        *(f32x4*)(ob + off) = h;
                        s += (h[0] * h[0] + h[1] * h[1]) + (h[2] * h[2] + h[3] * h[3]); }
                s += __shfl_xor(s, 16); s += __shfl_xor(s, 32);
                if (fq == 0) ssq[(size_t)(rbase + r) * 16 + u.pn * 4 + wc] = s; }
    }
};
struct EpiFinal {
    static constexpr bool PERM = false, AFTER_DRAIN = false;
    float* out; const bf16_t* hb; const float* g; float* xbuf; unsigned* cnt; PG8_LAS unsigned char* lx;
    __device__ __forceinline__ void operator()(f32x4 (&acc)[2][2][4][2], const Unit& u, int wr, int wc, int fr, int fq) const {
        int tid = (wr * 4 + wc) * 64 + fresh_lane(); asm volatile("" : "+v"(tid));
        asm volatile("" : "+v"(fr), "+v"(fq));
        const int lane = tid & 63, wid = __builtin_amdgcn_readfirstlane(tid >> 6);
        PG8_LAS float* P = (PG8_LAS float*)lx; PG8_LAS float* S = (PG8_LAS float*)(lx + 4096);
        const int rbase = u.pm * BM; float* ob = out + (size_t)rbase * 1024;
        const int col0 = u.pn * BM + wc * 32 + 4 * fq;
        u32x2e hv[2][4][2][2];
#pragma unroll
        for (int ai = 0; ai < 2; ++ai)
#pragma unroll
            for (int m = 0; m < 4; ++m)
#pragma unroll
                for (int bj = 0; bj < 2; ++bj)
#pragma unroll
                    for (int n = 0; n < 2; ++n) hv[ai][m][bj][n] = *(const u32x2e*)(hb + (size_t)(rbase + ai * HALF + wr * 64 + m * 16 + fr) * 1024 + col0 + bj * HALF + n * 16);
        asm volatile("" : "+v"(hv[0][0][0][0]), "+v"(hv[0][0][0][1]), "+v"(hv[0][0][1][0]), "+v"(hv[0][0][1][1]), "+v"(hv[0][1][0][0]), "+v"(hv[0][1][0][1]), "+v"(hv[0][1][1][0]), "+v"(hv[0][1][1][1]), "+v"(hv[0][2][0][0]), "+v"(hv[0][2][0][1]), "+v"(hv[0][2][1][0]), "+v"(hv[0][2][1][1]), "+v"(hv[0][3][0][0]), "+v"(hv[0][3][0][1]), "+v"(hv[0][3][1][0]), "+v"(hv[0][3][1][1]) :: "memory");
        asm volatile("" : "+v"(hv[1][0][0][0]), "+v"(hv[1][0][0][1]), "+v"(hv[1][0][1][0]), "+v"(hv[1][0][1][1]), "+v"(hv[1][1][0][0]), "+v"(hv[1][1][0][1]), "+v"(hv[1][1][1][0]), "+v"(hv[1][1][1][1]), "+v"(hv[1][2][0][0]), "+v"(hv[1][2][0][1]), "+v"(hv[1][2][1][0]), "+v"(hv[1][2][1][1]), "+v"(hv[1][3][0][0]), "+v"(hv[1][3][0][1]), "+v"(hv[1][3][1][0]), "+v"(hv[1][3][1][1]) :: "memory");
#pragma unroll
        for (int ai = 0; ai < 2; ++ai)
#pragma unroll
            for (int m = 0; m < 4; ++m) { const int r = ai * HALF + wr * 64 + m * 16 + fr; float s = 0.f;
#pragma unroll
                for (int bj = 0; bj < 2; ++bj)
#pragma unroll
                    for (int n = 0; n < 2; ++n) { const u32x2e hw = hv[ai][m][bj][n];
                        const f32x4 h = (f32x4){__uint_as_float(hw.x << 16), __uint_as_float(hw.x & 0xffff0000u), __uint_as_float(hw.y << 16), __uint_as_float(hw.y & 0xffff0000u)} + acc[ai][bj][m][n]; acc[ai][bj][m][n] = h;
                        s += (h[0] * h[0] + h[1] * h[1]) + (h[2] * h[2] + h[3] * h[3]); }
                s += __shfl_xor(s, 16); s += __shfl_xor(s, 32);
                if (fq == 0) P[r * 4 + wc] = s; }
        asm volatile("s_waitcnt lgkmcnt(0)" ::: "memory"); __builtin_amdgcn_s_barrier(); asm volatile("" ::: "memory");
        if (tid < 256) { const f32x4 p = *(const PG8_LAS f32x4*)(P + tid * 4);
            __hip_atomic_store(xbuf + (size_t)(rbase + tid) * 4 + u.pn, (p[0] + p[1]) + (p[2] + p[3]), __ATOMIC_RELAXED, __HIP_MEMORY_SCOPE_AGENT); }
        asm volatile("s_waitcnt vmcnt(0)" ::: "memory");
        if (wid < 4 && lane == 0) __hip_atomic_fetch_add(cnt + 64 * u.pm, 1u, __ATOMIC_RELAXED, __HIP_MEMORY_SCOPE_AGENT);
        if (wid == 0) {
            for (unsigned sp = 0; sp < (1u << 21); ++sp) {
                if ((unsigned)__builtin_amdgcn_readfirstlane(__hip_atomic_load(cnt + 64 * u.pm, __ATOMIC_RELAXED, __HIP_MEMORY_SCOPE_AGENT)) >= 16u) break;
                __builtin_amdgcn_s_sleep(2); }
            __builtin_amdgcn_fence(__ATOMIC_ACQUIRE, "agent"); }
        asm volatile("s_waitcnt vmcnt(0) lgkmcnt(0)" ::: "memory"); __builtin_amdgcn_s_barrier(); asm volatile("" ::: "memory");
        if (tid < 256) { const float* sl = xbuf + (size_t)(rbase + tid) * 4; float t = 0.f;
#pragma unroll
            for (int k = 0; k < 4; ++k) t += __hip_atomic_load(sl + k, __ATOMIC_RELAXED, __HIP_MEMORY_SCOPE_AGENT);
            S[tid] = __builtin_amdgcn_rsqf(t * (1.0f / 1024.0f) + 1e-6f); }
        asm volatile("s_waitcnt vmcnt(0) lgkmcnt(0)" ::: "memory"); __builtin_amdgcn_s_barrier(); asm volatile("" ::: "memory");
        f32x4 gv[2][2];
#pragma unroll
        for (int bj = 0; bj < 2; ++bj)
#pragma unroll
            for (int n = 0; n < 2; ++n) gv[bj][n] = *(const f32x4*)(g + col0 + bj * HALF + n * 16);
#pragma unroll
        for (int ai = 0; ai < 2; ++ai)
#pragma unroll
            for (int m = 0; m < 4; ++m) { const int r = ai * HALF + wr * 64 + m * 16 + fr; const float rs = S[r];
#pragma unroll
                for (int bj = 0; bj < 2; ++bj)
#pragma unroll
                    for (int n = 0; n < 2; ++n) *(f32x4*)(ob + (size_t)r * 1024 + col0 + bj * HALF + n * 16) = acc[ai][bj][m][n] * rs * gv[bj][n]; }
        asm volatile("s_waitcnt lgkmcnt(0)" ::: "memory"); __builtin_amdgcn_s_barrier(); asm volatile("" ::: "memory");
    }
};
}

#include <hip/hip_bf16.h>
#include <cmath>
namespace attn_body {
using bf16=__hip_bfloat16;
using bf16x8=__attribute__((ext_vector_type(8)))short;
using s16x4=__attribute__((ext_vector_type(4)))short;
using f32x16=__attribute__((ext_vector_type(16)))float;
using u32x4=__attribute__((ext_vector_type(4)))unsigned;
constexpr int D=64,QP=1792,OP=1024;
constexpr int NW=8,QBLK=32,QB=QBLK*NW,KVBLK=64,NT=129;
__device__ __forceinline__ int crow(int r,int hi){return (r&3)+8*(r>>2)+4*hi;}
#define SBAR() __builtin_amdgcn_sched_barrier(0)
__device__ __forceinline__ void tmask(f32x16&p0,f32x16&p1){
  const float NEG=-INFINITY;
  #pragma unroll
  for(int r=0;r<16;++r){ if(r>=8)p0[r]=NEG; p1[r]=NEG; }
}

constexpr int NSLOT=3, SLOTB=8192;
constexpr int LDS_K=0, LDS_V=NSLOT*SLOTB, LDS_WS=2*NSLOT*SLOTB, LDS_OST=LDS_WS+NW*64*4, LDS_BYTES=LDS_OST+NW*4096;
constexpr float C2=0.125f*1.4426950408889634f;
__device__ __forceinline__ void glds16(const void*gsrc,unsigned lds_dst){unsigned keep;
  asm volatile("s_mov_b32 %0, m0\n\ts_mov_b32 m0, %2\n\ts_nop 0\n\tglobal_load_lds_dwordx4 %1, off\n\ts_mov_b32 m0, %0":"=&s"(keep):"v"(gsrc),"s"(lds_dst):"memory");}
__device__ __forceinline__ float max3f(float a,float b,float c){float r;asm("v_max3_f32 %0, %1, %2, %3":"=v"(r):"v"(a),"v"(b),"v"(c));return r;}
__device__ __forceinline__ float max2f(float a,float b){float r;asm("v_max_f32_e32 %0, %1, %2":"=v"(r):"v"(a),"v"(b));return r;}
__device__ __forceinline__ float fadd_s(float a,float b){float r;asm("v_add_f32_e32 %0, %1, %2":"=v"(r):"v"(a),"v"(b));return r;}
__device__ __forceinline__ float fsub_s(float a,float b){float r;asm("v_sub_f32_e32 %0, %1, %2":"=v"(r):"v"(a),"v"(b));return r;}
typedef float f32x2_t __attribute__((ext_vector_type(2))); typedef __bf16 bf16x2_t __attribute__((ext_vector_type(2)));
__device__ __forceinline__ unsigned cvtpk_s(float lo,float hi){f32x2_t v={lo,hi};bf16x2_t b=__builtin_convertvector(v,bf16x2_t);return __builtin_bit_cast(unsigned,b);}
#define WAIT_BAR(N) asm volatile("s_waitcnt vmcnt(" #N ") lgkmcnt(0)\n\ts_barrier":::"memory")

__device__ __forceinline__ void qkt(f32x16&p0,f32x16&p1,const char*Kslot,const bf16x8*qr,const f32x16&negm,int r32,int hi){
  const char*kb=Kslot+hi*1024+r32*16;
  #pragma unroll
  for(int d0=0;d0<4;++d0){
    const bf16x8 b0=*reinterpret_cast<const bf16x8*>(kb+d0*2048);
    const bf16x8 b1=*reinterpret_cast<const bf16x8*>(kb+d0*2048+512);
    if(d0==0){p0=__builtin_amdgcn_mfma_f32_32x32x16_bf16(b0,qr[0],negm,0,0,0);p1=__builtin_amdgcn_mfma_f32_32x32x16_bf16(b1,qr[0],negm,0,0,0);}
    else{p0=__builtin_amdgcn_mfma_f32_32x32x16_bf16(b0,qr[d0],p0,0,0,0);p1=__builtin_amdgcn_mfma_f32_32x32x16_bf16(b1,qr[d0],p1,0,0,0);}}
}
typedef __attribute__((address_space(3))) const char* lds_cptr;
typedef short v4i16_t __attribute__((ext_vector_type(4)));
__device__ __forceinline__ void kload8(bf16x8*kf,lds_cptr kp){
  kf[0]=*(const __attribute__((address_space(3))) bf16x8*)(kp);      kf[1]=*(const __attribute__((address_space(3))) bf16x8*)(kp+512);
  kf[2]=*(const __attribute__((address_space(3))) bf16x8*)(kp+2048); kf[3]=*(const __attribute__((address_space(3))) bf16x8*)(kp+2560);
  kf[4]=*(const __attribute__((address_space(3))) bf16x8*)(kp+4096); kf[5]=*(const __attribute__((address_space(3))) bf16x8*)(kp+4608);
  kf[6]=*(const __attribute__((address_space(3))) bf16x8*)(kp+6144); kf[7]=*(const __attribute__((address_space(3))) bf16x8*)(kp+6656);
}
__device__ __forceinline__ void kload2(bf16x8*kf,lds_cptr kp,int j){ kf[2*j]=*(const __attribute__((address_space(3))) bf16x8*)(kp+j*2048); kf[2*j+1]=*(const __attribute__((address_space(3))) bf16x8*)(kp+j*2048+512); }
__device__ __forceinline__ s16x4 vtr(lds_cptr p){ return __builtin_bit_cast(s16x4,__builtin_amdgcn_ds_read_tr16_b64_v4i16((__attribute__((address_space(3))) v4i16_t*)p)); }
__device__ __forceinline__ float rowmax(const f32x16&p0,const f32x16&p1){
  float a=max3f(p0[0],p0[1],p1[0]),b=max3f(p0[2],p0[3],p1[1]);a=max3f(a,p1[2],p1[3]);
  #pragma unroll
  for(int r=4;r<16;r+=4){a=max3f(a,p0[r],p0[r+1]);b=max3f(b,p0[r+2],p0[r+3]);a=max3f(a,p1[r],p1[r+1]);b=max3f(b,p1[r+2],p1[r+3]);}
  const float m=max2f(a,b);
  auto rr=__builtin_amdgcn_permlane32_swap(__float_as_uint(m),__float_as_uint(m),false,false);
  return max2f(__uint_as_float(rr[0]),__uint_as_float(rr[1]));
}
__device__ __forceinline__ void pv(f32x16*o,int vb,bf16x8 pa0,bf16x8 pa1,bf16x8 pa2,bf16x8 pa3){
  #pragma unroll
  for(int d0=0;d0<2;++d0){s16x4 lo[4],hi[4];
    #pragma unroll
    for(int ks=0;ks<4;++ks){
      asm volatile("ds_read_b64_tr_b16 %0,%1 offset:%c2":"=&v"(lo[ks]):"v"(vb),"i"(d0*4096+ks*1024):"memory");
      asm volatile("ds_read_b64_tr_b16 %0,%1 offset:%c2":"=&v"(hi[ks]):"v"(vb),"i"(d0*4096+ks*1024+512):"memory");}
    asm volatile("s_waitcnt lgkmcnt(0)":::"memory");SBAR();
    #define PK(k) (bf16x8){lo[k][0],lo[k][1],lo[k][2],lo[k][3],hi[k][0],hi[k][1],hi[k][2],hi[k][3]}
    o[d0]=__builtin_amdgcn_mfma_f32_32x32x16_bf16(pa0,PK(0),o[d0],0,0,0);
    o[d0]=__builtin_amdgcn_mfma_f32_32x32x16_bf16(pa1,PK(1),o[d0],0,0,0);
    o[d0]=__builtin_amdgcn_mfma_f32_32x32x16_bf16(pa2,PK(2),o[d0],0,0,0);
    o[d0]=__builtin_amdgcn_mfma_f32_32x32x16_bf16(pa3,PK(3),o[d0],0,0,0);
    #undef PK
  }
}

#ifndef ATTN_STORE16
#define ATTN_STORE16(p,v) (*(u32x4*)(p)=(v))
#endif
template<int THRL> __device__ __forceinline__ void attn_unit(const bf16*Qw0,const bf16*__restrict__ Kh,const bf16*__restrict__ Vh,bf16*Ow0,char*shm,const float negM,const int wid,const float*qg,const float*ctab,const float*stab,const int t0){
  const int lane=fresh_lane(),r32=lane&31,hi=lane>>5;
  const bf16*Qw=Qw0+(long)(wid*QBLK)*QP;
  const unsigned lds0=(unsigned)(uintptr_t)shm;
  float*wsf=(float*)(shm+LDS_WS)+wid*64;
  const bf16*ksrc=Kh+(long)lane*QP+wid*8;
  const bf16*vsrc=Vh+(long)(16*(wid&3)+(lane>>2))*QP+(wid>>2)*32+(lane&3)*8;
  const unsigned kdst=lds0+LDS_K+wid*1024, vdst=lds0+LDS_V+wid*1024;
  #define DMA_K(t,slot) glds16(ksrc+(long)(t)*KVBLK*QP,(unsigned)__builtin_amdgcn_readfirstlane(kdst+(slot)))
  #define DMA_V(t,slot) glds16(vsrc+(long)(t)*KVBLK*QP,(unsigned)__builtin_amdgcn_readfirstlane(vdst+(slot)))
  const int vb0=(int)(lds0+LDS_V)+((lane>>4)&1)*32+(lane&3)*8+(4*hi+((lane&15)>>2))*64;
  const char*Kbase=shm+LDS_K; bf16x8 kf[8];
  const lds_cptr shm3=(lds_cptr)shm; const lds_cptr kp0=shm3+LDS_K+hi*1024+r32*16; const lds_cptr vp0=shm3+LDS_V+((lane>>4)&1)*32+(lane&3)*8+(4*hi+((lane&15)>>2))*64;
  DMA_K(0,0);DMA_V(0,0);DMA_K(1,SLOTB);
  bf16x8 qr[4];
  #pragma unroll
  for(int d0=0;d0<4;++d0)qr[d0]=*reinterpret_cast<const bf16x8*>(&Qw[(long)r32*QP+d0*16+hi*8]);
  { float x[4][8]; float ss=0.f;
    #pragma unroll
    for(int d0=0;d0<4;++d0){
      #pragma unroll
      for(int j=0;j<8;++j){x[d0][j]=__uint_as_float(((unsigned)(unsigned short)qr[d0][j])<<16);ss+=x[d0][j]*x[d0][j];}}
    {auto rr=__builtin_amdgcn_permlane32_swap(__float_as_uint(ss),__float_as_uint(ss),false,false);ss=__uint_as_float(rr[0])+__uint_as_float(rr[1]);}
    const float rstd=__builtin_amdgcn_rsqf(ss*(1.0f/64.0f)+1e-6f);
    #pragma unroll
    for(int d0=0;d0<4;++d0){ const float*gp=qg+d0*16+hi*8;
      #pragma unroll
      for(int j=0;j<8;++j)x[d0][j]*=rstd*gp[j]; }
    const long trow=(long)(t0+wid*QBLK+r32)*32+hi*8;
    #pragma unroll
    for(int hf=0;hf<2;++hf){ const float*cp=ctab+trow+hf*16,*sp=stab+trow+hf*16;
      #pragma unroll
      for(int j=0;j<8;++j){ const float c=cp[j],sn=sp[j],a=x[2*hf][j],b=x[2*hf+1][j]; x[2*hf][j]=(a*c-b*sn)*C2; x[2*hf+1][j]=(b*c+a*sn)*C2; } }
    #pragma unroll
    for(int d0=0;d0<4;++d0){ u32x4 w; w.x=cvtpk_s(x[d0][0],x[d0][1]); w.y=cvtpk_s(x[d0][2],x[d0][3]); w.z=cvtpk_s(x[d0][4],x[d0][5]); w.w=cvtpk_s(x[d0][6],x[d0][7]); qr[d0]=__builtin_bit_cast(bf16x8,w); }
  }
  f32x16 o[2];o[0]=f32x16{};o[1]=f32x16{};f32x16 lacc=f32x16{};const f32x16 negm=f32x16{};(void)negM;
  bf16x8 ones={(short)0x3F80,(short)0x3F80,(short)0x3F80,(short)0x3F80,(short)0x3F80,(short)0x3F80,(short)0x3F80,(short)0x3F80}; asm volatile("":"+v"(ones));
  #define CMASK(P0,P1,t) do{ if((t)==NT-1)tmask(P0,P1); }while(0)
  #define START(P0,P1) do{ _Pragma("unroll") for(int r=0;r<16;++r)P0[r]=__builtin_amdgcn_exp2f(P0[r]); }while(0)
  #define RESC() do{}while(0)
  f32x16 pA0,pA1,pB0,pB1;
  int sl_prev=0,sl_cur=0,sl_next=SLOTB;
  #define ROT() do{sl_prev=sl_cur;sl_cur=sl_next;sl_next=(sl_next==(NSLOT-1)*SLOTB)?0:sl_next+SLOTB;}while(0)
  DMA_K(2,2*SLOTB);
  WAIT_BAR(3);
  qkt(pA0,pA1,Kbase,qr,negm,r32,hi);asm volatile("s_nop 15\n\ts_nop 7":"+v"(pA0),"+v"(pA1));CMASK(pA0,pA1,0);
  START(pA0,pA1);
  _Pragma("unroll") for(int r=0;r<16;++r)pA1[r]=__builtin_amdgcn_exp2f(pA1[r]);
  WAIT_BAR(0);
  DMA_K(3,0);DMA_V(1,SLOTB);
  ROT();
  kload8(kf,kp0+sl_cur);
  WAIT_BAR(2);
  s16x4 vlo[8],vhi[8]; u32x4 pw0,pw1,pw2,pw3;
  #define PKW(P,B) cvtpk_s(P[B],P[B+1])
  #define PAF(k) __builtin_bit_cast(bf16x8,pw##k)
  #define VFR(i) (bf16x8){vlo[i][0],vlo[i][1],vlo[i][2],vlo[i][3],vhi[i][0],vhi[i][1],vhi[i][2],vhi[i][3]}
  #define PIN(x) asm volatile("":"+v"(x))
  #define MX3(a,b,c) __builtin_fmaxf(__builtin_fmaxf((a),(b)),(c))
  #define GAPA(MF,W0,W1,PW) do{ MF; W0; W1; PIN(PW); SBAR(); }while(0)
  #define EX(v) __builtin_amdgcn_exp2f(v)
  #define GAPB3(MF,X,B) do{ MF; X[B]=EX(X[B]); X[B+1]=EX(X[B+1]); X[B+2]=EX(X[B+2]); PIN(X); SBAR(); }while(0)
  #define GAPB2(MF,X,B) do{ MF; X[B]=EX(X[B]); X[B+1]=EX(X[B+1]); PIN(X); SBAR(); }while(0)
  #define LSUM(k) lacc=__builtin_amdgcn_mfma_f32_32x32x16_bf16(PAF(k),ones,lacc,0,0,0)
  #define VRD(i) do{ vlo[i]=vtr(vp_+(((i)>>2)*4096+((i)&3)*1024)); vhi[i]=vtr(vp_+(((i)>>2)*4096+((i)&3)*1024+512)); }while(0)
  #define KRD(G,j) do{ if(G){ kload2(kf,kp0+sl_next,j); SBAR(); } }while(0)
  #define STEP(C0,C1,P0,P1,t,GK,GV,GL) do{ SBAR(); \
    const lds_cptr vp_=vp0+sl_prev; \
    VRD(0); SBAR(); \
    GAPA(C0=__builtin_amdgcn_mfma_f32_32x32x16_bf16(kf[0],qr[0],negm,0,0,0), pw0[0]=PKW(P0,0), pw0[1]=PKW(P0,2), pw0); \
    VRD(4); SBAR(); GAPA(C1=__builtin_amdgcn_mfma_f32_32x32x16_bf16(kf[1],qr[0],negm,0,0,0), pw0[2]=PKW(P0,4), pw0[3]=PKW(P0,6), pw0); \
    VRD(1); SBAR(); GAPA(C0=__builtin_amdgcn_mfma_f32_32x32x16_bf16(kf[2],qr[1],C0,0,0,0),   pw1[0]=PKW(P0,8), pw1[1]=PKW(P0,10), pw1); \
    VRD(5); SBAR(); GAPA(C1=__builtin_amdgcn_mfma_f32_32x32x16_bf16(kf[3],qr[1],C1,0,0,0),   pw1[2]=PKW(P0,12),pw1[3]=PKW(P0,14), pw1); \
    VRD(2); SBAR(); GAPA(C0=__builtin_amdgcn_mfma_f32_32x32x16_bf16(kf[4],qr[2],C0,0,0,0),   pw2[0]=PKW(P1,0), pw2[1]=PKW(P1,2), pw2); \
    VRD(6); SBAR(); GAPA(C1=__builtin_amdgcn_mfma_f32_32x32x16_bf16(kf[5],qr[2],C1,0,0,0),   pw2[2]=PKW(P1,4), pw2[3]=PKW(P1,6), pw2); \
    VRD(3); SBAR(); GAPA(C0=__builtin_amdgcn_mfma_f32_32x32x16_bf16(kf[6],qr[3],C0,0,0,0),   pw3[0]=PKW(P1,8), pw3[1]=PKW(P1,10), pw3); \
    VRD(7); SBAR(); GAPA(C1=__builtin_amdgcn_mfma_f32_32x32x16_bf16(kf[7],qr[3],C1,0,0,0),   pw3[2]=PKW(P1,12),pw3[3]=PKW(P1,14), pw3); \
    if(GK){DMA_K((t)+3,sl_cur);} if(GV){DMA_V((t)+1,sl_next);} \
    CMASK(C0,C1,t); \
    SBAR(); \
    GAPB3(o[0]=__builtin_amdgcn_mfma_f32_32x32x16_bf16(PAF(0),VFR(0),o[0],0,0,0), C0,0); \
    GAPB3(o[1]=__builtin_amdgcn_mfma_f32_32x32x16_bf16(PAF(0),VFR(4),o[1],0,0,0), C0,3); \
    GAPB2(LSUM(0), C0,6); \
    KRD(GL,0); GAPB3(o[0]=__builtin_amdgcn_mfma_f32_32x32x16_bf16(PAF(1),VFR(1),o[0],0,0,0), C0,8); \
    KRD(GL,1); GAPB3(o[1]=__builtin_amdgcn_mfma_f32_32x32x16_bf16(PAF(1),VFR(5),o[1],0,0,0), C0,11); \
    GAPB2(LSUM(1), C0,14); \
    KRD(GL,2); GAPB3(o[0]=__builtin_amdgcn_mfma_f32_32x32x16_bf16(PAF(2),VFR(2),o[0],0,0,0), C1,0); \
    KRD(GL,3); GAPB3(o[1]=__builtin_amdgcn_mfma_f32_32x32x16_bf16(PAF(2),VFR(6),o[1],0,0,0), C1,3); \
    GAPB2(LSUM(2), C1,6); \
    GAPB3(o[0]=__builtin_amdgcn_mfma_f32_32x32x16_bf16(PAF(3),VFR(3),o[0],0,0,0), C1,8); \
    GAPB3(o[1]=__builtin_amdgcn_mfma_f32_32x32x16_bf16(PAF(3),VFR(7),o[1],0,0,0), C1,11); \
    GAPB2(LSUM(3), C1,14); \
    }while(0)
  int t=1;
  #define ENDW(tt) do{ if((tt)+3<NT){WAIT_BAR(2);} else if((tt)+2<NT){WAIT_BAR(1);} else {WAIT_BAR(0);} }while(0)
  #undef CMASK
  #define CMASK(P0,P1,t) do{}while(0)
  for(;t+4<NT;t+=2){
    STEP(pB0,pB1,pA0,pA1,t,true,true,true);     WAIT_BAR(2); RESC(); ROT();
    STEP(pA0,pA1,pB0,pB1,t+1,true,true,true);   WAIT_BAR(2); RESC(); ROT();
  }
  for(;t+2<NT;t+=2){
    STEP(pB0,pB1,pA0,pA1,t,(t+3<NT),(t+1<NT),(t+1<NT));       ENDW(t);   RESC(); ROT();
    STEP(pA0,pA1,pB0,pB1,t+1,(t+4<NT),(t+2<NT),(t+2<NT));     ENDW(t+1); RESC(); ROT();
  }
  STEP(pB0,pB1,pA0,pA1,NT-2,false,true,true); WAIT_BAR(0); RESC(); ROT();
  #undef CMASK
  #define CMASK(P0,P1,t) tmask(P0,P1)
  STEP(pA0,pA1,pB0,pB1,NT-1,false,false,false); RESC();
  { pw0=(u32x4){PKW(pA0,0),PKW(pA0,2),PKW(pA0,4),PKW(pA0,6)};pw1=(u32x4){PKW(pA0,8),PKW(pA0,10),PKW(pA0,12),PKW(pA0,14)};pw2=(u32x4){PKW(pA1,0),PKW(pA1,2),PKW(pA1,4),PKW(pA1,6)};pw3=(u32x4){PKW(pA1,8),PKW(pA1,10),PKW(pA1,12),PKW(pA1,14)};
    SBAR(); pv(o,vb0+sl_cur,PAF(0),PAF(1),PAF(2),PAF(3)); LSUM(0); LSUM(1); LSUM(2); LSUM(3); }
  #undef PKW
  #undef PAF
  #undef VFR
  #undef PIN
  #undef MX3
  #undef GAPA
  #undef GAPB3
  #undef GAPB2
  #undef LSUM
  #undef EX
  #undef VRD
  #undef KRD
  #undef STEP
  #undef ENDW
  float rli[16];
  #pragma unroll
  for(int r=0;r<16;++r)rli[r]=__builtin_amdgcn_rcpf(lacc[r]);
  bf16*Ow=Ow0+(long)(wid*QBLK)*OP;
  { bf16*stg=(bf16*)(shm+LDS_OST)+wid*2048;
    #pragma unroll
    for(int r=0;r<16;++r){const int orow=crow(r,hi);
      #pragma unroll
      for(int d0=0;d0<2;++d0)stg[orow*64+d0*32+r32]=__float2bfloat16(o[d0][r]*rli[r]);}
    asm volatile("s_waitcnt lgkmcnt(0)":::"memory");
    #pragma unroll
    for(int i=0;i<4;++i){const int row=i*8+(lane>>3),ch=lane&7; const u32x4 v=*(const u32x4*)(stg+row*64+ch*8); ATTN_STORE16(Ow+(long)row*OP+ch*8,v);} }
  asm volatile("s_waitcnt lgkmcnt(0)\n\ts_barrier":::"memory");
  #undef DMA_K
  #undef DMA_V
  #undef CMASK
  #undef START
  #undef RESC
  #undef ROT
}
constexpr int ATTN_LDS_BYTES=LDS_BYTES;
#undef SBAR
#undef WAIT_BAR
}

#ifndef MK_N_LAUNCHES
#define MK_N_LAUNCHES 1
#endif
constexpr int NWAVES = 8, NPHASE = 9;
constexpr int DM = 1024, NSEQ = 12, SEQ = 8192, NMETA = 16, LSEQ = SEQ + NMETA;
constexpr int TNAT = NSEQ * LSEQ, MP = 98560, MC = NSEQ * SEQ;
constexpr int INW = 1792, FFH = 2816, LRUW = 512;
constexpr int COL_K = 512, COL_V = 640, COL_LIN = 768, COL_LG = 1280;
constexpr int CT = 32, NCH = 257, NLU = NSEQ * NCH;
constexpr float QSCALE = 0.125f * 1.4426950408889634f;
constexpr size_t MiB = 1u << 20;
constexpr size_t WS_WIN = 2 * MiB, WS_WOUT = 6 * MiB, WS_WGU = 8 * MiB, WS_WDN = 20 * MiB, WS_WLRU = 26 * MiB, WS_NL = 26 * MiB + 512 * 1024;
constexpr size_t WS_COS = 27 * MiB, WS_SIN = 28 * MiB, WS_NEGM = 29 * MiB, WS_CNT = 30 * MiB;
constexpr size_t WS_AGG = 32 * MiB, WS_CARRY = 60 * MiB, WS_SSQ1 = 74 * MiB, WS_SSQ2 = 82 * MiB;
constexpr size_t WS_XN = 96 * MiB;
constexpr size_t WS_PROJ = 300 * MiB;
constexpr size_t WS_HID = 96 * MiB;
constexpr size_t WS_H1B = 656 * MiB;
constexpr size_t WS_SP = 656 * MiB;
constexpr size_t WS_END = 960 * MiB;
static_assert(WS_AGG + (size_t)NLU * 2048 * 4 <= WS_CARRY && WS_CARRY + (size_t)NLU * 1024 * 4 <= WS_SSQ1 && WS_SSQ1 + (size_t)MC * 64 <= WS_SSQ2 && WS_SSQ2 + (size_t)MC * 64 <= WS_XN, "ws map 1");
static_assert(WS_XN + (size_t)MP * 1024 * 2 <= WS_PROJ && WS_PROJ + (size_t)MP * INW * 2 <= WS_H1B && WS_HID + (size_t)MC * FFH * 2 <= WS_H1B && WS_H1B + (size_t)MC * 1024 * 2 <= WS_END && WS_SP + (size_t)(TNAT + 64) * 2048 <= WS_END, "ws map 2");
constexpr int LDS_BYTES = 147456;

#define GAS __attribute__((address_space(1)))
#define LAS __attribute__((address_space(3)))
typedef unsigned short bf16;
typedef unsigned v4u __attribute__((ext_vector_type(4)));
typedef unsigned v2u __attribute__((ext_vector_type(2)));
typedef float f32x4 __attribute__((ext_vector_type(4)));
typedef short bf16x8 __attribute__((ext_vector_type(8)));
using pg8::pkbf;
__device__ __forceinline__ float bflo(unsigned w) { return __uint_as_float(w << 16); }
__device__ __forceinline__ float bfhi(unsigned w) { return __uint_as_float(w & 0xffff0000u); }
__device__ __forceinline__ float wave_sum(float v) {
#pragma unroll
    for (int o = 1; o < 64; o <<= 1) v += __shfl_xor(v, o);
    return v;
}
template <int CTRL> __device__ __forceinline__ float dppf(float old, float v) { return __builtin_bit_cast(float, __builtin_amdgcn_update_dpp(__builtin_bit_cast(int, old), __builtin_bit_cast(int, v), CTRL, 0xf, 0xf, false)); }
__device__ __forceinline__ void scan_fwd16(float& A, float& B) {
#define SF(S) { const float Ap = dppf<0x110 + S>(1.f, A), Bp = dppf<0x110 + S>(0.f, B); B = fmaf(A, Bp, B); A = A * Ap; }
    SF(1) SF(2) SF(4) SF(8)
#undef SF
}
__device__ __forceinline__ void scan_bwd16(float& A, float& B) {
#define SB(S) { const float Ap = dppf<0x100 + S>(1.f, A), Bp = dppf<0x100 + S>(0.f, B); B = fmaf(A, Bp, B); A = A * Ap; }
    SB(1) SB(2) SB(4) SB(8)
#undef SB
}

#define LRU_DPP_STEP(DIR, S) \
    "v_fmac_f32_dpp %0, %0, %4 " DIR ":" #S " row_mask:0xf bank_mask:0xf\n\tv_fmac_f32_dpp %1, %1, %5 " DIR ":" #S " row_mask:0xf bank_mask:0xf\n\t" \
    "v_fmac_f32_dpp %2, %2, %6 " DIR ":" #S " row_mask:0xf bank_mask:0xf\n\tv_fmac_f32_dpp %3, %3, %7 " DIR ":" #S " row_mask:0xf bank_mask:0xf\n\t" \
    "v_mul_f32_dpp %4, %4, %4 " DIR ":" #S " row_mask:0xf bank_mask:0xf\n\tv_mul_f32_dpp %5, %5, %5 " DIR ":" #S " row_mask:0xf bank_mask:0xf\n\t" \
    "v_mul_f32_dpp %6, %6, %6 " DIR ":" #S " row_mask:0xf bank_mask:0xf\n\tv_mul_f32_dpp %7, %7, %7 " DIR ":" #S " row_mask:0xf bank_mask:0xf\n\t"
__device__ __forceinline__ void scan4_fwd16(float (&A)[4], float (&B)[4]) {
    asm volatile("s_nop 1\n\t" LRU_DPP_STEP("row_shr", 1) LRU_DPP_STEP("row_shr", 2) LRU_DPP_STEP("row_shr", 4) LRU_DPP_STEP("row_shr", 8)
                 : "+v"(B[0]), "+v"(B[1]), "+v"(B[2]), "+v"(B[3]), "+v"(A[0]), "+v"(A[1]), "+v"(A[2]), "+v"(A[3]));
}
__device__ __forceinline__ void scan4_bwd16(float (&A)[4], float (&B)[4]) {
    asm volatile("s_nop 1\n\t" LRU_DPP_STEP("row_shl", 1) LRU_DPP_STEP("row_shl", 2) LRU_DPP_STEP("row_shl", 4) LRU_DPP_STEP("row_shl", 8)
                 : "+v"(B[0]), "+v"(B[1]), "+v"(B[2]), "+v"(B[3]), "+v"(A[0]), "+v"(A[1]), "+v"(A[2]), "+v"(A[3]));
}

struct Args {
    const float *x_prompt, *x_sample, *meta, *norm_mix_g, *w_in, *q_norm_g, *k_norm_g, *conv_w, *conv_b, *lru_w_a, *lru_b_a, *lru_w_x, *lru_b_x, *lru_lam,
                *attn_out_g, *lru_out_g, *w_out, *norm_ffn_g, *w_gate_up, *w_down, *final_norm_g;
    float* out; unsigned char* ws; int ph_lo, ph_hi;
};

__device__ __forceinline__ void p0_transpose_item(const float* W, int K, int N, bf16* WT, int mode, const float* kscale, LAS float* scr, int item, int lane) {
    const int nblk = N / 32, kb = item / nblk, nb = item % nblk, k0 = 64 * kb, n0 = 32 * nb;
#pragma unroll 8
    for (int i = 0; i < 32; ++i) { const int kk = 2 * i + (lane >> 5); float v = W[(size_t)(k0 + kk) * N + n0 + (lane & 31)]; if (kscale) v *= kscale[k0 + kk]; scr[kk * 33 + (lane & 31)] = v; }
    asm volatile("s_waitcnt lgkmcnt(0)" ::: "memory");
    int rbase = n0;
    if (mode == 1) { if (n0 < FFH) rbase = (n0 / 128) * 256 + (n0 % 128); else { const int j = n0 - FFH; rbase = (j / 128) * 256 + 128 + (j % 128); } }
    const int c = lane & 7;
#pragma unroll
    for (int j = 0; j < 4; ++j) { const int n = (lane >> 3) + 8 * j; const LAS float* s = scr + (8 * c) * 33 + n;
        v4u o; o.x = pkbf(s[0 * 33], s[1 * 33]); o.y = pkbf(s[2 * 33], s[3 * 33]); o.z = pkbf(s[4 * 33], s[5 * 33]); o.w = pkbf(s[6 * 33], s[7 * 33]);
        *(GAS v4u*)(WT + (size_t)(rbase + n) * K + k0 + 8 * c) = o; }
    asm volatile("s_waitcnt lgkmcnt(0)" ::: "memory");
}

__device__ __forceinline__ void phase0(const Args& a, LAS unsigned char* lds, int vcu, int G, int wave, int lane, int tid) {
    unsigned char* ws = a.ws;
    LAS float* scr = (LAS float*)(lds + wave * 16384);
    const int gw = vcu * NWAVES + wave, NGW = G * NWAVES;
    constexpr int I_IN = (DM / 64) * (INW / 32), I_OUT = (DM / 64) * (DM / 32), I_GU = (DM / 64) * (2 * FFH / 32), I_DN = (FFH / 64) * (DM / 32);
    constexpr int NITEMS = I_IN + I_OUT + I_GU + I_DN;
    for (int it = gw; it < NITEMS; it += NGW) {
        int r = it;
        if (r < I_IN) { p0_transpose_item(a.w_in, DM, INW, (bf16*)(ws + WS_WIN), 0, nullptr, scr, r, lane); continue; } r -= I_IN;
        if (r < I_OUT) { p0_transpose_item(a.w_out, DM, DM, (bf16*)(ws + WS_WOUT), 0, nullptr, scr, r, lane); continue; } r -= I_OUT;
        if (r < I_GU) { p0_transpose_item(a.w_gate_up, DM, 2 * FFH, (bf16*)(ws + WS_WGU), 1, a.norm_ffn_g, scr, r, lane); continue; } r -= I_GU;
        p0_transpose_item(a.w_down, FFH, DM, (bf16*)(ws + WS_WDN), 0, nullptr, scr, r, lane);
    }
    const int gt = vcu * (NWAVES * 64) + tid, NGT = G * NWAVES * 64;
    { bf16* Wl = (bf16*)(ws + WS_WLRU);
      for (int e = gt; e < 8 * 256 * 64; e += NGT) { const int h = e >> 14, o = (e >> 6) & 255, i = e & 63, g4 = o >> 6, j = o & 63, d = g4 >> 1;
          const float* src = (g4 & 1) ? a.lru_w_x : a.lru_w_a; Wl[e] = (bf16)(pkbf(src[((size_t)(d * 8 + h) * 64 + i) * 64 + j], 0.f) & 0xffffu); } }
    if (gt == 0) { float mq = 0.f, mk = 0.f; for (int e = 0; e < 64; ++e) { mq = fmaxf(mq, fabsf(a.q_norm_g[e])); mk = fmaxf(mk, fabsf(a.k_norm_g[e])); }
        *(float*)(ws + WS_NEGM) = -(8.0f * 1.4426950408889634f * mq * mk * 1.02f + 0.5f); }
    { unsigned* cnt = (unsigned*)(ws + WS_CNT); for (int e = gt; e < 384 * 64; e += NGT) cnt[e] = 0u; }
    { float* nl = (float*)(ws + WS_NL); for (int e = gt; e < 2 * LRUW; e += NGT) nl[e] = -8.0f * log1pf(expf(-a.lru_lam[e])); }
    { float* ct = (float*)(ws + WS_COS); float* st = (float*)(ws + WS_SIN);
      for (int e = gt; e < SEQ * 32; e += NGT) { const int t = e >> 5, k = e & 31, pos = (k < 16) ? (t >> 6) : (t & 63), i = k & 15;
          const float freq = __builtin_amdgcn_exp2f(-(float)i * (13.287712379549449f / 16.0f));
          const float rev = (float)pos * freq * 0.15915494309189535f; const float fr = rev - rintf(rev);
          ct[e] = __builtin_amdgcn_cosf(fr); st[e] = __builtin_amdgcn_sinf(fr); } }
    { bf16* XN = (bf16*)(ws + WS_XN);
      f32x4 g4[4];
#pragma unroll
      for (int j = 0; j < 4; ++j) g4[j] = *((const f32x4*)a.norm_mix_g + lane + 64 * j);
      for (int r = gw; r < MP; r += NGW) {
          GAS unsigned long long* o8 = (GAS unsigned long long*)(XN + (size_t)r * DM) + lane;
          if (r >= TNAT) {
#pragma unroll
              for (int j = 0; j < 4; ++j) o8[64 * j] = 0ull;
              continue; }
          const int b = r / LSEQ, p = r - b * LSEQ;
          const float* src = (p < NMETA) ? a.meta + (size_t)p * DM : (b < 8 ? a.x_prompt + ((size_t)b * SEQ + (p - NMETA)) * DM : a.x_sample + ((size_t)(b - 8) * SEQ + (p - NMETA)) * DM);
          const f32x4* xr = (const f32x4*)src + lane; f32x4 v[4]; float s = 0.f;
#pragma unroll
          for (int j = 0; j < 4; ++j) { v[j] = xr[64 * j]; s += (v[j][0] * v[j][0] + v[j][1] * v[j][1]) + (v[j][2] * v[j][2] + v[j][3] * v[j][3]); }
          const float rstd = __builtin_amdgcn_rsqf(wave_sum(s) * (1.0f / DM) + 1e-6f);
#pragma unroll
          for (int j = 0; j < 4; ++j) { const f32x4 y = v[j] * rstd * g4[j]; o8[64 * j] = (unsigned long long)pkbf(y[0], y[1]) | ((unsigned long long)pkbf(y[2], y[3]) << 32); }
      } }
}

__device__ __forceinline__ void phase_qk(const Args& a, int vcu, int G, int wave, int lane) {
    bf16* proj = (bf16*)(a.ws + WS_PROJ); const float* ct = (const float*)(a.ws + WS_COS); const float* st = (const float*)(a.ws + WS_SIN);
    const int gw = vcu * NWAVES + wave, NGW = G * NWAVES; const int sub = lane >> 3, j = lane & 7;
    constexpr int NGRP = TNAT * 2 / 8;
    for (int grp = gw; grp < NGRP; grp += NGW) {
        const int item = grp * 8 + sub, row = item >> 1, hh = 8 + (item & 1);
        bf16* ptr = proj + (size_t)row * INW + hh * 64 + j * 8;
        const v4u raw = *(const v4u*)ptr;
        float x[8] = {bflo(raw.x), bfhi(raw.x), bflo(raw.y), bfhi(raw.y), bflo(raw.z), bfhi(raw.z), bflo(raw.w), bfhi(raw.w)};
        float ss = 0.f;
#pragma unroll
        for (int e = 0; e < 8; ++e) ss += x[e] * x[e];
        ss += __shfl_xor(ss, 1); ss += __shfl_xor(ss, 2); ss += __shfl_xor(ss, 4);
        const float rstd = __builtin_amdgcn_rsqf(ss * (1.0f / 64.0f) + 1e-6f);
        const float* gp = (hh < 8 ? a.q_norm_g : a.k_norm_g) + j * 8;
        const f32x4 g0 = *(const f32x4*)gp, g1 = *(const f32x4*)(gp + 4);
        float y[8];
#pragma unroll
        for (int e = 0; e < 8; ++e) y[e] = x[e] * rstd * (e < 4 ? g0[e] : g1[e - 4]);
        const int b = row / LSEQ, p = row - b * LSEQ;
        float c[8], s[8];
        if (p >= NMETA) { const int toff = (p - NMETA) * 32 + (j >> 2) * 16 + (j & 1) * 8;
            const f32x4 c0 = *(const f32x4*)(ct + toff), c1 = *(const f32x4*)(ct + toff + 4), s0 = *(const f32x4*)(st + toff), s1 = *(const f32x4*)(st + toff + 4);
#pragma unroll
            for (int e = 0; e < 4; ++e) { c[e] = c0[e]; c[e + 4] = c1[e]; s[e] = s0[e]; s[e + 4] = s1[e]; }
        } else {
#pragma unroll
            for (int e = 0; e < 8; ++e) { c[e] = 1.f; s[e] = 0.f; } }
        const float sgn = (j & 2) ? 1.f : -1.f, sc = (hh < 8) ? QSCALE : 1.f;
        float o[8];
#pragma unroll
        for (int e = 0; e < 8; ++e) { const float py = __shfl_xor(y[e], 2); o[e] = (y[e] * c[e] + sgn * py * s[e]) * sc; }
        v4u w; w.x = pkbf(o[0], o[1]); w.y = pkbf(o[2], o[3]); w.z = pkbf(o[4], o[5]); w.w = pkbf(o[6], o[7]);
        *(v4u*)ptr = w;
    }
}

constexpr int CB_ROW = 144, CB_WAVE = CT * CB_ROW, LRU_CB = 0, LRU_CONST = NWAVES * CB_WAVE, LRU_SLAB = LRU_CONST + 11 * 512 * 4, SLAB_WAVE = 40 * 128, LRU_Y = 0, Y_ROW = 2064, LRU_PART = 0;
static_assert(LRU_SLAB + NWAVES * SLAB_WAVE <= LDS_BYTES, "lru lds");
static_assert(LSEQ == (NCH - 1) * CT + 16, "the last chunk of a sequence holds exactly one 16-token tile");
#define LRU_LOADW(dst, cgi_) do { _Pragma("unroll") for (int g4 = 0; g4 < 4; ++g4) _Pragma("unroll") for (int ks = 0; ks < 2; ++ks) \
    dst[g4][ks] = *(const bf16x8*)(Wl + (size_t)(g4 * 64 + (cgi_) * 16 + fr) * 64 + ks * 32 + 8 * fq); } while (0)
template <bool FINAL> __device__ __forceinline__ void lru_phase(const Args& a, LAS unsigned char* lds, int bx, int G, int wave, int lane, int tid) {
    const bf16* proj = (const bf16*)(a.ws + WS_PROJ);
    const int fr = lane & 15, fq = lane >> 4;
    constexpr float L2E = 1.4426950408889634f;
    { LAS float* cst = (LAS float*)(lds + LRU_CONST); const float* nl = (const float*)(a.ws + WS_NL); const int e = tid;
      cst[0 * 512 + e] = -a.lru_b_a[e] * L2E; cst[1 * 512 + e] = -a.lru_b_x[e] * L2E; cst[2 * 512 + e] = -a.lru_b_a[LRUW + e] * L2E; cst[3 * 512 + e] = -a.lru_b_x[LRUW + e] * L2E;
      cst[4 * 512 + e] = nl[e] * L2E; cst[5 * 512 + e] = nl[LRUW + e] * L2E;
      cst[6 * 512 + e] = a.conv_w[e]; cst[7 * 512 + e] = a.conv_w[LRUW + e]; cst[8 * 512 + e] = a.conv_w[2 * LRUW + e]; cst[9 * 512 + e] = a.conv_w[3 * LRUW + e]; cst[10 * 512 + e] = a.conv_b[e]; }
    __syncthreads();
    LAS unsigned char* cb = lds + LRU_CB + wave * CB_WAVE;
    const bf16* Wl = (const bf16*)(a.ws + WS_WLRU) + (size_t)wave * 256 * 64;
#define LRU_DMA_SLAB(b_, p0_) do { _Pragma("unroll") for (int k_ = 0; k_ < 5; ++k_) { int pp_ = (p0_) - 2 + 8 * k_ + (lane >> 3); pp_ = pp_ < 0 ? 0 : (pp_ >= LSEQ ? LSEQ - 1 : pp_); \
        __builtin_amdgcn_global_load_lds((const unsigned*)(proj + ((size_t)(b_) * LSEQ + pp_) * INW + COL_LIN + 64 * wave + (lane & 7) * 8), (LAS unsigned*)(lds + LRU_SLAB + wave * SLAB_WAVE + k_ * 1024), 16, 0, 0); } } while (0)
    if (bx < NLU) { const int b0_ = bx / NCH, p00_ = (bx - b0_ * NCH) * CT; LRU_DMA_SLAB(b0_, p00_); }
    bf16x8 wall[4][4][2];
#pragma unroll
    for (int c4 = 0; c4 < 4; ++c4) LRU_LOADW(wall[c4], c4);
    for (int unit = bx; unit < NLU; unit += G) {
        const int b = unit / NCH, ci = unit - b * NCH, p0 = ci * CT; const size_t rowbase = (size_t)b * LSEQ;
        const bool lastc = (ci == NCH - 1);
        { const int j8 = lane & 7, tg = lane >> 3, ch = 64 * wave + 8 * j8;
          if (unit == bx) asm volatile("s_waitcnt vmcnt(0)" ::: "memory"); else asm volatile("s_waitcnt vmcnt(8)" ::: "memory");
          v4u raw[7];
#pragma unroll
          for (int k = 0; k < 7; ++k) { const int pp = p0 + tg * 4 + k - 2;
              const v4u r = *(const LAS v4u*)(lds + LRU_SLAB + wave * SLAB_WAVE + (tg * 4 + k) * 128 + j8 * 16); const bool ok = (pp >= 0 && pp < LSEQ);
              raw[k].x = ok ? r.x : 0u; raw[k].y = ok ? r.y : 0u; raw[k].z = ok ? r.z : 0u; raw[k].w = ok ? r.w : 0u; }
          asm volatile("s_waitcnt lgkmcnt(0)" ::: "memory");
          { const int nu = unit + G;
            if (nu < NLU) { const int nb = nu / NCH, np0 = (nu - nb * NCH) * CT; LRU_DMA_SLAB(nb, np0); } }
          const LAS float* cc = (const LAS float*)(lds + LRU_CONST) + 6 * 512 + ch;
          float acc[4][8];
          { const f32x4 b0 = *(const LAS f32x4*)(cc + 4 * 512), b1 = *(const LAS f32x4*)(cc + 4 * 512 + 4);
#pragma unroll
            for (int o = 0; o < 4; ++o)
#pragma unroll
                for (int e = 0; e < 4; ++e) { acc[o][e] = b0[e]; acc[o][e + 4] = b1[e]; } }
#pragma unroll
          for (int jj = 0; jj < 4; ++jj) { const f32x4 w0 = *(const LAS f32x4*)(cc + jj * 512), w1 = *(const LAS f32x4*)(cc + jj * 512 + 4);
#pragma unroll
              for (int o = 0; o < 4; ++o) { const v4u r = raw[o + jj];
                  acc[o][0] += w0[0] * bflo(r.x); acc[o][1] += w0[1] * bfhi(r.x); acc[o][2] += w0[2] * bflo(r.y); acc[o][3] += w0[3] * bfhi(r.y);
                  acc[o][4] += w1[0] * bflo(r.z); acc[o][5] += w1[1] * bfhi(r.z); acc[o][6] += w1[2] * bflo(r.w); acc[o][7] += w1[3] * bfhi(r.w); } }
#pragma unroll
          for (int o = 0; o < 4; ++o) { v4u w; w.x = pkbf(acc[o][0], acc[o][1]); w.y = pkbf(acc[o][2], acc[o][3]); w.z = pkbf(acc[o][4], acc[o][5]); w.w = pkbf(acc[o][6], acc[o][7]);
              *(LAS v4u*)(cb + (tg * 4 + o) * CB_ROW + j8 * 16) = w; }
        }
        asm volatile("s_waitcnt lgkmcnt(0)" ::: "memory");
        float ssq[2] = {0.f, 0.f};
#pragma unroll
        for (int cgi = 0; cgi < 4; ++cgi) {
            const int chl = cgi * 16 + 4 * fq, ch = 64 * wave + chl;
            f32x4 cf, cbk; v2u graw[2];
            if constexpr (FINAL) { const float* carry = (const float*)(a.ws + WS_CARRY) + (size_t)unit * 1024; cf = *(const f32x4*)(carry + ch); cbk = *(const f32x4*)(carry + LRUW + ch);
#pragma unroll
                for (int tt = 0; tt < 2; ++tt) { const int p = p0 + tt * 16 + fr; graw[tt] = (p < LSEQ) ? *(const v2u*)(proj + (rowbase + p) * INW + COL_LG + ch) : (v2u){0u, 0u}; } }
            const LAS float* cst = (const LAS float*)(lds + LRU_CONST) + ch;
            const f32x4 baf = *(const LAS f32x4*)(cst), bxf = *(const LAS f32x4*)(cst + 512), bab = *(const LAS f32x4*)(cst + 1024), bxb = *(const LAS f32x4*)(cst + 1536), nlf = *(const LAS f32x4*)(cst + 2048), nlb = *(const LAS f32x4*)(cst + 2560);
            float AF[2][4], UF[2][4], AB[2][4], UB[2][4];
#pragma unroll
            for (int tt = 0; tt < 2; ++tt) {
                if (tt == 1 && lastc) {
#pragma unroll
                    for (int i = 0; i < 4; ++i) { AF[1][i] = 1.f; UF[1][i] = 0.f; AB[1][i] = 1.f; UB[1][i] = 0.f; }
                } else {
                const LAS unsigned char* crow = cb + (tt * 16 + fr) * CB_ROW;
                const bf16x8 b0 = *(const LAS bf16x8*)(crow + fq * 16), b1 = *(const LAS bf16x8*)(crow + 64 + fq * 16);
                f32x4 pre[4];
#pragma unroll
                for (int g4 = 0; g4 < 4; ++g4) { pre[g4] = __builtin_amdgcn_mfma_f32_16x16x32_bf16(wall[cgi][g4][0], b0, (f32x4){0.f, 0.f, 0.f, 0.f}, 0, 0, 0);
                    pre[g4] = __builtin_amdgcn_mfma_f32_16x16x32_bf16(wall[cgi][g4][1], b1, pre[g4], 0, 0, 0); }
                const v2u craw = *(const LAS v2u*)(crow + chl * 2);
                const float cv[4] = {bflo(craw.x), bfhi(craw.x), bflo(craw.y), bfhi(craw.y)};
#pragma unroll
                for (int i = 0; i < 4; ++i) {
                    const float rf = __builtin_amdgcn_rcpf(1.0f + __builtin_amdgcn_exp2f(fmaf(pre[0][i], -L2E, baf[i])));
                    const float xf = __builtin_amdgcn_rcpf(1.0f + __builtin_amdgcn_exp2f(fmaf(pre[1][i], -L2E, bxf[i])));
                    const float rb = __builtin_amdgcn_rcpf(1.0f + __builtin_amdgcn_exp2f(fmaf(pre[2][i], -L2E, bab[i])));
                    const float xb = __builtin_amdgcn_rcpf(1.0f + __builtin_amdgcn_exp2f(fmaf(pre[3][i], -L2E, bxb[i])));
                    const float af = __builtin_amdgcn_exp2f(nlf[i] * rf), ab = __builtin_amdgcn_exp2f(nlb[i] * rb);
                    AF[tt][i] = af; AB[tt][i] = ab;
                    UF[tt][i] = __builtin_amdgcn_sqrtf(fmaf(-af, af, 1.0f)) * (xf * cv[i]); UB[tt][i] = __builtin_amdgcn_sqrtf(fmaf(-ab, ab, 1.0f)) * (xb * cv[i]);
                }
                }
                scan4_fwd16(AF[tt], UF[tt]); scan4_bwd16(AB[tt], UB[tt]);
            }
            if constexpr (!FINAL) {
                float S[2][4], PF[2][4], PB[2][4];
#pragma unroll
                for (int i = 0; i < 4; ++i) {
                    const float A0t = __shfl(AF[0][i], 15, 16), B0t = __shfl(UF[0][i], 15, 16), A1t = __shfl(AB[1][i], 0, 16), B1t = __shfl(UB[1][i], 0, 16);
                    PF[0][i] = AF[0][i]; PF[1][i] = AF[1][i] * A0t; const float hf0 = UF[0][i], hf1 = fmaf(AF[1][i], B0t, UF[1][i]);
                    PB[1][i] = AB[1][i]; PB[0][i] = AB[0][i] * A1t; const float hb1 = UB[1][i], hb0 = fmaf(AB[0][i], B1t, UB[0][i]);
                    S[0][i] = hf0 + hb0; S[1][i] = hf1 + hb1;
                    AF[1][i] = hf1; AB[0][i] = hb0; }
                float* agg = (float*)(a.ws + WS_AGG) + (size_t)unit * 2048;
                { const bool isf = (fr == 15);
                  if (isf || fr == 0) { float* dst = agg + (isf ? 0 : LRUW) + ch;
                      *(f32x4*)dst = isf ? (f32x4){PF[1][0], PF[1][1], PF[1][2], PF[1][3]} : (f32x4){PB[0][0], PB[0][1], PB[0][2], PB[0][3]};
                      *(f32x4*)(dst + 1024) = isf ? (f32x4){AF[1][0], AF[1][1], AF[1][2], AF[1][3]} : (f32x4){AB[0][0], AB[0][1], AB[0][2], AB[0][3]}; } }
#pragma unroll
                for (int tt = 0; tt < 2; ++tt) { const int p = p0 + tt * 16 + fr;
                    unsigned* sp = (unsigned*)(a.ws + WS_SP) + ((p < LSEQ) ? (rowbase + p) : (size_t)(TNAT + (p - LSEQ))) * 512 + ch;
                    v4u w;
#pragma unroll
                    for (int i = 0; i < 4; ++i) { const unsigned sb = pkbf(0.f, S[tt][i]) & 0xffff0000u;
                        const unsigned pf = (unsigned)__builtin_rintf(PF[tt][i] * 255.0f), pb = (unsigned)__builtin_rintf(PB[tt][i] * 255.0f); w[i] = sb | (pf << 8) | pb; }
                    *(v4u*)sp = w; }
            } else {
                float hs[2][4];
#pragma unroll
                for (int i = 0; i < 4; ++i) {
                    const float hf0 = fmaf(AF[0][i], cf[i], UF[0][i]); const float c1 = __shfl(hf0, 15, 16); const float hf1 = fmaf(AF[1][i], c1, UF[1][i]);
                    const float hb1 = fmaf(AB[1][i], cbk[i], UB[1][i]); const float c0 = __shfl(hb1, 0, 16); const float hb0 = fmaf(AB[0][i], c0, UB[0][i]);
                    hs[0][i] = hf0 + hb0; hs[1][i] = hf1 + hb1; }
#pragma unroll
                for (int tt = 0; tt < 2; ++tt) { const int tok = tt * 16 + fr; f32x4 y;
                    const float gv[4] = {bflo(graw[tt].x), bfhi(graw[tt].x), bflo(graw[tt].y), bfhi(graw[tt].y)};
#pragma unroll
                    for (int i = 0; i < 4; ++i) { const float g = gv[i], z = (-1.5957691216057308f * L2E) * fmaf(0.044715f * g * g, g, g);
                        y[i] = hs[tt][i] * g * __builtin_amdgcn_rcpf(1.0f + __builtin_amdgcn_exp2f(z)); }
                    ssq[tt] += (y[0] * y[0] + y[1] * y[1]) + (y[2] * y[2] + y[3] * y[3]);
                    *(LAS f32x4*)(lds + LRU_Y + tok * Y_ROW + ch * 4) = y; }
            }
        }
        if constexpr (FINAL) {
#pragma unroll
            for (int tt = 0; tt < 2; ++tt) { float s = ssq[tt]; s += __shfl_xor(s, 16); s += __shfl_xor(s, 32); if (fq == 0) *(LAS float*)(lds + LRU_PART + ((tt * 16 + fr) * 8 + wave) * 4) = s; }
            __syncthreads();
            { const int tok = tid >> 4, seg = tid & 15, p = p0 + tok;
              if (p >= NMETA && p < LSEQ) {
                  const LAS f32x4* pp = (const LAS f32x4*)(lds + LRU_PART + tok * 32); const f32x4 s0 = pp[0], s1 = pp[1];
                  const float tot = ((s0[0] + s0[1]) + (s0[2] + s0[3])) + ((s1[0] + s1[1]) + (s1[2] + s1[3]));
                  const float rstd = __builtin_amdgcn_rsqf(tot * (1.0f / LRUW) + 1e-6f);
                  bf16* orow = (bf16*)(a.ws + WS_XN) + ((size_t)b * SEQ + (p - NMETA)) * DM + LRUW;
#pragma unroll
                  for (int k = 0; k < 4; ++k) { const int ch = k * 128 + seg * 8;
                      const LAS f32x4* yp = (const LAS f32x4*)(lds + LRU_Y + tok * Y_ROW + ch * 4); const f32x4 y0 = yp[0], y1 = yp[1];
                      const f32x4 g0 = *(const f32x4*)(a.lru_out_g + ch), g1 = *(const f32x4*)(a.lru_out_g + ch + 4);
                      v4u w; w.x = pkbf(y0[0] * rstd * g0[0], y0[1] * rstd * g0[1]); w.y = pkbf(y0[2] * rstd * g0[2], y0[3] * rstd * g0[3]);
                      w.z = pkbf(y1[0] * rstd * g1[0], y1[1] * rstd * g1[1]); w.w = pkbf(y1[2] * rstd * g1[2], y1[3] * rstd * g1[3]);
                      *(v4u*)(orow + ch) = w; } } }
            __syncthreads();
        }
    }
    __syncthreads();
}

__device__ __forceinline__ void mix_norm_phase(const Args& a, int vcu, int G, int wave, int lane) {
    const bf16* proj = (const bf16*)(a.ws + WS_PROJ); const unsigned* SP = (const unsigned*)(a.ws + WS_SP); const float* carry = (const float*)(a.ws + WS_CARRY); bf16* mix = (bf16*)(a.ws + WS_XN);
    const int gw = vcu * NWAVES + wave, NGW = G * NWAVES, ch = lane * 8; constexpr float L2E = 1.4426950408889634f;
    const f32x4 ga0 = *(const f32x4*)(a.attn_out_g + ch), ga1 = *(const f32x4*)(a.attn_out_g + ch + 4), gl0 = *(const f32x4*)(a.lru_out_g + ch), gl1 = *(const f32x4*)(a.lru_out_g + ch + 4);
    for (int r = gw; r < MC; r += NGW) {
        const int b = r >> 13, p = (r & 8191) + NMETA; const size_t nat = (size_t)b * LSEQ + p; const int unit = b * NCH + (p >> 5);
        bf16* mrow = mix + (size_t)r * DM;
        const v4u ao = *(const v4u*)(mrow + ch);
        const v4u sp0 = *(const v4u*)(SP + nat * 512 + ch), sp1 = *(const v4u*)(SP + nat * 512 + ch + 4), gr = *(const v4u*)(proj + nat * INW + COL_LG + ch);
        const float* cp = carry + (size_t)unit * 1024 + ch;
        const f32x4 cf0 = *(const f32x4*)cp, cf1 = *(const f32x4*)(cp + 4), cb0 = *(const f32x4*)(cp + 512), cb1 = *(const f32x4*)(cp + 516);
        { float x[8] = {bflo(ao.x), bfhi(ao.x), bflo(ao.y), bfhi(ao.y), bflo(ao.z), bfhi(ao.z), bflo(ao.w), bfhi(ao.w)}; float s = 0.f;
#pragma unroll
          for (int e = 0; e < 8; ++e) s += x[e] * x[e];
          const float rstd = __builtin_amdgcn_rsqf(wave_sum(s) * (1.0f / 512.0f) + 1e-6f);
          v4u w; w.x = pkbf(x[0] * rstd * ga0[0], x[1] * rstd * ga0[1]); w.y = pkbf(x[2] * rstd * ga0[2], x[3] * rstd * ga0[3]);
          w.z = pkbf(x[4] * rstd * ga1[0], x[5] * rstd * ga1[1]); w.w = pkbf(x[6] * rstd * ga1[2], x[7] * rstd * ga1[3]);
          *(v4u*)(mrow + ch) = w; }
        { const unsigned spw[8] = {sp0.x, sp0.y, sp0.z, sp0.w, sp1.x, sp1.y, sp1.z, sp1.w};
          float S[8], PF[8], PB[8];
#pragma unroll
          for (int e = 0; e < 8; ++e) { S[e] = __uint_as_float(spw[e] & 0xffff0000u); PF[e] = (float)((spw[e] >> 8) & 255u) * (1.0f / 255.0f); PB[e] = (float)(spw[e] & 255u) * (1.0f / 255.0f); }
          const float gv[8] = {bflo(gr.x), bfhi(gr.x), bflo(gr.y), bfhi(gr.y), bflo(gr.z), bfhi(gr.z), bflo(gr.w), bfhi(gr.w)};
          float y[8]; float s = 0.f;
#pragma unroll
          for (int e = 0; e < 8; ++e) { const float cf = e < 4 ? cf0[e & 3] : cf1[e & 3], cbk = e < 4 ? cb0[e & 3] : cb1[e & 3];
              const float h = fmaf(PF[e], cf, fmaf(PB[e], cbk, S[e])); const float g = gv[e], z = (-1.5957691216057308f * L2E) * fmaf(0.044715f * g * g, g, g);
              y[e] = h * g * __builtin_amdgcn_rcpf(1.0f + __builtin_amdgcn_exp2f(z)); s += y[e] * y[e]; }
          const float rstd = __builtin_amdgcn_rsqf(wave_sum(s) * (1.0f / 512.0f) + 1e-6f);
          v4u w; w.x = pkbf(y[0] * rstd * gl0[0], y[1] * rstd * gl0[1]); w.y = pkbf(y[2] * rstd * gl0[2], y[3] * rstd * gl0[3]);
          w.z = pkbf(y[4] * rstd * gl1[0], y[5] * rstd * gl1[1]); w.w = pkbf(y[6] * rstd * gl1[2], y[7] * rstd * gl1[3]);
          *(v4u*)(mrow + LRUW + ch) = w; }
    }
}

__device__ __forceinline__ void lru_carry(const Args& a, LAS unsigned char* lds, int g, int tid) {
    const float* __restrict__ agg = (const float*)(a.ws + WS_AGG); float* __restrict__ carry = (float*)(a.ws + WS_CARRY);
    const int b = g >> 4, dc0 = (g & 15) * 64, dir = dc0 >> 9;
    const int lane = tid & 63, wv = __builtin_amdgcn_readfirstlane(tid >> 6);
    LAS float* sm = (LAS float*)lds;
    { const int sub = lane >> 4, j = lane & 15;
      for (int k = wv; k < (NCH + 1) / 2; k += NWAVES) { int ci = 2 * k + (sub >> 1); ci = ci < NCH ? ci : NCH - 1;
          __builtin_amdgcn_global_load_lds((const unsigned*)(agg + (size_t)(b * NCH + ci) * 2048 + (sub & 1) * 1024 + dc0 + j * 4), (LAS unsigned*)(lds + k * 1024), 16, 0, 0); } }
    asm volatile("s_waitcnt vmcnt(0)" ::: "memory");
    __syncthreads();
    LAS float* seg = (LAS float*)(lds + 258 * 512);
    const int q0 = 33 * wv, q1 = (q0 + 33 < NCH) ? q0 + 33 : NCH;
    { float As = 1.f, Bs = 0.f;
      for (int q = q0; q < q1; ++q) { const int ci = dir ? (NCH - 1 - q) : q; const float A = sm[ci * 128 + lane], B = sm[ci * 128 + 64 + lane]; Bs = fmaf(A, Bs, B); As *= A; }
      seg[wv * 128 + lane] = As; seg[wv * 128 + 64 + lane] = Bs; }
    __syncthreads();
    { float h = 0.f;
      for (int v = 0; v < wv; ++v) h = fmaf(seg[v * 128 + lane], h, seg[v * 128 + 64 + lane]);
      float* cp = carry + (size_t)b * NCH * 1024 + dc0 + lane;
      for (int q = q0; q < q1; ++q) { const int ci = dir ? (NCH - 1 - q) : q; const float A = sm[ci * 128 + lane], B = sm[ci * 128 + 64 + lane]; cp[(size_t)ci * 1024] = h; h = fmaf(A, h, B); } }
    __syncthreads();
}

#define XB_TMO      128
#define XB_XCNT(j)  (256  + 64 * (j))
#define XB_XSUB(j)  (1280 + 64 * (j))
#define XB_XGEN(j)  (2304 + 64 * (j))
#define XB_TOP      3328
#define XB_TOPGEN   3392
#define XCD_BAR_WORDS 3456
#define XB_SPIN_CAP (1u << 18)

__device__ __forceinline__ unsigned xb_ld(unsigned* p)              { return __hip_atomic_load(p, __ATOMIC_RELAXED, __HIP_MEMORY_SCOPE_AGENT); }
__device__ __forceinline__ unsigned xb_add(unsigned* p, unsigned v) { return __hip_atomic_fetch_add(p, v, __ATOMIC_RELAXED, __HIP_MEMORY_SCOPE_AGENT); }
__device__ __forceinline__ unsigned xb_xcc_id() { return (unsigned)__builtin_amdgcn_s_getreg((3 << 11) | 20) & 0xFu; }
#define XB_SPIN(cond, bar) do { unsigned _sp = 0; while (cond) { __builtin_amdgcn_s_sleep(1); \
    if ((++_sp & 255u) == 0u) { if (xb_ld(&(bar)[XB_TMO])) break; if (_sp > XB_SPIN_CAP) { atomicAdd(&(bar)[XB_TMO], 1u); break; } } } } while (0)

struct XcdBarrier {
    unsigned* bar; unsigned x;
    volatile LAS unsigned* st;
};

__device__ __forceinline__ XcdBarrier xcd_barrier_post(unsigned* bar, volatile LAS unsigned* st) {
    XcdBarrier b; b.bar = bar; b.x = xb_xcc_id(); b.st = st;
    if (threadIdx.x == 0) (void)xb_add(&bar[XB_XCNT(b.x)], 1u);
    return b;
}
__device__ __forceinline__ void xcd_barrier_complete(unsigned* bar, unsigned x, unsigned& nloc, unsigned& nx) {
    const unsigned G = gridDim.x * gridDim.y * gridDim.z;
    unsigned sum, cnt, mine, sp = 0u;
    for (;;) {
        sum = 0u; cnt = 0u; mine = 0u;
#pragma unroll
        for (unsigned j = 0; j < 16; ++j) { const unsigned c = xb_ld(&bar[XB_XCNT(j)]); sum += c; cnt += (c > 0u) ? 1u : 0u; mine = (j == x) ? c : mine; }
        if (sum == G) break;
        __builtin_amdgcn_s_sleep(1);
        if ((++sp & 255u) == 0u) { if (xb_ld(&bar[XB_TMO])) break; if (sp > XB_SPIN_CAP) { atomicAdd(&bar[XB_TMO], 1u); break; } }
    }
    nloc = mine > 0u ? mine : 1u; nx = cnt > 0u ? cnt : 1u;
}

__device__ __forceinline__ void xcd_barrier(const XcdBarrier& b) {
    asm volatile("s_waitcnt vmcnt(0)" ::: "memory");
    __syncthreads();
    if (threadIdx.x == 0) {
        unsigned* bar = b.bar;
        __builtin_amdgcn_s_waitcnt(0);
        unsigned nloc = b.st[0], nx = b.st[1];
        if (nloc == 0u) { xcd_barrier_complete(bar, b.x, nloc, nx); b.st[0] = nloc; b.st[1] = nx; }
        const unsigned old = xb_add(&bar[XB_XSUB(b.x)], 1u);
        const unsigned gen = old / nloc;
        if (old + 1u == (gen + 1u) * nloc) {
            __builtin_amdgcn_fence(__ATOMIC_RELEASE, "agent");
            asm volatile("s_waitcnt vmcnt(0)" ::: "memory");
            const unsigned og = xb_add(&bar[XB_TOP], 1u);
            const unsigned tg = og / nx;
            if (og + 1u == (tg + 1u) * nx) xb_add(&bar[XB_TOPGEN], 1u);
            else XB_SPIN(xb_ld(&bar[XB_TOPGEN]) == tg, bar);
            __builtin_amdgcn_fence(__ATOMIC_ACQUIRE, "agent");
            xb_add(&bar[XB_XGEN(b.x)], 1u);
            asm volatile("s_waitcnt vmcnt(0)" ::: "memory");
        } else {
            XB_SPIN(xb_ld(&bar[XB_XGEN(b.x)]) == gen, bar);
            __builtin_amdgcn_fence(__ATOMIC_ACQUIRE, "agent");
            asm volatile("s_waitcnt vmcnt(0)" ::: "memory");
        }
    }
    __syncthreads();
}

__global__ void __launch_bounds__(NWAVES * 64, 2) hymba_fwd(Args a) {
    extern __shared__ __attribute__((aligned(16))) unsigned char lds_raw[];
    LAS unsigned char* lds = (LAS unsigned char*)lds_raw;
    cg::grid_group grid = cg::this_grid();
    const int wave = __builtin_amdgcn_readfirstlane((int)threadIdx.x >> 6);
#define FRESH_IDS const int lane = fresh_lane(), tid = wave * 64 + lane; (void)tid; (void)lane
    const int G = gridDim.x, bx = blockIdx.x, vcu = (G % 8 == 0) ? (bx % 8) * (G / 8) + bx / 8 : bx;
    volatile LAS unsigned* bst = (volatile LAS unsigned*)(lds + LDS_BYTES - 32);
    if (threadIdx.x < 2) bst[threadIdx.x] = 0u;
    __syncthreads();
    XcdBarrier bar = xcd_barrier_post((unsigned*)a.ws + a.ph_lo * 4096, bst);
    unsigned char* ws = a.ws;
    const int lo = a.ph_lo, hi = a.ph_hi;
#define IN(k) (lo <= (k) && (k) < hi)
#define SEAM(k) do { if (IN(k) && IN((k) + 1)) xcd_barrier(bar); } while (0)
    if (a.ph_hi > 1000) grid.sync();

    if (IN(0)) { FRESH_IDS; phase0(a, lds, vcu, G, wave, lane, tid); }
    SEAM(0);
    if (IN(1)) {
        pg8::Gemm g{(const pg8::bf16_t*)(ws + WS_XN), (const pg8::bf16_t*)(ws + WS_WIN), MP, INW, DM}; pg8::StaticOrder S; S.init(MP, INW, G, bx);
        pg8::EpiStore E{(pg8::bf16_t*)(ws + WS_PROJ), INW};
        pg8::gemm_phase<pg8::EpiStore, pg8::StaticOrder, true, true>(lds, g, S, E, wave);
    }
    SEAM(1);
    if (IN(2)) {
        { FRESH_IDS; phase_qk(a, vcu, G, wave, lane); }
        { FRESH_IDS; lru_phase<false>(a, lds, bx, G, wave, lane, tid); }
    }
    SEAM(2);
    if (IN(3)) {
        for (int g = bx; g < 192; g += G) { FRESH_IDS; lru_carry(a, lds, g, tid); }
        const float negM = *(const float*)(ws + WS_NEGM);
        const attn_body::bf16* proj = (const attn_body::bf16*)(ws + WS_PROJ); attn_body::bf16* mix = (attn_body::bf16*)(ws + WS_XN);
        if (G == 256) {
            const int x = bx & 7, jl = bx >> 3;
            for (int i = 0; i < 12; ++i) { const int pi = x + 8 * (i >> 2), w = jl * 4 + (i & 3), b = pi >> 1, kvh = pi & 1, h = kvh * 4 + (w >> 5), qb = w & 31;
                attn_body::attn_unit<8>(proj + ((size_t)b * LSEQ + NMETA + qb * 256) * INW + h * 64, proj + (size_t)b * LSEQ * INW + COL_K + kvh * 64, proj + (size_t)b * LSEQ * INW + COL_V + kvh * 64,
                                        mix + ((size_t)b * SEQ + qb * 256) * DM + h * 64, (char*)lds_raw, negM, wave, a.q_norm_g, (const float*)(ws + WS_COS), (const float*)(ws + WS_SIN), qb * 256); }
        } else {
            for (int u = bx; u < NSEQ * 8 * 32; u += G) { const int b = u >> 8, h = (u >> 5) & 7, qb = u & 31, kvh = h >> 2;
                attn_body::attn_unit<8>(proj + ((size_t)b * LSEQ + NMETA + qb * 256) * INW + h * 64, proj + (size_t)b * LSEQ * INW + COL_K + kvh * 64, proj + (size_t)b * LSEQ * INW + COL_V + kvh * 64,
                                        mix + ((size_t)b * SEQ + qb * 256) * DM + h * 64, (char*)lds_raw, negM, wave, a.q_norm_g, (const float*)(ws + WS_COS), (const float*)(ws + WS_SIN), qb * 256); }
        }
    }
    SEAM(3);
    if (IN(4)) { FRESH_IDS; mix_norm_phase(a, vcu, G, wave, lane); }
    SEAM(4);
    if (IN(5)) {
        pg8::Gemm g{(const pg8::bf16_t*)(ws + WS_XN), (const pg8::bf16_t*)(ws + WS_WOUT), MC, DM, DM}; pg8::StaticOrder S; S.init(MC, DM, G, bx);
        pg8::EpiResid1 E{a.x_prompt, a.x_sample, a.out, (pg8::bf16_t*)(ws + WS_H1B), (float*)(ws + WS_SSQ1)};
        pg8::gemm_phase<pg8::EpiResid1, pg8::StaticOrder, true, true>(lds, g, S, E, wave);
    }
    SEAM(5);
    if (IN(6)) {
        pg8::Gemm g{(const pg8::bf16_t*)(ws + WS_H1B), (const pg8::bf16_t*)(ws + WS_WGU), MC, 2 * FFH, DM}; pg8::StaticOrder S; S.init(MC, 2 * FFH, G, bx);
        pg8::EpiSwiglu E{(pg8::bf16_t*)(ws + WS_HID), FFH, (const float*)(ws + WS_SSQ1)};
        pg8::gemm_phase<pg8::EpiSwiglu, pg8::StaticOrder, true, true>(lds, g, S, E, wave);
    }
    SEAM(6);
    if (IN(7)) {
        pg8::Gemm g{(const pg8::bf16_t*)(ws + WS_HID), (const pg8::bf16_t*)(ws + WS_WDN), MC, DM, FFH}; pg8::StaticOrder S; S.init(MC, DM, G, bx);
        if (G == 256) { pg8::EpiFinal E{a.out, (const pg8::bf16_t*)(ws + WS_H1B), a.final_norm_g, (float*)(ws + WS_SSQ2), (unsigned*)(ws + WS_CNT), lds + 131072};
            pg8::gemm_phase<pg8::EpiFinal, pg8::StaticOrder, true, true>(lds, g, S, E, wave); }
        else { pg8::EpiResid2 E{a.out, (float*)(ws + WS_SSQ2), (const pg8::bf16_t*)(ws + WS_H1B)};
            pg8::gemm_phase<pg8::EpiResid2, pg8::StaticOrder, true, true>(lds, g, S, E, wave); }
    }
    if (G != 256) {
    SEAM(7);
    if (IN(8)) {
        FRESH_IDS;
        const int gw = vcu * NWAVES + wave, NGW = G * NWAVES; const float* ssq = (const float*)(ws + WS_SSQ2);
        f32x4 g4[4];
#pragma unroll
        for (int j = 0; j < 4; ++j) g4[j] = *((const f32x4*)a.final_norm_g + lane + 64 * j);
        for (int r = gw; r < MC; r += NGW) { f32x4* xr = (f32x4*)(a.out + (size_t)r * DM) + lane;
            const f32x4* sp = (const f32x4*)(ssq + (size_t)r * 16); const f32x4 s0 = sp[0], s1 = sp[1], s2 = sp[2], s3 = sp[3];
            const float tot = (((s0[0] + s0[1]) + (s0[2] + s0[3])) + ((s1[0] + s1[1]) + (s1[2] + s1[3]))) + (((s2[0] + s2[1]) + (s2[2] + s2[3])) + ((s3[0] + s3[1]) + (s3[2] + s3[3])));
            const float rstd = __builtin_amdgcn_rsqf(tot * (1.0f / DM) + 1e-6f);
#pragma unroll
            for (int j = 0; j < 4; ++j) xr[64 * j] = xr[64 * j] * rstd * g4[j]; }
    }
    }
#undef IN
#undef SEAM
}

extern "C" void kernel_launch(void* const* d_in, const int* in_sizes, int n_in, void* d_out, int out_size, void* d_ws, size_t ws_size, hipStream_t stream) {
    static int grid = 0;
    if (grid == 0) {
        if (n_in != 21 || out_size != MC * DM || ws_size < WS_END) { fprintf(stderr, "kernel_launch: unexpected shapes (n_in %d out %d ws %zu)\n", n_in, out_size, ws_size); grid = -1; return; }
        int dev = 0, cus = 0, per_cu = 0;
        (void)hipGetDevice(&dev); (void)hipDeviceGetAttribute(&cus, hipDeviceAttributeMultiprocessorCount, dev);
        if (hipFuncSetAttribute((const void*)hymba_fwd, hipFuncAttributeMaxDynamicSharedMemorySize, LDS_BYTES) != hipSuccess) { fprintf(stderr, "kernel_launch: hipFuncSetAttribute failed\n"); grid = -1; return; }
        if (hipOccupancyMaxActiveBlocksPerMultiprocessor(&per_cu, (const void*)hymba_fwd, NWAVES * 64, LDS_BYTES) != hipSuccess || per_cu < 1) { fprintf(stderr, "kernel_launch: occupancy query says %d\n", per_cu); per_cu = 1; }
        (void)hipGetLastError();
        grid = cus * 1;
        if (grid <= 0) grid = 256;
    }
    if (grid < 0) return;
    (void)hipMemsetAsync(d_ws, 0, 16384 * NPHASE, stream);
    Args a{};
    const float** slots[21] = {&a.x_prompt, &a.x_sample, &a.meta, &a.norm_mix_g, &a.w_in, &a.q_norm_g, &a.k_norm_g, &a.conv_w, &a.conv_b, &a.lru_w_a, &a.lru_b_a, &a.lru_w_x, &a.lru_b_x, &a.lru_lam,
                               &a.attn_out_g, &a.lru_out_g, &a.w_out, &a.norm_ffn_g, &a.w_gate_up, &a.w_down, &a.final_norm_g};
    for (int i = 0; i < 21; ++i) *slots[i] = (const float*)d_in[i];
    a.out = (float*)d_out; a.ws = (unsigned char*)d_ws;
#if MK_N_LAUNCHES == 1
    a.ph_lo = 0; a.ph_hi = NPHASE;
    void* args[] = {&a};
    hipError_t e = hipLaunchCooperativeKernel((const void*)hymba_fwd, dim3(grid), dim3(NWAVES * 64), args, LDS_BYTES, stream);
    if (e != hipSuccess) fprintf(stderr, "kernel_launch: cooperative launch failed: %s (grid %d)\n", hipGetErrorString(e), grid);
#else
    for (int p = 0; p < NPHASE; ++p) { a.ph_lo = p; a.ph_hi = p + 1; hipLaunchKernelGGL(hymba_fwd, dim3(grid), dim3(NWAVES * 64), LDS_BYTES, stream, a); }
#endif
}
```

```cpp
#include <hip/hip_runtime.h>
#include <hip/hip_cooperative_groups.h>
#include <hip/hip_bf16.h>
#include <cstdio>
#include <cstdint>
#include <cmath>
namespace cg = cooperative_groups;
__device__ __forceinline__ int fresh_lane() { int l; asm volatile("v_mbcnt_lo_u32_b32 %0, -1, 0\n\tv_mbcnt_hi_u32_b32 %0, -1, %0" : "=v"(l)); return l; }

namespace pg8 {
#define PG8_LAS __attribute__((address_space(3)))
typedef unsigned short bf16_t;
typedef short bf16x8 __attribute__((ext_vector_type(8)));
typedef float f32x4 __attribute__((ext_vector_type(4)));
typedef unsigned u32x4 __attribute__((ext_vector_type(4)));
constexpr int BM = 256, BK = 64, HALF = 128, HTB = HALF * BK * 2  , STAGE_BYTES = 8 * HTB, NXCD = 8, WGM = 8;

__host__ __device__ __forceinline__ int lds_byte(int r, int c) { const int st = (r >> 4) * 2 + (c >> 5), rr = r & 15, cc = c & 31, ob = rr * 64 + cc * 2; return st * 1024 + (ob ^ (((ob >> 9) & 1) << 5)); }
__host__ __device__ __forceinline__ void stage_rc(int b, int& R, int& C) { const int st = b / 1024, sb = b % 1024, swz = sb ^ (((sb >> 9) & 1) << 5); R = (st >> 1) * 16 + swz / 64; C = (st & 1) * 32 + (swz % 64) / 2; }
__host__ __device__ __forceinline__ int perm32(int rho) { const int n = rho >> 4, i = rho & 15; return 8 * (i >> 2) + 4 * n + (i & 3); }

struct Unit { int pm, pn; };
struct Gemm { const bf16_t* A; const bf16_t* Bt; int M, N, K; };

struct StaticOrder {
    int nM, nN, nwg, G, c;
    __host__ __device__ void init(int M, int N, int G_, int c_) { nM = M / BM; nN = N / BM; nwg = nM * nN; G = G_; c = c_; }
    __host__ __device__ bool next(int i, Unit& u) const {
        const long L = (long)i * G + c; if (L >= nwg) return false;
        int wgid = (int)L; { const int q = nwg / NXCD, r = nwg % NXCD, xcd = wgid % NXCD, off = wgid / NXCD; wgid = (xcd < r ? xcd * (q + 1) : r * (q + 1) + (xcd - r) * q) + off; }
        const int nig = WGM * nN, gid = wgid / nig, fm = gid * WGM, gsz = (nM - fm) < WGM ? (nM - fm) : WGM;
        u.pm = fm + ((wgid % nig) % gsz); u.pn = (wgid % nig) / gsz; return true;
    }
    __device__ __forceinline__ void a_ready(const Unit&) const {}
    __device__ __forceinline__ void done(const Unit&) const {}
};


template <class Epi, class Sched, bool ALIGN_EPI = false, bool SP2 = false>
__device__ __forceinline__ void gemm_phase(PG8_LAS unsigned char* lds, const Gemm g, const Sched& S, const Epi& E, const int wid) {
    const int lane = fresh_lane(), tid = wid * 64 + lane, wr = wid >> 2, wc = wid & 3, fr = lane & 15, fq = lane >> 4;
    const int K = g.K, nt = K / BK;
    unsigned voffA[2], voffB[2];
#pragma unroll
    for (int i = 0; i < 2; ++i) { int R, C; stage_rc(tid * 16 + i * 8192, R, C); const int Rb = Epi::PERM ? ((R & ~31) + perm32(R & 31)) : R;
        voffA[i] = (unsigned)(R * K + C) * 2u; voffB[i] = (unsigned)(Rb * K + C) * 2u; }
    const size_t kstep = (size_t)(BK * 2);
    const size_t hstep = (size_t)HALF * K * 2;
    const size_t tstep = 2 * hstep;
    const unsigned ldsw = (unsigned)wid * 1024u;
    const int aoff = lds_byte(wr * 64 + fr, fq * 8), boff = lds_byte(wc * 32 + fr, fq * 8);
#define PG8_SA(b, h) (((b) * 2 + (h)) * HTB)
#define PG8_SB(b, h) ((4 + (b) * 2 + (h)) * HTB)
#define PG8_STAGE(bufoff, gbase, voff) do { _Pragma("unroll") for (int _i = 0; _i < 2; ++_i) \
        __builtin_amdgcn_global_load_lds((const unsigned*)((const char*)(gbase) + (voff)[_i]), (PG8_LAS unsigned*)(lds + (bufoff) + ldsw + _i * 8192), 16, 0, 0); } while (0)
#define PG8_LDA(dst, b, h) do { _Pragma("unroll") for (int m = 0; m < 4; ++m) _Pragma("unroll") for (int k = 0; k < 2; ++k) dst[m][k] = *(const PG8_LAS bf16x8*)(lds + PG8_SA(b, h) + aoff + m * 2048 + k * 1024); } while (0)
#define PG8_LDB(dst, b, h) do { _Pragma("unroll") for (int n = 0; n < 2; ++n) _Pragma("unroll") for (int k = 0; k < 2; ++k) dst[n][k] = *(const PG8_LAS bf16x8*)(lds + PG8_SB(b, h) + boff + n * 2048 + k * 1024); } while (0)
#define PG8_MMA(ai, bj, At, Bt) do { __builtin_amdgcn_s_setprio(1); _Pragma("unroll") for (int m = 0; m < 4; ++m) _Pragma("unroll") for (int n = 0; n < 2; ++n) _Pragma("unroll") for (int k = 0; k < 2; ++k) \
        acc[ai][bj][m][n] = __builtin_amdgcn_mfma_f32_16x16x32_bf16(Bt[n][k], At[m][k], acc[ai][bj][m][n], 0, 0, 0); __builtin_amdgcn_s_setprio(0); } while (0)
#define PG8_WAIT_V(n) asm volatile("s_waitcnt vmcnt(" #n ")" ::: "memory")
#define PG8_WAIT_L(n) asm volatile("s_waitcnt lgkmcnt(" #n ")" ::: "memory")
#define PG8_BAR __builtin_amdgcn_s_barrier()
#define PG8_SCHED __builtin_amdgcn_sched_barrier(0)
    Unit cur, nxt; int ui = 0;
    if (!S.next(0, cur)) return;
    f32x4 acc[2][2][4][2];
#pragma unroll
    for (int a = 0; a < 2; ++a)
#pragma unroll
        for (int b = 0; b < 2; ++b)
#pragma unroll
            for (int m = 0; m < 4; ++m)
#pragma unroll
                for (int n = 0; n < 2; ++n) acc[a][b][m][n] = (f32x4){0.f, 0.f, 0.f, 0.f};
    bf16x8 At[4][2], B0[2][2], B1[2][2];
    const char* cA = (const char*)g.A + (size_t)cur.pm * tstep; const char* cB = (const char*)g.Bt + (size_t)cur.pn * tstep;
    S.a_ready(cur);
    if constexpr (SP2) {
        PG8_STAGE(PG8_SB(0, 0), cB, voffB); PG8_STAGE(PG8_SB(0, 1), cB + hstep, voffB); PG8_STAGE(PG8_SA(0, 0), cA, voffA); PG8_STAGE(PG8_SA(0, 1), cA + hstep, voffA);
        if (wr == 1) PG8_BAR;
        PG8_WAIT_V(2); PG8_BAR;
        PG8_STAGE(PG8_SB(1, 0), cB + kstep, voffB); PG8_STAGE(PG8_SA(1, 0), cA + kstep, voffA); PG8_STAGE(PG8_SB(1, 1), cB + hstep + kstep, voffB);
        PG8_WAIT_V(6); PG8_BAR;
    } else {
        PG8_STAGE(PG8_SB(0, 0), cB, voffB); PG8_STAGE(PG8_SA(0, 0), cA, voffA); PG8_STAGE(PG8_SB(0, 1), cB + hstep, voffB); PG8_STAGE(PG8_SA(0, 1), cA + hstep, voffA);
        if (wr == 1) PG8_BAR;
        PG8_WAIT_V(4); PG8_BAR;
        PG8_STAGE(PG8_SB(1, 0), cB + kstep, voffB); PG8_STAGE(PG8_SA(1, 0), cA + kstep, voffA); PG8_STAGE(PG8_SB(1, 1), cB + hstep + kstep, voffB);
        PG8_WAIT_V(6); PG8_BAR;
    }
    for (;;) {
        const bool has_next = S.next(ui + 1, nxt);
        const char* nA = has_next ? (const char*)g.A + (size_t)nxt.pm * tstep : cA; const char* nB = has_next ? (const char*)g.Bt + (size_t)nxt.pn * tstep : cB;
        for (int t = 0; t < nt; t += 2) {
            const bool last = (t == nt - 2);
            const char* a1 = cA + (size_t)(t + 1) * kstep;
            const char* a2 = last ? nA : cA + (size_t)(t + 2) * kstep; const char* b2 = last ? nB : cB + (size_t)(t + 2) * kstep;
            const char* a3 = a2 + kstep; const char* b3 = b2 + kstep;
            if (last && has_next) S.a_ready(nxt);
            if constexpr (SP2) {
            PG8_LDB(B0, 0, 0); PG8_LDB(B1, 0, 1); PG8_SCHED; PG8_LDA(At, 0, 0); PG8_STAGE(PG8_SA(1, 1), a1 + hstep, voffA);
            PG8_WAIT_V(8); PG8_WAIT_L(0); PG8_BAR; PG8_MMA(0, 0, At, B0); PG8_MMA(0, 1, At, B1); PG8_BAR; PG8_SCHED;
            PG8_LDA(At, 0, 1); PG8_STAGE(PG8_SB(0, 0), b2, voffB); PG8_STAGE(PG8_SB(0, 1), b2 + hstep, voffB); PG8_STAGE(PG8_SA(0, 0), a2, voffA);
            PG8_WAIT_V(8); PG8_WAIT_L(0); PG8_BAR; PG8_MMA(1, 0, At, B0); PG8_MMA(1, 1, At, B1); PG8_BAR; PG8_SCHED;
            PG8_LDB(B0, 1, 0); PG8_LDB(B1, 1, 1); PG8_SCHED; PG8_LDA(At, 1, 0); PG8_STAGE(PG8_SA(0, 1), a2 + hstep, voffA);
            PG8_WAIT_V(8); PG8_WAIT_L(0); PG8_BAR; PG8_MMA(0, 0, At, B0); PG8_MMA(0, 1, At, B1); PG8_BAR; PG8_SCHED;
            PG8_LDA(At, 1, 1); PG8_STAGE(PG8_SB(1, 0), b3, voffB); PG8_STAGE(PG8_SB(1, 1), b3 + hstep, voffB); PG8_STAGE(PG8_SA(1, 0), a3, voffA);
            PG8_WAIT_V(8); PG8_WAIT_L(0); PG8_BAR; PG8_MMA(1, 0, At, B0); PG8_MMA(1, 1, At, B1); PG8_BAR; PG8_SCHED;
            } else {
            PG8_LDB(B0, 0, 0); PG8_SCHED; PG8_LDA(At, 0, 0); PG8_STAGE(PG8_SA(1, 1), a1 + hstep, voffA);
            PG8_WAIT_L(8); PG8_BAR; PG8_WAIT_L(0); PG8_MMA(0, 0, At, B0); PG8_BAR; PG8_SCHED;
            PG8_LDB(B1, 0, 1); PG8_STAGE(PG8_SB(0, 0), b2, voffB);
            PG8_BAR; PG8_WAIT_L(0); PG8_MMA(0, 1, At, B1); PG8_BAR;
            PG8_LDA(At, 0, 1); PG8_STAGE(PG8_SA(0, 0), a2, voffA);
            PG8_BAR; PG8_WAIT_L(0); PG8_MMA(1, 0, At, B0); PG8_BAR; PG8_SCHED;
            PG8_STAGE(PG8_SB(0, 1), b2 + hstep, voffB);
            PG8_WAIT_V(6); PG8_BAR; PG8_MMA(1, 1, At, B1); PG8_BAR;
            PG8_LDB(B0, 1, 0); PG8_SCHED; PG8_LDA(At, 1, 0); PG8_STAGE(PG8_SA(0, 1), a2 + hstep, voffA);
            PG8_WAIT_L(8); PG8_BAR; PG8_WAIT_L(0); PG8_MMA(0, 0, At, B0); PG8_BAR; PG8_SCHED;
            PG8_LDB(B1, 1, 1); PG8_STAGE(PG8_SB(1, 0), b3, voffB);
            PG8_BAR; PG8_WAIT_L(0); PG8_MMA(0, 1, At, B1); PG8_BAR;
            PG8_LDA(At, 1, 1); PG8_STAGE(PG8_SA(1, 0), a3, voffA);
            PG8_BAR; PG8_WAIT_L(0); PG8_MMA(1, 0, At, B0); PG8_BAR; PG8_SCHED;
            PG8_STAGE(PG8_SB(1, 1), b3 + hstep, voffB);
            PG8_WAIT_V(6); PG8_BAR; PG8_MMA(1, 1, At, B1); PG8_BAR;
            }
        }
        if constexpr (ALIGN_EPI) { if (wr == 0) PG8_BAR; }
        if constexpr (!Epi::AFTER_DRAIN) { E(acc, cur, wr, wc, fr, fq); S.done(cur); }
        if (!has_next) break;
#pragma unroll
        for (int a = 0; a < 2; ++a)
#pragma unroll
            for (int b = 0; b < 2; ++b)
#pragma unroll
                for (int m = 0; m < 4; ++m)
#pragma unroll
                    for (int n = 0; n < 2; ++n) acc[a][b][m][n] = (f32x4){0.f, 0.f, 0.f, 0.f};
        cur = nxt; cA = nA; cB = nB; ++ui;
        if constexpr (ALIGN_EPI) { if (wr == 1) PG8_BAR; }
    }
    PG8_WAIT_V(0);
    if constexpr (!ALIGN_EPI) { if (wr == 0) PG8_BAR; }
    PG8_BAR;
    if constexpr (Epi::AFTER_DRAIN) { E.fused(acc, cur, wr, wc, fr, fq, lds, wid, lane); S.done(cur); }
#undef PG8_SA
#undef PG8_SB
#undef PG8_STAGE
#undef PG8_LDA
#undef PG8_LDB
#undef PG8_MMA
#undef PG8_WAIT_V
#undef PG8_WAIT_L
#undef PG8_BAR
#undef PG8_SCHED
}
}

namespace pg8 {
typedef float f32x2e __attribute__((ext_vector_type(2))); typedef __bf16 bf16x2e __attribute__((ext_vector_type(2))); typedef unsigned u32x2e __attribute__((ext_vector_type(2)));
__device__ __forceinline__ unsigned pkbf(float lo, float hi) { f32x2e v = {lo, hi}; bf16x2e b = __builtin_convertvector(v, bf16x2e); return __builtin_bit_cast(unsigned, b); }
struct EpiStore {
    static constexpr bool PERM = true, AFTER_DRAIN = false;
    bf16_t* O; int ldc;
    __device__ __forceinline__ void operator()(const f32x4 (&acc)[2][2][4][2], const Unit& u, int wr, int wc, int fr, int fq) const {
        const int row0 = u.pm * BM + wr * 64 + fr, col0 = u.pn * BM + wc * 32 + 8 * fq;
#pragma unroll
        for (int ai = 0; ai < 2; ++ai)
#pragma unroll
            for (int m = 0; m < 4; ++m) { bf16_t* rowp = O + (size_t)(row0 + ai * HALF + m * 16) * ldc + col0;
#pragma unroll
                for (int bj = 0; bj < 2; ++bj) { const f32x4 v0 = acc[ai][bj][m][0], v1 = acc[ai][bj][m][1];
                    u32x4 w; w.x = pkbf(v0[0], v0[1]); w.y = pkbf(v0[2], v0[3]); w.z = pkbf(v1[0], v1[1]); w.w = pkbf(v1[2], v1[3]);
                    *(u32x4*)(rowp + bj * HALF) = w; } }
    }
};
struct EpiResid1 {
    static constexpr bool PERM = false, AFTER_DRAIN = false;
    const float* xp; const float* xs; float* out; bf16_t* hb; float* ssq;
    __device__ __forceinline__ void operator()(const f32x4 (&acc)[2][2][4][2], const Unit& u, int wr, int wc, int fr, int fq) const {
        asm volatile("" : "+v"(fr), "+v"(fq));
        const int rbase = u.pm * BM;
        const float* xb = rbase < 65536 ? xp + (size_t)rbase * 1024 : xs + (size_t)(rbase - 65536) * 1024;
        bf16_t* hbb = hb + (size_t)rbase * 1024;
        const int col0 = u.pn * BM + wc * 32 + 4 * fq;
#pragma unroll
        for (int ai = 0; ai < 2; ++ai) {
            f32x4 xv[4][2][2];
#pragma unroll
            for (int m = 0; m < 4; ++m)
#pragma unroll
                for (int bj = 0; bj < 2; ++bj)
#pragma unroll
                    for (int n = 0; n < 2; ++n) xv[m][bj][n] = *(const f32x4*)(xb + (size_t)(ai * HALF + wr * 64 + m * 16 + fr) * 1024 + col0 + bj * HALF + n * 16);
            asm volatile("" : "+v"(xv[0][0][0]), "+v"(xv[0][0][1]), "+v"(xv[0][1][0]), "+v"(xv[0][1][1]), "+v"(xv[1][0][0]), "+v"(xv[1][0][1]), "+v"(xv[1][1][0]), "+v"(xv[1][1][1]), "+v"(xv[2][0][0]), "+v"(xv[2][0][1]), "+v"(xv[2][1][0]), "+v"(xv[2][1][1]), "+v"(xv[3][0][0]), "+v"(xv[3][0][1]), "+v"(xv[3][1][0]), "+v"(xv[3][1][1]) :: "memory");
#pragma unroll
            for (int m = 0; m < 4; ++m) { const int r = ai * HALF + wr * 64 + m * 16 + fr; float s = 0.f;
#pragma unroll
                for (int bj = 0; bj < 2; ++bj)
#pragma unroll
                    for (int n = 0; n < 2; ++n) { const size_t off = (size_t)r * 1024 + col0 + bj * HALF + n * 16;
                        const f32x4 h = xv[m][bj][n] + acc[ai][bj][m][n];
                        u32x2e w; w.x = pkbf(h[0], h[1]); w.y = pkbf(h[2], h[3]); *(u32x2e*)(hbb + off) = w;
                        s += (h[0] * h[0] + h[1] * h[1]) + (h[2] * h[2] + h[3] * h[3]); }
                s += __shfl_xor(s, 16); s += __shfl_xor(s, 32);
                if (fq == 0) ssq[(size_t)(rbase + r) * 16 + u.pn * 4 + wc] = s; }
        }
    }
};
struct EpiSwiglu {
    static constexpr bool PERM = true, AFTER_DRAIN = false;
    bf16_t* H; int ldh; const float* ssq;
    __device__ __forceinline__ void operator()(const f32x4 (&acc)[2][2][4][2], const Unit& u, int wr, int wc, int fr, int fq) const {
        const int col0 = u.pn * HALF + wc * 32 + 8 * fq;
        f32x4 part[2][4];
#pragma unroll
        for (int ai = 0; ai < 2; ++ai)
#pragma unroll
            for (int m = 0; m < 4; ++m) part[ai][m] = *(const f32x4*)(ssq + (size_t)(u.pm * BM + ai * HALF + wr * 64 + m * 16 + fr) * 16 + 4 * fq);
        asm volatile("" : "+v"(part[0][0]), "+v"(part[0][1]), "+v"(part[0][2]), "+v"(part[0][3]), "+v"(part[1][0]), "+v"(part[1][1]), "+v"(part[1][2]), "+v"(part[1][3]) :: "memory");
#pragma unroll
        for (int ai = 0; ai < 2; ++ai)
#pragma unroll
            for (int m = 0; m < 4; ++m) { const int row = u.pm * BM + ai * HALF + wr * 64 + m * 16 + fr;
                float tot = (part[ai][m][0] + part[ai][m][1]) + (part[ai][m][2] + part[ai][m][3]);
                tot += __shfl_xor(tot, 16); tot += __shfl_xor(tot, 32);
                const float rstd = __builtin_amdgcn_rsqf(tot * (1.0f / 1024.0f) + 1e-6f);
                float hv[8];
#pragma unroll
                for (int n = 0; n < 2; ++n)
#pragma unroll
                    for (int i = 0; i < 4; ++i) { const float g = acc[ai][0][m][n][i] * rstd, uu = acc[ai][1][m][n][i] * rstd;
                        const float sg = g * __builtin_amdgcn_rcpf(1.0f + __builtin_amdgcn_exp2f(g * -1.4426950408889634f)); hv[n * 4 + i] = sg * uu; }
                u32x4 w; w.x = pkbf(hv[0], hv[1]); w.y = pkbf(hv[2], hv[3]); w.z = pkbf(hv[4], hv[5]); w.w = pkbf(hv[6], hv[7]);
                *(u32x4*)(H + (size_t)row * ldh + col0) = w; }
    }
};
struct EpiResid2 {
    static constexpr bool PERM = false, AFTER_DRAIN = false;
    float* out; float* ssq; const bf16_t* hb;
    __device__ __forceinline__ void operator()(const f32x4 (&acc)[2][2][4][2], const Unit& u, int wr, int wc, int fr, int fq) const {
        const int rbase = u.pm * BM; float* ob = out + (size_t)rbase * 1024;
        const int col0 = u.pn * BM + wc * 32 + 4 * fq;
#pragma unroll
        for (int ai = 0; ai < 2; ++ai)
#pragma unroll
            for (int m = 0; m < 4; ++m) { const int r = ai * HALF + wr * 64 + m * 16 + fr; float s = 0.f;
#pragma unroll
                for (int bj = 0; bj < 2; ++bj)
#pragma unroll
                    for (int n = 0; n < 2; ++n) { const size_t off = (size_t)r * 1024 + col0 + bj * HALF + n * 16;
                        const u32x2e hw = *(const u32x2e*)(hb + (size_t)rbase * 1024 + off);
                        const f32x4 h = (f32x4){__uint_as_float(hw.x << 16), __uint_as_float(hw.x & 0xffff0000u), __uint_as_float(hw.y << 16), __uint_as_float(hw.y & 0xffff0000u)} + acc[ai][bj][m][n];
                        *(f32x4*)(ob + off) = h;
                        s += (h[0] * h[0] + h[1] * h[1]) + (h[2] * h[2] + h[3] * h[3]); }
                s += __shfl_xor(s, 16); s += __shfl_xor(s, 32);
                if (fq == 0) ssq[(size_t)(rbase + r) * 16 + u.pn * 4 + wc] = s; }
    }
};
struct EpiFinal {
    static constexpr bool PERM = false, AFTER_DRAIN = false;
    float* out; const bf16_t* hb; const float* g; float* xbuf; unsigned* cnt; PG8_LAS unsigned char* lx;
    __device__ __forceinline__ void operator()(f32x4 (&acc)[2][2][4][2], const Unit& u, int wr, int wc, int fr, int fq) const {
        int tid = (wr * 4 + wc) * 64 + fresh_lane(); asm volatile("" : "+v"(tid));
        asm volatile("" : "+v"(fr), "+v"(fq));
        const int lane = tid & 63, wid = __builtin_amdgcn_readfirstlane(tid >> 6);
        PG8_LAS float* P = (PG8_LAS float*)lx; PG8_LAS float* S = (PG8_LAS float*)(lx + 4096);
        const int rbase = u.pm * BM; float* ob = out + (size_t)rbase * 1024;
        const int col0 = u.pn * BM + wc * 32 + 4 * fq;
        u32x2e hv[2][4][2][2];
#pragma unroll
        for (int ai = 0; ai < 2; ++ai)
#pragma unroll
            for (int m = 0; m < 4; ++m)
#pragma unroll
                for (int bj = 0; bj < 2; ++bj)
#pragma unroll
                    for (int n = 0; n < 2; ++n) hv[ai][m][bj][n] = *(const u32x2e*)(hb + (size_t)(rbase + ai * HALF + wr * 64 + m * 16 + fr) * 1024 + col0 + bj * HALF + n * 16);
        asm volatile("" : "+v"(hv[0][0][0][0]), "+v"(hv[0][0][0][1]), "+v"(hv[0][0][1][0]), "+v"(hv[0][0][1][1]), "+v"(hv[0][1][0][0]), "+v"(hv[0][1][0][1]), "+v"(hv[0][1][1][0]), "+v"(hv[0][1][1][1]), "+v"(hv[0][2][0][0]), "+v"(hv[0][2][0][1]), "+v"(hv[0][2][1][0]), "+v"(hv[0][2][1][1]), "+v"(hv[0][3][0][0]), "+v"(hv[0][3][0][1]), "+v"(hv[0][3][1][0]), "+v"(hv[0][3][1][1]) :: "memory");
        asm volatile("" : "+v"(hv[1][0][0][0]), "+v"(hv[1][0][0][1]), "+v"(hv[1][0][1][0]), "+v"(hv[1][0][1][1]), "+v"(hv[1][1][0][0]), "+v"(hv[1][1][0][1]), "+v"(hv[1][1][1][0]), "+v"(hv[1][1][1][1]), "+v"(hv[1][2][0][0]), "+v"(hv[1][2][0][1]), "+v"(hv[1][2][1][0]), "+v"(hv[1][2][1][1]), "+v"(hv[1][3][0][0]), "+v"(hv[1][3][0][1]), "+v"(hv[1][3][1][0]), "+v"(hv[1][3][1][1]) :: "memory");
#pragma unroll
        for (int ai = 0; ai < 2; ++ai)
#pragma unroll
            for (int m = 0; m < 4; ++m) { const int r = ai * HALF + wr * 64 + m * 16 + fr; float s = 0.f;
#pragma unroll
                for (int bj = 0; bj < 2; ++bj)
#pragma unroll
                    for (int n = 0; n < 2; ++n) { const u32x2e hw = hv[ai][m][bj][n];
                        const f32x4 h = (f32x4){__uint_as_float(hw.x << 16), __uint_as_float(hw.x & 0xffff0000u), __uint_as_float(hw.y << 16), __uint_as_float(hw.y & 0xffff0000u)} + acc[ai][bj][m][n]; acc[ai][bj][m][n] = h;
                        s += (h[0] * h[0] + h[1] * h[1]) + (h[2] * h[2] + h[3] * h[3]); }
                s += __shfl_xor(s, 16); s += __shfl_xor(s, 32);
                if (fq == 0) P[r * 4 + wc] = s; }
        asm volatile("s_waitcnt lgkmcnt(0)" ::: "memory"); __builtin_amdgcn_s_barrier(); asm volatile("" ::: "memory");
        if (tid < 256) { const f32x4 p = *(const PG8_LAS f32x4*)(P + tid * 4);
            __hip_atomic_store(xbuf + (size_t)(rbase + tid) * 4 + u.pn, (p[0] + p[1]) + (p[2] + p[3]), __ATOMIC_RELAXED, __HIP_MEMORY_SCOPE_AGENT); }
        asm volatile("s_waitcnt vmcnt(0)" ::: "memory");
        if (wid < 4 && lane == 0) __hip_atomic_fetch_add(cnt + 64 * u.pm, 1u, __ATOMIC_RELAXED, __HIP_MEMORY_SCOPE_AGENT);
        if (wid == 0) {
            for (unsigned sp = 0; sp < (1u << 21); ++sp) {
                if ((unsigned)__builtin_amdgcn_readfirstlane(__hip_atomic_load(cnt + 64 * u.pm, __ATOMIC_RELAXED, __HIP_MEMORY_SCOPE_AGENT)) >= 16u) break;
                __builtin_amdgcn_s_sleep(2); }
            __builtin_amdgcn_fence(__ATOMIC_ACQUIRE, "agent"); }
        asm volatile("s_waitcnt vmcnt(0) lgkmcnt(0)" ::: "memory"); __builtin_amdgcn_s_barrier(); asm volatile("" ::: "memory");
        if (tid < 256) { const float* sl = xbuf + (size_t)(rbase + tid) * 4; float t = 0.f;
#pragma unroll
            for (int k = 0; k < 4; ++k) t += __hip_atomic_load(sl + k, __ATOMIC_RELAXED, __HIP_MEMORY_SCOPE_AGENT);
            S[tid] = __builtin_amdgcn_rsqf(t * (1.0f / 1024.0f) + 1e-6f); }
        asm volatile("s_waitcnt vmcnt(0) lgkmcnt(0)" ::: "memory"); __builtin_amdgcn_s_barrier(); asm volatile("" ::: "memory");
        f32x4 gv[2][2];
#pragma unroll
        for (int bj = 0; bj < 2; ++bj)
#pragma unroll
            for (int n = 0; n < 2; ++n) gv[bj][n] = *(const f32x4*)(g + col0 + bj * HALF + n * 16);
#pragma unroll
        for (int ai = 0; ai < 2; ++ai)
#pragma unroll
            for (int m = 0; m < 4; ++m) { const int r = ai * HALF + wr * 64 + m * 16 + fr; const float rs = S[r];
#pragma unroll
                for (int bj = 0; bj < 2; ++bj)
#pragma unroll
                    for (int n = 0; n < 2; ++n) *(f32x4*)(ob + (size_t)r * 1024 + col0 + bj * HALF + n * 16) = acc[ai][bj][m][n] * rs * gv[bj][n]; }
        asm volatile("s_waitcnt lgkmcnt(0)" ::: "memory"); __builtin_amdgcn_s_barrier(); asm volatile("" ::: "memory");
    }
};
}

#include <hip/hip_bf16.h>
#include <cmath>
namespace attn_body {
using bf16=__hip_bfloat16;
using bf16x8=__attribute__((ext_vector_type(8)))short;
using s16x4=__attribute__((ext_vector_type(4)))short;
using f32x16=__attribute__((ext_vector_type(16)))float;
using u32x4=__attribute__((ext_vector_type(4)))unsigned;
constexpr int D=64,QP=1792,OP=1024;
constexpr int NW=8,QBLK=32,QB=QBLK*NW,KVBLK=64,NT=129;
__device__ __forceinline__ int crow(int r,int hi){return (r&3)+8*(r>>2)+4*hi;}
#define SBAR() __builtin_amdgcn_sched_barrier(0)
__device__ __forceinline__ void tmask(f32x16&p0,f32x16&p1){
  const float NEG=-INFINITY;
  #pragma unroll
  for(int r=0;r<16;++r){ if(r>=8)p0[r]=NEG; p1[r]=NEG; }
}

constexpr int NSLOT=3, SLOTB=8192;
constexpr int LDS_K=0, LDS_V=NSLOT*SLOTB, LDS_WS=2*NSLOT*SLOTB, LDS_OST=LDS_WS+NW*64*4, LDS_BYTES=LDS_OST+NW*4096;
constexpr float C2=0.125f*1.4426950408889634f;
__device__ __forceinline__ void glds16(const void*gsrc,unsigned lds_dst){unsigned keep;
  asm volatile("s_mov_b32 %0, m0\n\ts_mov_b32 m0, %2\n\ts_nop 0\n\tglobal_load_lds_dwordx4 %1, off\n\ts_mov_b32 m0, %0":"=&s"(keep):"v"(gsrc),"s"(lds_dst):"memory");}
__device__ __forceinline__ float max3f(float a,float b,float c){float r;asm("v_max3_f32 %0, %1, %2, %3":"=v"(r):"v"(a),"v"(b),"v"(c));return r;}
__device__ __forceinline__ float max2f(float a,float b){float r;asm("v_max_f32_e32 %0, %1, %2":"=v"(r):"v"(a),"v"(b));return r;}
__device__ __forceinline__ float fadd_s(float a,float b){float r;asm("v_add_f32_e32 %0, %1, %2":"=v"(r):"v"(a),"v"(b));return r;}
__device__ __forceinline__ float fsub_s(float a,float b){float r;asm("v_sub_f32_e32 %0, %1, %2":"=v"(r):"v"(a),"v"(b));return r;}
typedef float f32x2_t __attribute__((ext_vector_type(2))); typedef __bf16 bf16x2_t __attribute__((ext_vector_type(2)));
__device__ __forceinline__ unsigned cvtpk_s(float lo,float hi){f32x2_t v={lo,hi};bf16x2_t b=__builtin_convertvector(v,bf16x2_t);return __builtin_bit_cast(unsigned,b);}
#define WAIT_BAR(N) asm volatile("s_waitcnt vmcnt(" #N ") lgkmcnt(0)\n\ts_barrier":::"memory")

__device__ __forceinline__ void qkt(f32x16&p0,f32x16&p1,const char*Kslot,const bf16x8*qr,const f32x16&negm,int r32,int hi){
  const char*kb=Kslot+hi*1024+r32*16;
  #pragma unroll
  for(int d0=0;d0<4;++d0){
    const bf16x8 b0=*reinterpret_cast<const bf16x8*>(kb+d0*2048);
    const bf16x8 b1=*reinterpret_cast<const bf16x8*>(kb+d0*2048+512);
    if(d0==0){p0=__builtin_amdgcn_mfma_f32_32x32x16_bf16(b0,qr[0],negm,0,0,0);p1=__builtin_amdgcn_mfma_f32_32x32x16_bf16(b1,qr[0],negm,0,0,0);}
    else{p0=__builtin_amdgcn_mfma_f32_32x32x16_bf16(b0,qr[d0],p0,0,0,0);p1=__builtin_amdgcn_mfma_f32_32x32x16_bf16(b1,qr[d0],p1,0,0,0);}}
}
typedef __attribute__((address_space(3))) const char* lds_cptr;
typedef short v4i16_t __attribute__((ext_vector_type(4)));
__device__ __forceinline__ void kload8(bf16x8*kf,lds_cptr kp){
  kf[0]=*(const __attribute__((address_space(3))) bf16x8*)(kp);      kf[1]=*(const __attribute__((address_space(3))) bf16x8*)(kp+512);
  kf[2]=*(const __attribute__((address_space(3))) bf16x8*)(kp+2048); kf[3]=*(const __attribute__((address_space(3))) bf16x8*)(kp+2560);
  kf[4]=*(const __attribute__((address_space(3))) bf16x8*)(kp+4096); kf[5]=*(const __attribute__((address_space(3))) bf16x8*)(kp+4608);
  kf[6]=*(const __attribute__((address_space(3))) bf16x8*)(kp+6144); kf[7]=*(const __attribute__((address_space(3))) bf16x8*)(kp+6656);
}
__device__ __forceinline__ void kload2(bf16x8*kf,lds_cptr kp,int j){ kf[2*j]=*(const __attribute__((address_space(3))) bf16x8*)(kp+j*2048); kf[2*j+1]=*(const __attribute__((address_space(3))) bf16x8*)(kp+j*2048+512); }
__device__ __forceinline__ s16x4 vtr(lds_cptr p){ return __builtin_bit_cast(s16x4,__builtin_amdgcn_ds_read_tr16_b64_v4i16((__attribute__((address_space(3))) v4i16_t*)p)); }
__device__ __forceinline__ float rowmax(const f32x16&p0,const f32x16&p1){
  float a=max3f(p0[0],p0[1],p1[0]),b=max3f(p0[2],p0[3],p1[1]);a=max3f(a,p1[2],p1[3]);
  #pragma unroll
  for(int r=4;r<16;r+=4){a=max3f(a,p0[r],p0[r+1]);b=max3f(b,p0[r+2],p0[r+3]);a=max3f(a,p1[r],p1[r+1]);b=max3f(b,p1[r+2],p1[r+3]);}
  const float m=max2f(a,b);
  auto rr=__builtin_amdgcn_permlane32_swap(__float_as_uint(m),__float_as_uint(m),false,false);
  return max2f(__uint_as_float(rr[0]),__uint_as_float(rr[1]));
}
__device__ __forceinline__ void pv(f32x16*o,int vb,bf16x8 pa0,bf16x8 pa1,bf16x8 pa2,bf16x8 pa3){
  #pragma unroll
  for(int d0=0;d0<2;++d0){s16x4 lo[4],hi[4];
    #pragma unroll
    for(int ks=0;ks<4;++ks){
      asm volatile("ds_read_b64_tr_b16 %0,%1 offset:%c2":"=&v"(lo[ks]):"v"(vb),"i"(d0*4096+ks*1024):"memory");
      asm volatile("ds_read_b64_tr_b16 %0,%1 offset:%c2":"=&v"(hi[ks]):"v"(vb),"i"(d0*4096+ks*1024+512):"memory");}
    asm volatile("s_waitcnt lgkmcnt(0)":::"memory");SBAR();
    #define PK(k) (bf16x8){lo[k][0],lo[k][1],lo[k][2],lo[k][3],hi[k][0],hi[k][1],hi[k][2],hi[k][3]}
    o[d0]=__builtin_amdgcn_mfma_f32_32x32x16_bf16(pa0,PK(0),o[d0],0,0,0);
    o[d0]=__builtin_amdgcn_mfma_f32_32x32x16_bf16(pa1,PK(1),o[d0],0,0,0);
    o[d0]=__builtin_amdgcn_mfma_f32_32x32x16_bf16(pa2,PK(2),o[d0],0,0,0);
    o[d0]=__builtin_amdgcn_mfma_f32_32x32x16_bf16(pa3,PK(3),o[d0],0,0,0);
    #undef PK
  }
}

#ifndef ATTN_STORE16
#define ATTN_STORE16(p,v) (*(u32x4*)(p)=(v))
#endif
template<int THRL> __device__ __forceinline__ void attn_unit(const bf16*Qw0,const bf16*__restrict__ Kh,const bf16*__restrict__ Vh,bf16*Ow0,char*shm,const float negM,const int wid,const float*qg,const float*ctab,const float*stab,const int t0){
  const int lane=fresh_lane(),r32=lane&31,hi=lane>>5;
  const bf16*Qw=Qw0+(long)(wid*QBLK)*QP;
  const unsigned lds0=(unsigned)(uintptr_t)shm;
  float*wsf=(float*)(shm+LDS_WS)+wid*64;
  const bf16*ksrc=Kh+(long)lane*QP+wid*8;
  const bf16*vsrc=Vh+(long)(16*(wid&3)+(lane>>2))*QP+(wid>>2)*32+(lane&3)*8;
  const unsigned kdst=lds0+LDS_K+wid*1024, vdst=lds0+LDS_V+wid*1024;
  #define DMA_K(t,slot) glds16(ksrc+(long)(t)*KVBLK*QP,(unsigned)__builtin_amdgcn_readfirstlane(kdst+(slot)))
  #define DMA_V(t,slot) glds16(vsrc+(long)(t)*KVBLK*QP,(unsigned)__builtin_amdgcn_readfirstlane(vdst+(slot)))
  const int vb0=(int)(lds0+LDS_V)+((lane>>4)&1)*32+(lane&3)*8+(4*hi+((lane&15)>>2))*64;
  const char*Kbase=shm+LDS_K; bf16x8 kf[8];
  const lds_cptr shm3=(lds_cptr)shm; const lds_cptr kp0=shm3+LDS_K+hi*1024+r32*16; const lds_cptr vp0=shm3+LDS_V+((lane>>4)&1)*32+(lane&3)*8+(4*hi+((lane&15)>>2))*64;
  DMA_K(0,0);DMA_V(0,0);DMA_K(1,SLOTB);
  bf16x8 qr[4];
  #pragma unroll
  for(int d0=0;d0<4;++d0)qr[d0]=*reinterpret_cast<const bf16x8*>(&Qw[(long)r32*QP+d0*16+hi*8]);
  { float x[4][8]; float ss=0.f;
    #pragma unroll
    for(int d0=0;d0<4;++d0){
      #pragma unroll
      for(int j=0;j<8;++j){x[d0][j]=__uint_as_float(((unsigned)(unsigned short)qr[d0][j])<<16);ss+=x[d0][j]*x[d0][j];}}
    {auto rr=__builtin_amdgcn_permlane32_swap(__float_as_uint(ss),__float_as_uint(ss),false,false);ss=__uint_as_float(rr[0])+__uint_as_float(rr[1]);}
    const float rstd=__builtin_amdgcn_rsqf(ss*(1.0f/64.0f)+1e-6f);
    #pragma unroll
    for(int d0=0;d0<4;++d0){ const float*gp=qg+d0*16+hi*8;
      #pragma unroll
      for(int j=0;j<8;++j)x[d0][j]*=rstd*gp[j]; }
    const long trow=(long)(t0+wid*QBLK+r32)*32+hi*8;
    #pragma unroll
    for(int hf=0;hf<2;++hf){ const float*cp=ctab+trow+hf*16,*sp=stab+trow+hf*16;
      #pragma unroll
      for(int j=0;j<8;++j){ const float c=cp[j],sn=sp[j],a=x[2*hf][j],b=x[2*hf+1][j]; x[2*hf][j]=(a*c-b*sn)*C2; x[2*hf+1][j]=(b*c+a*sn)*C2; } }
    #pragma unroll
    for(int d0=0;d0<4;++d0){ u32x4 w; w.x=cvtpk_s(x[d0][0],x[d0][1]); w.y=cvtpk_s(x[d0][2],x[d0][3]); w.z=cvtpk_s(x[d0][4],x[d0][5]); w.w=cvtpk_s(x[d0][6],x[d0][7]); qr[d0]=__builtin_bit_cast(bf16x8,w); }
  }
  f32x16 o[2];o[0]=f32x16{};o[1]=f32x16{};float l_reg=0.f;const f32x16 negm=f32x16{};(void)negM;
  #define CMASK(P0,P1,t) do{ if((t)==NT-1)tmask(P0,P1); }while(0)
  #define START(P0,P1) do{ _Pragma("unroll") for(int r=0;r<16;++r)P0[r]=__builtin_amdgcn_exp2f(P0[r]); }while(0)
  #define RESC() do{}while(0)
  f32x16 pA0,pA1,pB0,pB1;
  int sl_prev=0,sl_cur=0,sl_next=SLOTB;
  #define ROT() do{sl_prev=sl_cur;sl_cur=sl_next;sl_next=(sl_next==(NSLOT-1)*SLOTB)?0:sl_next+SLOTB;}while(0)
  DMA_K(2,2*SLOTB);
  WAIT_BAR(3);
  qkt(pA0,pA1,Kbase,qr,negm,r32,hi);asm volatile("s_nop 15\n\ts_nop 7":"+v"(pA0),"+v"(pA1));CMASK(pA0,pA1,0);
  START(pA0,pA1);
  _Pragma("unroll") for(int r=0;r<16;++r)pA1[r]=__builtin_amdgcn_exp2f(pA1[r]);
  WAIT_BAR(0);
  DMA_K(3,0);DMA_V(1,SLOTB);
  ROT();
  kload8(kf,kp0+sl_cur);
  WAIT_BAR(2);
  s16x4 vlo[8],vhi[8]; u32x4 pw0,pw1,pw2,pw3;
  #define PKW(P,B) cvtpk_s(P[B],P[B+1])
  #define PAF(k) __builtin_bit_cast(bf16x8,pw##k)
  #define VFR(i) (bf16x8){vlo[i][0],vlo[i][1],vlo[i][2],vlo[i][3],vhi[i][0],vhi[i][1],vhi[i][2],vhi[i][3]}
  #define PIN(x) asm volatile("":"+v"(x))
  #define MX3(a,b,c) __builtin_fmaxf(__builtin_fmaxf((a),(b)),(c))
  #define GAPA(MF,A0,A1,A2,A3,W0,W1,PW) do{ MF; sacc+=A0; sacc+=A1; sacc+=A2; sacc+=A3; PIN(sacc); W0; W1; PIN(PW); SBAR(); }while(0)
  #define EX(v) __builtin_amdgcn_exp2f(v)
  #define GAPB(MF,X,B) do{ MF; X[B]=EX(X[B]); X[B+1]=EX(X[B+1]); X[B+2]=EX(X[B+2]); X[B+3]=EX(X[B+3]); PIN(X); SBAR(); }while(0)
  #define VRD(i) do{ vlo[i]=vtr(vp_+(((i)>>2)*4096+((i)&3)*1024)); vhi[i]=vtr(vp_+(((i)>>2)*4096+((i)&3)*1024+512)); }while(0)
  #define KRD(G,j) do{ if(G){ kload2(kf,kp0+sl_next,j); SBAR(); } }while(0)
  #define STEP(C0,C1,P0,P1,t,GK,GV,GL) do{ SBAR(); \
    const lds_cptr vp_=vp0+sl_prev; \
    VRD(0); SBAR(); float sacc=(P0[0]+P0[1]); \
    GAPA(C0=__builtin_amdgcn_mfma_f32_32x32x16_bf16(kf[0],qr[0],negm,0,0,0), P0[2],P0[3],P0[4],P0[5],     pw0[0]=PKW(P0,0), pw0[1]=PKW(P0,2), pw0); \
    VRD(4); SBAR(); GAPA(C1=__builtin_amdgcn_mfma_f32_32x32x16_bf16(kf[1],qr[0],negm,0,0,0), P0[6],P0[7],P0[8],P0[9],     pw0[2]=PKW(P0,4), pw0[3]=PKW(P0,6), pw0); \
    VRD(1); SBAR(); GAPA(C0=__builtin_amdgcn_mfma_f32_32x32x16_bf16(kf[2],qr[1],C0,0,0,0),   P0[10],P0[11],P0[12],P0[13], pw1[0]=PKW(P0,8), pw1[1]=PKW(P0,10), pw1); \
    VRD(5); SBAR(); GAPA(C1=__builtin_amdgcn_mfma_f32_32x32x16_bf16(kf[3],qr[1],C1,0,0,0),   P0[14],P0[15],P1[0],P1[1],   pw1[2]=PKW(P0,12),pw1[3]=PKW(P0,14), pw1); \
    VRD(2); SBAR(); GAPA(C0=__builtin_amdgcn_mfma_f32_32x32x16_bf16(kf[4],qr[2],C0,0,0,0),   P1[2],P1[3],P1[4],P1[5],     pw2[0]=PKW(P1,0), pw2[1]=PKW(P1,2), pw2); \
    VRD(6); SBAR(); GAPA(C1=__builtin_amdgcn_mfma_f32_32x32x16_bf16(kf[5],qr[2],C1,0,0,0),   P1[6],P1[7],P1[8],P1[9],     pw2[2]=PKW(P1,4), pw2[3]=PKW(P1,6), pw2); \
    VRD(3); SBAR(); GAPA(C0=__builtin_amdgcn_mfma_f32_32x32x16_bf16(kf[6],qr[3],C0,0,0,0),   P1[10],P1[11],P1[12],P1[13], pw3[0]=PKW(P1,8), pw3[1]=PKW(P1,10), pw3); \
    VRD(7); SBAR(); GAPA(C1=__builtin_amdgcn_mfma_f32_32x32x16_bf16(kf[7],qr[3],C1,0,0,0),   P1[14],P1[15],0.f,0.f,       pw3[2]=PKW(P1,12),pw3[3]=PKW(P1,14), pw3); \
    l_reg+=sacc; \
    if(GK){DMA_K((t)+3,sl_cur);} if(GV){DMA_V((t)+1,sl_next);} \
    CMASK(C0,C1,t); \
    SBAR(); \
    GAPB(o[0]=__builtin_amdgcn_mfma_f32_32x32x16_bf16(PAF(0),VFR(0),o[0],0,0,0), C0,0); \
    GAPB(o[1]=__builtin_amdgcn_mfma_f32_32x32x16_bf16(PAF(0),VFR(4),o[1],0,0,0), C0,4); \
    KRD(GL,0); GAPB(o[0]=__builtin_amdgcn_mfma_f32_32x32x16_bf16(PAF(1),VFR(1),o[0],0,0,0), C0,8); \
    KRD(GL,1); GAPB(o[1]=__builtin_amdgcn_mfma_f32_32x32x16_bf16(PAF(1),VFR(5),o[1],0,0,0), C0,12); \
    KRD(GL,2); GAPB(o[0]=__builtin_amdgcn_mfma_f32_32x32x16_bf16(PAF(2),VFR(2),o[0],0,0,0), C1,0); \
    KRD(GL,3); GAPB(o[1]=__builtin_amdgcn_mfma_f32_32x32x16_bf16(PAF(2),VFR(6),o[1],0,0,0), C1,4); \
    GAPB(o[0]=__builtin_amdgcn_mfma_f32_32x32x16_bf16(PAF(3),VFR(3),o[0],0,0,0), C1,8); \
    GAPB(o[1]=__builtin_amdgcn_mfma_f32_32x32x16_bf16(PAF(3),VFR(7),o[1],0,0,0), C1,12); \
    }while(0)
  int t=1;
  #define ENDW(tt) do{ if((tt)+3<NT){WAIT_BAR(2);} else if((tt)+2<NT){WAIT_BAR(1);} else {WAIT_BAR(0);} }while(0)
  #undef CMASK
  #define CMASK(P0,P1,t) do{}while(0)
  for(;t+4<NT;t+=2){
    STEP(pB0,pB1,pA0,pA1,t,true,true,true);     WAIT_BAR(2); RESC(); ROT();
    STEP(pA0,pA1,pB0,pB1,t+1,true,true,true);   WAIT_BAR(2); RESC(); ROT();
  }
  for(;t+2<NT;t+=2){
    STEP(pB0,pB1,pA0,pA1,t,(t+3<NT),(t+1<NT),(t+1<NT));       ENDW(t);   RESC(); ROT();
    STEP(pA0,pA1,pB0,pB1,t+1,(t+4<NT),(t+2<NT),(t+2<NT));     ENDW(t+1); RESC(); ROT();
  }
  STEP(pB0,pB1,pA0,pA1,NT-2,false,true,true); WAIT_BAR(0); RESC(); ROT();
  #undef CMASK
  #define CMASK(P0,P1,t) tmask(P0,P1)
  STEP(pA0,pA1,pB0,pB1,NT-1,false,false,false); RESC();
  { float sacc=pA0[0]+pA0[1]; _Pragma("unroll") for(int r=2;r<16;++r)sacc+=pA0[r]; _Pragma("unroll") for(int r=0;r<16;++r)sacc+=pA1[r]; l_reg+=sacc;
    pw0=(u32x4){PKW(pA0,0),PKW(pA0,2),PKW(pA0,4),PKW(pA0,6)};pw1=(u32x4){PKW(pA0,8),PKW(pA0,10),PKW(pA0,12),PKW(pA0,14)};pw2=(u32x4){PKW(pA1,0),PKW(pA1,2),PKW(pA1,4),PKW(pA1,6)};pw3=(u32x4){PKW(pA1,8),PKW(pA1,10),PKW(pA1,12),PKW(pA1,14)};
    SBAR(); pv(o,vb0+sl_cur,PAF(0),PAF(1),PAF(2),PAF(3)); }
  #undef PKW
  #undef PAF
  #undef VFR
  #undef PIN
  #undef MX3
  #undef GAPA
  #undef GAPB
  #undef EX
  #undef VRD
  #undef KRD
  #undef STEP
  #undef ENDW
  {auto rr=__builtin_amdgcn_permlane32_swap(__float_as_uint(l_reg),__float_as_uint(l_reg),false,false);l_reg=__uint_as_float(rr[0])+__uint_as_float(rr[1]);}
  if(hi==0)wsf[32+r32]=l_reg;asm volatile("s_waitcnt lgkmcnt(0)":::"memory");
  float rli[16];
  #pragma unroll
  for(int r=0;r<16;++r)rli[r]=__builtin_amdgcn_rcpf(wsf[32+crow(r,hi)]);
  bf16*Ow=Ow0+(long)(wid*QBLK)*OP;
  { bf16*stg=(bf16*)(shm+LDS_OST)+wid*2048;
    #pragma unroll
    for(int r=0;r<16;++r){const int orow=crow(r,hi);
      #pragma unroll
      for(int d0=0;d0<2;++d0)stg[orow*64+d0*32+r32]=__float2bfloat16(o[d0][r]*rli[r]);}
    asm volatile("s_waitcnt lgkmcnt(0)":::"memory");
    #pragma unroll
    for(int i=0;i<4;++i){const int row=i*8+(lane>>3),ch=lane&7; const u32x4 v=*(const u32x4*)(stg+row*64+ch*8); ATTN_STORE16(Ow+(long)row*OP+ch*8,v);} }
  asm volatile("s_waitcnt lgkmcnt(0)\n\ts_barrier":::"memory");
  #undef DMA_K
  #undef DMA_V
  #undef CMASK
  #undef START
  #undef RESC
  #undef ROT
}
constexpr int ATTN_LDS_BYTES=LDS_BYTES;
#undef SBAR
#undef WAIT_BAR
}

#ifndef MK_N_LAUNCHES
#define MK_N_LAUNCHES 1
#endif
constexpr int NWAVES = 8, NPHASE = 9;
constexpr int DM = 1024, NSEQ = 12, SEQ = 8192, NMETA = 16, LSEQ = SEQ + NMETA;
constexpr int TNAT = NSEQ * LSEQ, MP = 98560, MC = NSEQ * SEQ;
constexpr int INW = 1792, FFH = 2816, LRUW = 512;
constexpr int COL_K = 512, COL_V = 640, COL_LIN = 768, COL_LG = 1280;
constexpr int CT = 32, NCH = 257, NLU = NSEQ * NCH;
constexpr float QSCALE = 0.125f * 1.4426950408889634f;
constexpr size_t MiB = 1u << 20;
constexpr size_t WS_WIN = 2 * MiB, WS_WOUT = 6 * MiB, WS_WGU = 8 * MiB, WS_WDN = 20 * MiB, WS_WLRU = 26 * MiB, WS_NL = 26 * MiB + 512 * 1024;
constexpr size_t WS_COS = 27 * MiB, WS_SIN = 28 * MiB, WS_NEGM = 29 * MiB, WS_CNT = 30 * MiB;
constexpr size_t WS_AGG = 32 * MiB, WS_CARRY = 60 * MiB, WS_SSQ1 = 74 * MiB, WS_SSQ2 = 82 * MiB;
constexpr size_t WS_XN = 96 * MiB;
constexpr size_t WS_PROJ = 300 * MiB;
constexpr size_t WS_HID = 96 * MiB;
constexpr size_t WS_H1B = 656 * MiB;
constexpr size_t WS_SP = 656 * MiB;
constexpr size_t WS_END = 960 * MiB;
static_assert(WS_AGG + (size_t)NLU * 2048 * 4 <= WS_CARRY && WS_CARRY + (size_t)NLU * 1024 * 4 <= WS_SSQ1 && WS_SSQ1 + (size_t)MC * 64 <= WS_SSQ2 && WS_SSQ2 + (size_t)MC * 64 <= WS_XN, "ws map 1");
static_assert(WS_XN + (size_t)MP * 1024 * 2 <= WS_PROJ && WS_PROJ + (size_t)MP * INW * 2 <= WS_H1B && WS_HID + (size_t)MC * FFH * 2 <= WS_H1B && WS_H1B + (size_t)MC * 1024 * 2 <= WS_END && WS_SP + (size_t)(TNAT + 64) * 2048 <= WS_END, "ws map 2");
constexpr int LDS_BYTES = 147456;

#define GAS __attribute__((address_space(1)))
#define LAS __attribute__((address_space(3)))
typedef unsigned short bf16;
typedef unsigned v4u __attribute__((ext_vector_type(4)));
typedef unsigned v2u __attribute__((ext_vector_type(2)));
typedef float f32x4 __attribute__((ext_vector_type(4)));
typedef short bf16x8 __attribute__((ext_vector_type(8)));
using pg8::pkbf;
__device__ __forceinline__ float bflo(unsigned w) { return __uint_as_float(w << 16); }
__device__ __forceinline__ float bfhi(unsigned w) { return __uint_as_float(w & 0xffff0000u); }
__device__ __forceinline__ float wave_sum(float v) {
#pragma unroll
    for (int o = 1; o < 64; o <<= 1) v += __shfl_xor(v, o);
    return v;
}
template <int CTRL> __device__ __forceinline__ float dppf(float old, float v) { return __builtin_bit_cast(float, __builtin_amdgcn_update_dpp(__builtin_bit_cast(int, old), __builtin_bit_cast(int, v), CTRL, 0xf, 0xf, false)); }
__device__ __forceinline__ void scan_fwd16(float& A, float& B) {
#define SF(S) { const float Ap = dppf<0x110 + S>(1.f, A), Bp = dppf<0x110 + S>(0.f, B); B = fmaf(A, Bp, B); A = A * Ap; }
    SF(1) SF(2) SF(4) SF(8)
#undef SF
}
__device__ __forceinline__ void scan_bwd16(float& A, float& B) {
#define SB(S) { const float Ap = dppf<0x100 + S>(1.f, A), Bp = dppf<0x100 + S>(0.f, B); B = fmaf(A, Bp, B); A = A * Ap; }
    SB(1) SB(2) SB(4) SB(8)
#undef SB
}

#define LRU_DPP_STEP(DIR, S) \
    "v_fmac_f32_dpp %0, %0, %4 " DIR ":" #S " row_mask:0xf bank_mask:0xf\n\tv_fmac_f32_dpp %1, %1, %5 " DIR ":" #S " row_mask:0xf bank_mask:0xf\n\t" \
    "v_fmac_f32_dpp %2, %2, %6 " DIR ":" #S " row_mask:0xf bank_mask:0xf\n\tv_fmac_f32_dpp %3, %3, %7 " DIR ":" #S " row_mask:0xf bank_mask:0xf\n\t" \
    "v_mul_f32_dpp %4, %4, %4 " DIR ":" #S " row_mask:0xf bank_mask:0xf\n\tv_mul_f32_dpp %5, %5, %5 " DIR ":" #S " row_mask:0xf bank_mask:0xf\n\t" \
    "v_mul_f32_dpp %6, %6, %6 " DIR ":" #S " row_mask:0xf bank_mask:0xf\n\tv_mul_f32_dpp %7, %7, %7 " DIR ":" #S " row_mask:0xf bank_mask:0xf\n\t"
__device__ __forceinline__ void scan4_fwd16(float (&A)[4], float (&B)[4]) {
    asm volatile("s_nop 1\n\t" LRU_DPP_STEP("row_shr", 1) LRU_DPP_STEP("row_shr", 2) LRU_DPP_STEP("row_shr", 4) LRU_DPP_STEP("row_shr", 8)
                 : "+v"(B[0]), "+v"(B[1]), "+v"(B[2]), "+v"(B[3]), "+v"(A[0]), "+v"(A[1]), "+v"(A[2]), "+v"(A[3]));
}
__device__ __forceinline__ void scan4_bwd16(float (&A)[4], float (&B)[4]) {
    asm volatile("s_nop 1\n\t" LRU_DPP_STEP("row_shl", 1) LRU_DPP_STEP("row_shl", 2) LRU_DPP_STEP("row_shl", 4) LRU_DPP_STEP("row_shl", 8)
                 : "+v"(B[0]), "+v"(B[1]), "+v"(B[2]), "+v"(B[3]), "+v"(A[0]), "+v"(A[1]), "+v"(A[2]), "+v"(A[3]));
}

struct Args {
    const float *x_prompt, *x_sample, *meta, *norm_mix_g, *w_in, *q_norm_g, *k_norm_g, *conv_w, *conv_b, *lru_w_a, *lru_b_a, *lru_w_x, *lru_b_x, *lru_lam,
                *attn_out_g, *lru_out_g, *w_out, *norm_ffn_g, *w_gate_up, *w_down, *final_norm_g;
    float* out; unsigned char* ws; int ph_lo, ph_hi;
};

__device__ __forceinline__ void p0_transpose_item(const float* W, int K, int N, bf16* WT, int mode, const float* kscale, LAS float* scr, int item, int lane) {
    const int nblk = N / 32, kb = item / nblk, nb = item % nblk, k0 = 64 * kb, n0 = 32 * nb;
#pragma unroll 8
    for (int i = 0; i < 32; ++i) { const int kk = 2 * i + (lane >> 5); float v = W[(size_t)(k0 + kk) * N + n0 + (lane & 31)]; if (kscale) v *= kscale[k0 + kk]; scr[kk * 33 + (lane & 31)] = v; }
    asm volatile("s_waitcnt lgkmcnt(0)" ::: "memory");
    int rbase = n0;
    if (mode == 1) { if (n0 < FFH) rbase = (n0 / 128) * 256 + (n0 % 128); else { const int j = n0 - FFH; rbase = (j / 128) * 256 + 128 + (j % 128); } }
    const int c = lane & 7;
#pragma unroll
    for (int j = 0; j < 4; ++j) { const int n = (lane >> 3) + 8 * j; const LAS float* s = scr + (8 * c) * 33 + n;
        v4u o; o.x = pkbf(s[0 * 33], s[1 * 33]); o.y = pkbf(s[2 * 33], s[3 * 33]); o.z = pkbf(s[4 * 33], s[5 * 33]); o.w = pkbf(s[6 * 33], s[7 * 33]);
        *(GAS v4u*)(WT + (size_t)(rbase + n) * K + k0 + 8 * c) = o; }
    asm volatile("s_waitcnt lgkmcnt(0)" ::: "memory");
}

__device__ __forceinline__ void phase0(const Args& a, LAS unsigned char* lds, int vcu, int G, int wave, int lane, int tid) {
    unsigned char* ws = a.ws;
    LAS float* scr = (LAS float*)(lds + wave * 16384);
    const int gw = vcu * NWAVES + wave, NGW = G * NWAVES;
    constexpr int I_IN = (DM / 64) * (INW / 32), I_OUT = (DM / 64) * (DM / 32), I_GU = (DM / 64) * (2 * FFH / 32), I_DN = (FFH / 64) * (DM / 32);
    constexpr int NITEMS = I_IN + I_OUT + I_GU + I_DN;
    for (int it = gw; it < NITEMS; it += NGW) {
        int r = it;
        if (r < I_IN) { p0_transpose_item(a.w_in, DM, INW, (bf16*)(ws + WS_WIN), 0, nullptr, scr, r, lane); continue; } r -= I_IN;
        if (r < I_OUT) { p0_transpose_item(a.w_out, DM, DM, (bf16*)(ws + WS_WOUT), 0, nullptr, scr, r, lane); continue; } r -= I_OUT;
        if (r < I_GU) { p0_transpose_item(a.w_gate_up, DM, 2 * FFH, (bf16*)(ws + WS_WGU), 1, a.norm_ffn_g, scr, r, lane); continue; } r -= I_GU;
        p0_transpose_item(a.w_down, FFH, DM, (bf16*)(ws + WS_WDN), 0, nullptr, scr, r, lane);
    }
    const int gt = vcu * (NWAVES * 64) + tid, NGT = G * NWAVES * 64;
    { bf16* Wl = (bf16*)(ws + WS_WLRU);
      for (int e = gt; e < 8 * 256 * 64; e += NGT) { const int h = e >> 14, o = (e >> 6) & 255, i = e & 63, g4 = o >> 6, j = o & 63, d = g4 >> 1;
          const float* src = (g4 & 1) ? a.lru_w_x : a.lru_w_a; Wl[e] = (bf16)(pkbf(src[((size_t)(d * 8 + h) * 64 + i) * 64 + j], 0.f) & 0xffffu); } }
    if (gt == 0) { float mq = 0.f, mk = 0.f; for (int e = 0; e < 64; ++e) { mq = fmaxf(mq, fabsf(a.q_norm_g[e])); mk = fmaxf(mk, fabsf(a.k_norm_g[e])); }
        *(float*)(ws + WS_NEGM) = -(8.0f * 1.4426950408889634f * mq * mk * 1.02f + 0.5f); }
    { unsigned* cnt = (unsigned*)(ws + WS_CNT); for (int e = gt; e < 384 * 64; e += NGT) cnt[e] = 0u; }
    { float* nl = (float*)(ws + WS_NL); for (int e = gt; e < 2 * LRUW; e += NGT) nl[e] = -8.0f * log1pf(expf(-a.lru_lam[e])); }
    { float* ct = (float*)(ws + WS_COS); float* st = (float*)(ws + WS_SIN);
      for (int e = gt; e < SEQ * 32; e += NGT) { const int t = e >> 5, k = e & 31, pos = (k < 16) ? (t >> 6) : (t & 63), i = k & 15;
          const float freq = __builtin_amdgcn_exp2f(-(float)i * (13.287712379549449f / 16.0f));
          const float rev = (float)pos * freq * 0.15915494309189535f; const float fr = rev - rintf(rev);
          ct[e] = __builtin_amdgcn_cosf(fr); st[e] = __builtin_amdgcn_sinf(fr); } }
    { bf16* XN = (bf16*)(ws + WS_XN);
      f32x4 g4[4];
#pragma unroll
      for (int j = 0; j < 4; ++j) g4[j] = *((const f32x4*)a.norm_mix_g + lane + 64 * j);
      for (int r = gw; r < MP; r += NGW) {
          GAS unsigned long long* o8 = (GAS unsigned long long*)(XN + (size_t)r * DM) + lane;
          if (r >= TNAT) {
#pragma unroll
              for (int j = 0; j < 4; ++j) o8[64 * j] = 0ull;
              continue; }
          const int b = r / LSEQ, p = r - b * LSEQ;
          const float* src = (p < NMETA) ? a.meta + (size_t)p * DM : (b < 8 ? a.x_prompt + ((size_t)b * SEQ + (p - NMETA)) * DM : a.x_sample + ((size_t)(b - 8) * SEQ + (p - NMETA)) * DM);
          const f32x4* xr = (const f32x4*)src + lane; f32x4 v[4]; float s = 0.f;
#pragma unroll
          for (int j = 0; j < 4; ++j) { v[j] = xr[64 * j]; s += (v[j][0] * v[j][0] + v[j][1] * v[j][1]) + (v[j][2] * v[j][2] + v[j][3] * v[j][3]); }
          const float rstd = __builtin_amdgcn_rsqf(wave_sum(s) * (1.0f / DM) + 1e-6f);
#pragma unroll
          for (int j = 0; j < 4; ++j) { const f32x4 y = v[j] * rstd * g4[j]; o8[64 * j] = (unsigned long long)pkbf(y[0], y[1]) | ((unsigned long long)pkbf(y[2], y[3]) << 32); }
      } }
}

__device__ __forceinline__ void phase_qk(const Args& a, int vcu, int G, int wave, int lane) {
    bf16* proj = (bf16*)(a.ws + WS_PROJ); const float* ct = (const float*)(a.ws + WS_COS); const float* st = (const float*)(a.ws + WS_SIN);
    const int gw = vcu * NWAVES + wave, NGW = G * NWAVES; const int sub = lane >> 3, j = lane & 7;
    constexpr int NGRP = TNAT * 2 / 8;
    for (int grp = gw; grp < NGRP; grp += NGW) {
        const int item = grp * 8 + sub, row = item >> 1, hh = 8 + (item & 1);
        bf16* ptr = proj + (size_t)row * INW + hh * 64 + j * 8;
        const v4u raw = *(const v4u*)ptr;
        float x[8] = {bflo(raw.x), bfhi(raw.x), bflo(raw.y), bfhi(raw.y), bflo(raw.z), bfhi(raw.z), bflo(raw.w), bfhi(raw.w)};
        float ss = 0.f;
#pragma unroll
        for (int e = 0; e < 8; ++e) ss += x[e] * x[e];
        ss += __shfl_xor(ss, 1); ss += __shfl_xor(ss, 2); ss += __shfl_xor(ss, 4);
        const float rstd = __builtin_amdgcn_rsqf(ss * (1.0f / 64.0f) + 1e-6f);
        const float* gp = (hh < 8 ? a.q_norm_g : a.k_norm_g) + j * 8;
        const f32x4 g0 = *(const f32x4*)gp, g1 = *(const f32x4*)(gp + 4);
        float y[8];
#pragma unroll
        for (int e = 0; e < 8; ++e) y[e] = x[e] * rstd * (e < 4 ? g0[e] : g1[e - 4]);
        const int b = row / LSEQ, p = row - b * LSEQ;
        float c[8], s[8];
        if (p >= NMETA) { const int toff = (p - NMETA) * 32 + (j >> 2) * 16 + (j & 1) * 8;
            const f32x4 c0 = *(const f32x4*)(ct + toff), c1 = *(const f32x4*)(ct + toff + 4), s0 = *(const f32x4*)(st + toff), s1 = *(const f32x4*)(st + toff + 4);
#pragma unroll
            for (int e = 0; e < 4; ++e) { c[e] = c0[e]; c[e + 4] = c1[e]; s[e] = s0[e]; s[e + 4] = s1[e]; }
        } else {
#pragma unroll
            for (int e = 0; e < 8; ++e) { c[e] = 1.f; s[e] = 0.f; } }
        const float sgn = (j & 2) ? 1.f : -1.f, sc = (hh < 8) ? QSCALE : 1.f;
        float o[8];
#pragma unroll
        for (int e = 0; e < 8; ++e) { const float py = __shfl_xor(y[e], 2); o[e] = (y[e] * c[e] + sgn * py * s[e]) * sc; }
        v4u w; w.x = pkbf(o[0], o[1]); w.y = pkbf(o[2], o[3]); w.z = pkbf(o[4], o[5]); w.w = pkbf(o[6], o[7]);
        *(v4u*)ptr = w;
    }
}

constexpr int CB_ROW = 144, CB_WAVE = CT * CB_ROW, LRU_CB = 0, LRU_CONST = NWAVES * CB_WAVE, LRU_SLAB = LRU_CONST + 11 * 512 * 4, SLAB_WAVE = 40 * 128, LRU_Y = 0, Y_ROW = 2064, LRU_PART = 0;
static_assert(LRU_SLAB + NWAVES * SLAB_WAVE <= LDS_BYTES, "lru lds");
static_assert(LSEQ == (NCH - 1) * CT + 16, "the last chunk of a sequence holds exactly one 16-token tile");
#define LRU_LOADW(dst, cgi_) do { _Pragma("unroll") for (int g4 = 0; g4 < 4; ++g4) _Pragma("unroll") for (int ks = 0; ks < 2; ++ks) \
    dst[g4][ks] = *(const bf16x8*)(Wl + (size_t)(g4 * 64 + (cgi_) * 16 + fr) * 64 + ks * 32 + 8 * fq); } while (0)
template <bool FINAL> __device__ __forceinline__ void lru_phase(const Args& a, LAS unsigned char* lds, int bx, int G, int wave, int lane, int tid) {
    const bf16* proj = (const bf16*)(a.ws + WS_PROJ);
    const int fr = lane & 15, fq = lane >> 4;
    constexpr float L2E = 1.4426950408889634f;
    { LAS float* cst = (LAS float*)(lds + LRU_CONST); const float* nl = (const float*)(a.ws + WS_NL); const int e = tid;
      cst[0 * 512 + e] = -a.lru_b_a[e] * L2E; cst[1 * 512 + e] = -a.lru_b_x[e] * L2E; cst[2 * 512 + e] = -a.lru_b_a[LRUW + e] * L2E; cst[3 * 512 + e] = -a.lru_b_x[LRUW + e] * L2E;
      cst[4 * 512 + e] = nl[e] * L2E; cst[5 * 512 + e] = nl[LRUW + e] * L2E;
      cst[6 * 512 + e] = a.conv_w[e]; cst[7 * 512 + e] = a.conv_w[LRUW + e]; cst[8 * 512 + e] = a.conv_w[2 * LRUW + e]; cst[9 * 512 + e] = a.conv_w[3 * LRUW + e]; cst[10 * 512 + e] = a.conv_b[e]; }
    __syncthreads();
    LAS unsigned char* cb = lds + LRU_CB + wave * CB_WAVE;
    const bf16* Wl = (const bf16*)(a.ws + WS_WLRU) + (size_t)wave * 256 * 64;
#define LRU_DMA_SLAB(b_, p0_) do { _Pragma("unroll") for (int k_ = 0; k_ < 5; ++k_) { int pp_ = (p0_) - 2 + 8 * k_ + (lane >> 3); pp_ = pp_ < 0 ? 0 : (pp_ >= LSEQ ? LSEQ - 1 : pp_); \
        __builtin_amdgcn_global_load_lds((const unsigned*)(proj + ((size_t)(b_) * LSEQ + pp_) * INW + COL_LIN + 64 * wave + (lane & 7) * 8), (LAS unsigned*)(lds + LRU_SLAB + wave * SLAB_WAVE + k_ * 1024), 16, 0, 0); } } while (0)
    if (bx < NLU) { const int b0_ = bx / NCH, p00_ = (bx - b0_ * NCH) * CT; LRU_DMA_SLAB(b0_, p00_); }
    bf16x8 wall[4][4][2];
#pragma unroll
    for (int c4 = 0; c4 < 4; ++c4) LRU_LOADW(wall[c4], c4);
    for (int unit = bx; unit < NLU; unit += G) {
        const int b = unit / NCH, ci = unit - b * NCH, p0 = ci * CT; const size_t rowbase = (size_t)b * LSEQ;
        const bool lastc = (ci == NCH - 1);
        { const int j8 = lane & 7, tg = lane >> 3, ch = 64 * wave + 8 * j8;
          if (unit == bx) asm volatile("s_waitcnt vmcnt(0)" ::: "memory"); else asm volatile("s_waitcnt vmcnt(8)" ::: "memory");
          v4u raw[7];
#pragma unroll
          for (int k = 0; k < 7; ++k) { const int pp = p0 + tg * 4 + k - 2;
              const v4u r = *(const LAS v4u*)(lds + LRU_SLAB + wave * SLAB_WAVE + (tg * 4 + k) * 128 + j8 * 16); const bool ok = (pp >= 0 && pp < LSEQ);
              raw[k].x = ok ? r.x : 0u; raw[k].y = ok ? r.y : 0u; raw[k].z = ok ? r.z : 0u; raw[k].w = ok ? r.w : 0u; }
          asm volatile("s_waitcnt lgkmcnt(0)" ::: "memory");
          { const int nu = unit + G;
            if (nu < NLU) { const int nb = nu / NCH, np0 = (nu - nb * NCH) * CT; LRU_DMA_SLAB(nb, np0); } }
          const LAS float* cc = (const LAS float*)(lds + LRU_CONST) + 6 * 512 + ch;
          float acc[4][8];
          { const f32x4 b0 = *(const LAS f32x4*)(cc + 4 * 512), b1 = *(const LAS f32x4*)(cc + 4 * 512 + 4);
#pragma unroll
            for (int o = 0; o < 4; ++o)
#pragma unroll
                for (int e = 0; e < 4; ++e) { acc[o][e] = b0[e]; acc[o][e + 4] = b1[e]; } }
#pragma unroll
          for (int jj = 0; jj < 4; ++jj) { const f32x4 w0 = *(const LAS f32x4*)(cc + jj * 512), w1 = *(const LAS f32x4*)(cc + jj * 512 + 4);
#pragma unroll
              for (int o = 0; o < 4; ++o) { const v4u r = raw[o + jj];
                  acc[o][0] += w0[0] * bflo(r.x); acc[o][1] += w0[1] * bfhi(r.x); acc[o][2] += w0[2] * bflo(r.y); acc[o][3] += w0[3] * bfhi(r.y);
                  acc[o][4] += w1[0] * bflo(r.z); acc[o][5] += w1[1] * bfhi(r.z); acc[o][6] += w1[2] * bflo(r.w); acc[o][7] += w1[3] * bfhi(r.w); } }
#pragma unroll
          for (int o = 0; o < 4; ++o) { v4u w; w.x = pkbf(acc[o][0], acc[o][1]); w.y = pkbf(acc[o][2], acc[o][3]); w.z = pkbf(acc[o][4], acc[o][5]); w.w = pkbf(acc[o][6], acc[o][7]);
              *(LAS v4u*)(cb + (tg * 4 + o) * CB_ROW + j8 * 16) = w; }
        }
        asm volatile("s_waitcnt lgkmcnt(0)" ::: "memory");
        float ssq[2] = {0.f, 0.f};
#pragma unroll
        for (int cgi = 0; cgi < 4; ++cgi) {
            const int chl = cgi * 16 + 4 * fq, ch = 64 * wave + chl;
            f32x4 cf, cbk; v2u graw[2];
            if constexpr (FINAL) { const float* carry = (const float*)(a.ws + WS_CARRY) + (size_t)unit * 1024; cf = *(const f32x4*)(carry + ch); cbk = *(const f32x4*)(carry + LRUW + ch);
#pragma unroll
                for (int tt = 0; tt < 2; ++tt) { const int p = p0 + tt * 16 + fr; graw[tt] = (p < LSEQ) ? *(const v2u*)(proj + (rowbase + p) * INW + COL_LG + ch) : (v2u){0u, 0u}; } }
            const LAS float* cst = (const LAS float*)(lds + LRU_CONST) + ch;
            const f32x4 baf = *(const LAS f32x4*)(cst), bxf = *(const LAS f32x4*)(cst + 512), bab = *(const LAS f32x4*)(cst + 1024), bxb = *(const LAS f32x4*)(cst + 1536), nlf = *(const LAS f32x4*)(cst + 2048), nlb = *(const LAS f32x4*)(cst + 2560);
            float AF[2][4], UF[2][4], AB[2][4], UB[2][4];
#pragma unroll
            for (int tt = 0; tt < 2; ++tt) {
                if (tt == 1 && lastc) {
#pragma unroll
                    for (int i = 0; i < 4; ++i) { AF[1][i] = 1.f; UF[1][i] = 0.f; AB[1][i] = 1.f; UB[1][i] = 0.f; }
                } else {
                const LAS unsigned char* crow = cb + (tt * 16 + fr) * CB_ROW;
                const bf16x8 b0 = *(const LAS bf16x8*)(crow + fq * 16), b1 = *(const LAS bf16x8*)(crow + 64 + fq * 16);
                f32x4 pre[4];
#pragma unroll
                for (int g4 = 0; g4 < 4; ++g4) { pre[g4] = __builtin_amdgcn_mfma_f32_16x16x32_bf16(wall[cgi][g4][0], b0, (f32x4){0.f, 0.f, 0.f, 0.f}, 0, 0, 0);
                    pre[g4] = __builtin_amdgcn_mfma_f32_16x16x32_bf16(wall[cgi][g4][1], b1, pre[g4], 0, 0, 0); }
                const v2u craw = *(const LAS v2u*)(crow + chl * 2);
                const float cv[4] = {bflo(craw.x), bfhi(craw.x), bflo(craw.y), bfhi(craw.y)};
#pragma unroll
                for (int i = 0; i < 4; ++i) {
                    const float rf = __builtin_amdgcn_rcpf(1.0f + __builtin_amdgcn_exp2f(fmaf(pre[0][i], -L2E, baf[i])));
                    const float xf = __builtin_amdgcn_rcpf(1.0f + __builtin_amdgcn_exp2f(fmaf(pre[1][i], -L2E, bxf[i])));
                    const float rb = __builtin_amdgcn_rcpf(1.0f + __builtin_amdgcn_exp2f(fmaf(pre[2][i], -L2E, bab[i])));
                    const float xb = __builtin_amdgcn_rcpf(1.0f + __builtin_amdgcn_exp2f(fmaf(pre[3][i], -L2E, bxb[i])));
                    const float af = __builtin_amdgcn_exp2f(nlf[i] * rf), ab = __builtin_amdgcn_exp2f(nlb[i] * rb);
                    AF[tt][i] = af; AB[tt][i] = ab;
                    UF[tt][i] = __builtin_amdgcn_sqrtf(fmaf(-af, af, 1.0f)) * (xf * cv[i]); UB[tt][i] = __builtin_amdgcn_sqrtf(fmaf(-ab, ab, 1.0f)) * (xb * cv[i]);
                }
                }
                scan4_fwd16(AF[tt], UF[tt]); scan4_bwd16(AB[tt], UB[tt]);
            }
            if constexpr (!FINAL) {
                float S[2][4], PF[2][4], PB[2][4];
#pragma unroll
                for (int i = 0; i < 4; ++i) {
                    const float A0t = __shfl(AF[0][i], 15, 16), B0t = __shfl(UF[0][i], 15, 16), A1t = __shfl(AB[1][i], 0, 16), B1t = __shfl(UB[1][i], 0, 16);
                    PF[0][i] = AF[0][i]; PF[1][i] = AF[1][i] * A0t; const float hf0 = UF[0][i], hf1 = fmaf(AF[1][i], B0t, UF[1][i]);
                    PB[1][i] = AB[1][i]; PB[0][i] = AB[0][i] * A1t; const float hb1 = UB[1][i], hb0 = fmaf(AB[0][i], B1t, UB[0][i]);
                    S[0][i] = hf0 + hb0; S[1][i] = hf1 + hb1;
                    AF[1][i] = hf1; AB[0][i] = hb0; }
                float* agg = (float*)(a.ws + WS_AGG) + (size_t)unit * 2048;
                { const bool isf = (fr == 15);
                  if (isf || fr == 0) { float* dst = agg + (isf ? 0 : LRUW) + ch;
                      *(f32x4*)dst = isf ? (f32x4){PF[1][0], PF[1][1], PF[1][2], PF[1][3]} : (f32x4){PB[0][0], PB[0][1], PB[0][2], PB[0][3]};
                      *(f32x4*)(dst + 1024) = isf ? (f32x4){AF[1][0], AF[1][1], AF[1][2], AF[1][3]} : (f32x4){AB[0][0], AB[0][1], AB[0][2], AB[0][3]}; } }
#pragma unroll
                for (int tt = 0; tt < 2; ++tt) { const int p = p0 + tt * 16 + fr;
                    unsigned* sp = (unsigned*)(a.ws + WS_SP) + ((p < LSEQ) ? (rowbase + p) : (size_t)(TNAT + (p - LSEQ))) * 512 + ch;
                    v4u w;
#pragma unroll
                    for (int i = 0; i < 4; ++i) { const unsigned sb = pkbf(0.f, S[tt][i]) & 0xffff0000u;
                        const unsigned pf = (unsigned)__builtin_rintf(PF[tt][i] * 255.0f), pb = (unsigned)__builtin_rintf(PB[tt][i] * 255.0f); w[i] = sb | (pf << 8) | pb; }
                    *(v4u*)sp = w; }
            } else {
                float hs[2][4];
#pragma unroll
                for (int i = 0; i < 4; ++i) {
                    const float hf0 = fmaf(AF[0][i], cf[i], UF[0][i]); const float c1 = __shfl(hf0, 15, 16); const float hf1 = fmaf(AF[1][i], c1, UF[1][i]);
                    const float hb1 = fmaf(AB[1][i], cbk[i], UB[1][i]); const float c0 = __shfl(hb1, 0, 16); const float hb0 = fmaf(AB[0][i], c0, UB[0][i]);
                    hs[0][i] = hf0 + hb0; hs[1][i] = hf1 + hb1; }
#pragma unroll
                for (int tt = 0; tt < 2; ++tt) { const int tok = tt * 16 + fr; f32x4 y;
                    const float gv[4] = {bflo(graw[tt].x), bfhi(graw[tt].x), bflo(graw[tt].y), bfhi(graw[tt].y)};
#pragma unroll
                    for (int i = 0; i < 4; ++i) { const float g = gv[i], z = (-1.5957691216057308f * L2E) * fmaf(0.044715f * g * g, g, g);
                        y[i] = hs[tt][i] * g * __builtin_amdgcn_rcpf(1.0f + __builtin_amdgcn_exp2f(z)); }
                    ssq[tt] += (y[0] * y[0] + y[1] * y[1]) + (y[2] * y[2] + y[3] * y[3]);
                    *(LAS f32x4*)(lds + LRU_Y + tok * Y_ROW + ch * 4) = y; }
            }
        }
        if constexpr (FINAL) {
#pragma unroll
            for (int tt = 0; tt < 2; ++tt) { float s = ssq[tt]; s += __shfl_xor(s, 16); s += __shfl_xor(s, 32); if (fq == 0) *(LAS float*)(lds + LRU_PART + ((tt * 16 + fr) * 8 + wave) * 4) = s; }
            __syncthreads();
            { const int tok = tid >> 4, seg = tid & 15, p = p0 + tok;
              if (p >= NMETA && p < LSEQ) {
                  const LAS f32x4* pp = (const LAS f32x4*)(lds + LRU_PART + tok * 32); const f32x4 s0 = pp[0], s1 = pp[1];
                  const float tot = ((s0[0] + s0[1]) + (s0[2] + s0[3])) + ((s1[0] + s1[1]) + (s1[2] + s1[3]));
                  const float rstd = __builtin_amdgcn_rsqf(tot * (1.0f / LRUW) + 1e-6f);
                  bf16* orow = (bf16*)(a.ws + WS_XN) + ((size_t)b * SEQ + (p - NMETA)) * DM + LRUW;
#pragma unroll
                  for (int k = 0; k < 4; ++k) { const int ch = k * 128 + seg * 8;
                      const LAS f32x4* yp = (const LAS f32x4*)(lds + LRU_Y + tok * Y_ROW + ch * 4); const f32x4 y0 = yp[0], y1 = yp[1];
                      const f32x4 g0 = *(const f32x4*)(a.lru_out_g + ch), g1 = *(const f32x4*)(a.lru_out_g + ch + 4);
                      v4u w; w.x = pkbf(y0[0] * rstd * g0[0], y0[1] * rstd * g0[1]); w.y = pkbf(y0[2] * rstd * g0[2], y0[3] * rstd * g0[3]);
                      w.z = pkbf(y1[0] * rstd * g1[0], y1[1] * rstd * g1[1]); w.w = pkbf(y1[2] * rstd * g1[2], y1[3] * rstd * g1[3]);
                      *(v4u*)(orow + ch) = w; } } }
            __syncthreads();
        }
    }
    __syncthreads();
}

__device__ __forceinline__ void mix_norm_phase(const Args& a, int vcu, int G, int wave, int lane) {
    const bf16* proj = (const bf16*)(a.ws + WS_PROJ); const unsigned* SP = (const unsigned*)(a.ws + WS_SP); const float* carry = (const float*)(a.ws + WS_CARRY); bf16* mix = (bf16*)(a.ws + WS_XN);
    const int gw = vcu * NWAVES + wave, NGW = G * NWAVES, ch = lane * 8; constexpr float L2E = 1.4426950408889634f;
    const f32x4 ga0 = *(const f32x4*)(a.attn_out_g + ch), ga1 = *(const f32x4*)(a.attn_out_g + ch + 4), gl0 = *(const f32x4*)(a.lru_out_g + ch), gl1 = *(const f32x4*)(a.lru_out_g + ch + 4);
    for (int r = gw; r < MC; r += NGW) {
        const int b = r >> 13, p = (r & 8191) + NMETA; const size_t nat = (size_t)b * LSEQ + p; const int unit = b * NCH + (p >> 5);
        bf16* mrow = mix + (size_t)r * DM;
        const v4u ao = *(const v4u*)(mrow + ch);
        const v4u sp0 = *(const v4u*)(SP + nat * 512 + ch), sp1 = *(const v4u*)(SP + nat * 512 + ch + 4), gr = *(const v4u*)(proj + nat * INW + COL_LG + ch);
        const float* cp = carry + (size_t)unit * 1024 + ch;
        const f32x4 cf0 = *(const f32x4*)cp, cf1 = *(const f32x4*)(cp + 4), cb0 = *(const f32x4*)(cp + 512), cb1 = *(const f32x4*)(cp + 516);
        { float x[8] = {bflo(ao.x), bfhi(ao.x), bflo(ao.y), bfhi(ao.y), bflo(ao.z), bfhi(ao.z), bflo(ao.w), bfhi(ao.w)}; float s = 0.f;
#pragma unroll
          for (int e = 0; e < 8; ++e) s += x[e] * x[e];
          const float rstd = __builtin_amdgcn_rsqf(wave_sum(s) * (1.0f / 512.0f) + 1e-6f);
          v4u w; w.x = pkbf(x[0] * rstd * ga0[0], x[1] * rstd * ga0[1]); w.y = pkbf(x[2] * rstd * ga0[2], x[3] * rstd * ga0[3]);
          w.z = pkbf(x[4] * rstd * ga1[0], x[5] * rstd * ga1[1]); w.w = pkbf(x[6] * rstd * ga1[2], x[7] * rstd * ga1[3]);
          *(v4u*)(mrow + ch) = w; }
        { const unsigned spw[8] = {sp0.x, sp0.y, sp0.z, sp0.w, sp1.x, sp1.y, sp1.z, sp1.w};
          float S[8], PF[8], PB[8];
#pragma unroll
          for (int e = 0; e < 8; ++e) { S[e] = __uint_as_float(spw[e] & 0xffff0000u); PF[e] = (float)((spw[e] >> 8) & 255u) * (1.0f / 255.0f); PB[e] = (float)(spw[e] & 255u) * (1.0f / 255.0f); }
          const float gv[8] = {bflo(gr.x), bfhi(gr.x), bflo(gr.y), bfhi(gr.y), bflo(gr.z), bfhi(gr.z), bflo(gr.w), bfhi(gr.w)};
          float y[8]; float s = 0.f;
#pragma unroll
          for (int e = 0; e < 8; ++e) { const float cf = e < 4 ? cf0[e & 3] : cf1[e & 3], cbk = e < 4 ? cb0[e & 3] : cb1[e & 3];
              const float h = fmaf(PF[e], cf, fmaf(PB[e], cbk, S[e])); const float g = gv[e], z = (-1.5957691216057308f * L2E) * fmaf(0.044715f * g * g, g, g);
              y[e] = h * g * __builtin_amdgcn_rcpf(1.0f + __builtin_amdgcn_exp2f(z)); s += y[e] * y[e]; }
          const float rstd = __builtin_amdgcn_rsqf(wave_sum(s) * (1.0f / 512.0f) + 1e-6f);
          v4u w; w.x = pkbf(y[0] * rstd * gl0[0], y[1] * rstd * gl0[1]); w.y = pkbf(y[2] * rstd * gl0[2], y[3] * rstd * gl0[3]);
          w.z = pkbf(y[4] * rstd * gl1[0], y[5] * rstd * gl1[1]); w.w = pkbf(y[6] * rstd * gl1[2], y[7] * rstd * gl1[3]);
          *(v4u*)(mrow + LRUW + ch) = w; }
    }
}

__device__ __forceinline__ void lru_carry(const Args& a, LAS unsigned char* lds, int g, int tid) {
    const float* __restrict__ agg = (const float*)(a.ws + WS_AGG); float* __restrict__ carry = (float*)(a.ws + WS_CARRY);
    const int b = g >> 4, dc0 = (g & 15) * 64, dir = dc0 >> 9;
    const int lane = tid & 63, wv = __builtin_amdgcn_readfirstlane(tid >> 6);
    LAS float* sm = (LAS float*)lds;
    { const int sub = lane >> 4, j = lane & 15;
      for (int k = wv; k < (NCH + 1) / 2; k += NWAVES) { int ci = 2 * k + (sub >> 1); ci = ci < NCH ? ci : NCH - 1;
          __builtin_amdgcn_global_load_lds((const unsigned*)(agg + (size_t)(b * NCH + ci) * 2048 + (sub & 1) * 1024 + dc0 + j * 4), (LAS unsigned*)(lds + k * 1024), 16, 0, 0); } }
    asm volatile("s_waitcnt vmcnt(0)" ::: "memory");
    __syncthreads();
    LAS float* seg = (LAS float*)(lds + 258 * 512);
    const int q0 = 33 * wv, q1 = (q0 + 33 < NCH) ? q0 + 33 : NCH;
    { float As = 1.f, Bs = 0.f;
      for (int q = q0; q < q1; ++q) { const int ci = dir ? (NCH - 1 - q) : q; const float A = sm[ci * 128 + lane], B = sm[ci * 128 + 64 + lane]; Bs = fmaf(A, Bs, B); As *= A; }
      seg[wv * 128 + lane] = As; seg[wv * 128 + 64 + lane] = Bs; }
    __syncthreads();
    { float h = 0.f;
      for (int v = 0; v < wv; ++v) h = fmaf(seg[v * 128 + lane], h, seg[v * 128 + 64 + lane]);
      float* cp = carry + (size_t)b * NCH * 1024 + dc0 + lane;
      for (int q = q0; q < q1; ++q) { const int ci = dir ? (NCH - 1 - q) : q; const float A = sm[ci * 128 + lane], B = sm[ci * 128 + 64 + lane]; cp[(size_t)ci * 1024] = h; h = fmaf(A, h, B); } }
    __syncthreads();
}

#define XB_TMO      128
#define XB_XCNT(j)  (256  + 64 * (j))
#define XB_XSUB(j)  (1280 + 64 * (j))
#define XB_XGEN(j)  (2304 + 64 * (j))
#define XB_TOP      3328
#define XB_TOPGEN   3392
#define XCD_BAR_WORDS 3456
#define XB_SPIN_CAP (1u << 18)

__device__ __forceinline__ unsigned xb_ld(unsigned* p)              { return __hip_atomic_load(p, __ATOMIC_RELAXED, __HIP_MEMORY_SCOPE_AGENT); }
__device__ __forceinline__ unsigned xb_add(unsigned* p, unsigned v) { return __hip_atomic_fetch_add(p, v, __ATOMIC_RELAXED, __HIP_MEMORY_SCOPE_AGENT); }
__device__ __forceinline__ unsigned xb_xcc_id() { return (unsigned)__builtin_amdgcn_s_getreg((3 << 11) | 20) & 0xFu; }
#define XB_SPIN(cond, bar) do { unsigned _sp = 0; while (cond) { __builtin_amdgcn_s_sleep(1); \
    if ((++_sp & 255u) == 0u) { if (xb_ld(&(bar)[XB_TMO])) break; if (_sp > XB_SPIN_CAP) { atomicAdd(&(bar)[XB_TMO], 1u); break; } } } } while (0)

struct XcdBarrier {
    unsigned* bar; unsigned x;
    volatile LAS unsigned* st;
};

__device__ __forceinline__ XcdBarrier xcd_barrier_post(unsigned* bar, volatile LAS unsigned* st) {
    XcdBarrier b; b.bar = bar; b.x = xb_xcc_id(); b.st = st;
    if (threadIdx.x == 0) (void)xb_add(&bar[XB_XCNT(b.x)], 1u);
    return b;
}
__device__ __forceinline__ void xcd_barrier_complete(unsigned* bar, unsigned x, unsigned& nloc, unsigned& nx) {
    const unsigned G = gridDim.x * gridDim.y * gridDim.z;
    unsigned sum, cnt, mine, sp = 0u;
    for (;;) {
        sum = 0u; cnt = 0u; mine = 0u;
#pragma unroll
        for (unsigned j = 0; j < 16; ++j) { const unsigned c = xb_ld(&bar[XB_XCNT(j)]); sum += c; cnt += (c > 0u) ? 1u : 0u; mine = (j == x) ? c : mine; }
        if (sum == G) break;
        __builtin_amdgcn_s_sleep(1);
        if ((++sp & 255u) == 0u) { if (xb_ld(&bar[XB_TMO])) break; if (sp > XB_SPIN_CAP) { atomicAdd(&bar[XB_TMO], 1u); break; } }
    }
    nloc = mine > 0u ? mine : 1u; nx = cnt > 0u ? cnt : 1u;
}

__device__ __forceinline__ void xcd_barrier(const XcdBarrier& b) {
    asm volatile("s_waitcnt vmcnt(0)" ::: "memory");
    __syncthreads();
    if (threadIdx.x == 0) {
        unsigned* bar = b.bar;
        __builtin_amdgcn_s_waitcnt(0);
        unsigned nloc = b.st[0], nx = b.st[1];
        if (nloc == 0u) { xcd_barrier_complete(bar, b.x, nloc, nx); b.st[0] = nloc; b.st[1] = nx; }
        const unsigned old = xb_add(&bar[XB_XSUB(b.x)], 1u);
        const unsigned gen = old / nloc;
        if (old + 1u == (gen + 1u) * nloc) {
            __builtin_amdgcn_fence(__ATOMIC_RELEASE, "agent");
            asm volatile("s_waitcnt vmcnt(0)" ::: "memory");
            const unsigned og = xb_add(&bar[XB_TOP], 1u);
            const unsigned tg = og / nx;
            if (og + 1u == (tg + 1u) * nx) xb_add(&bar[XB_TOPGEN], 1u);
            else XB_SPIN(xb_ld(&bar[XB_TOPGEN]) == tg, bar);
            __builtin_amdgcn_fence(__ATOMIC_ACQUIRE, "agent");
            xb_add(&bar[XB_XGEN(b.x)], 1u);
            asm volatile("s_waitcnt vmcnt(0)" ::: "memory");
        } else {
            XB_SPIN(xb_ld(&bar[XB_XGEN(b.x)]) == gen, bar);
            __builtin_amdgcn_fence(__ATOMIC_ACQUIRE, "agent");
            asm volatile("s_waitcnt vmcnt(0)" ::: "memory");
        }
    }
    __syncthreads();
}

__global__ void __launch_bounds__(NWAVES * 64, 2) hymba_fwd(Args a) {
    extern __shared__ __attribute__((aligned(16))) unsigned char lds_raw[];
    LAS unsigned char* lds = (LAS unsigned char*)lds_raw;
    cg::grid_group grid = cg::this_grid();
    const int wave = __builtin_amdgcn_readfirstlane((int)threadIdx.x >> 6);
#define FRESH_IDS const int lane = fresh_lane(), tid = wave * 64 + lane; (void)tid; (void)lane
    const int G = gridDim.x, bx = blockIdx.x, vcu = (G % 8 == 0) ? (bx % 8) * (G / 8) + bx / 8 : bx;
    volatile LAS unsigned* bst = (volatile LAS unsigned*)(lds + LDS_BYTES - 32);
    if (threadIdx.x < 2) bst[threadIdx.x] = 0u;
    __syncthreads();
    XcdBarrier bar = xcd_barrier_post((unsigned*)a.ws + a.ph_lo * 4096, bst);
    unsigned char* ws = a.ws;
    const int lo = a.ph_lo, hi = a.ph_hi;
#define IN(k) (lo <= (k) && (k) < hi)
#define SEAM(k) do { if (IN(k) && IN((k) + 1)) xcd_barrier(bar); } while (0)
    if (a.ph_hi > 1000) grid.sync();

    if (IN(0)) { FRESH_IDS; phase0(a, lds, vcu, G, wave, lane, tid); }
    SEAM(0);
    if (IN(1)) {
        pg8::Gemm g{(const pg8::bf16_t*)(ws + WS_XN), (const pg8::bf16_t*)(ws + WS_WIN), MP, INW, DM}; pg8::StaticOrder S; S.init(MP, INW, G, bx);
        pg8::EpiStore E{(pg8::bf16_t*)(ws + WS_PROJ), INW};
        pg8::gemm_phase<pg8::EpiStore, pg8::StaticOrder, true, true>(lds, g, S, E, wave);
    }
    SEAM(1);
    if (IN(2)) {
        { FRESH_IDS; phase_qk(a, vcu, G, wave, lane); }
        { FRESH_IDS; lru_phase<false>(a, lds, bx, G, wave, lane, tid); }
    }
    SEAM(2);
    if (IN(3)) {
        for (int g = bx; g < 192; g += G) { FRESH_IDS; lru_carry(a, lds, g, tid); }
        const float negM = *(const float*)(ws + WS_NEGM);
        const attn_body::bf16* proj = (const attn_body::bf16*)(ws + WS_PROJ); attn_body::bf16* mix = (attn_body::bf16*)(ws + WS_XN);
        if (G == 256) {
            const int x = bx & 7, jl = bx >> 3;
            for (int i = 0; i < 12; ++i) { const int pi = x + 8 * (i >> 2), w = jl * 4 + (i & 3), b = pi >> 1, kvh = pi & 1, h = kvh * 4 + (w >> 5), qb = w & 31;
                attn_body::attn_unit<8>(proj + ((size_t)b * LSEQ + NMETA + qb * 256) * INW + h * 64, proj + (size_t)b * LSEQ * INW + COL_K + kvh * 64, proj + (size_t)b * LSEQ * INW + COL_V + kvh * 64,
                                        mix + ((size_t)b * SEQ + qb * 256) * DM + h * 64, (char*)lds_raw, negM, wave, a.q_norm_g, (const float*)(ws + WS_COS), (const float*)(ws + WS_SIN), qb * 256); }
        } else {
            for (int u = bx; u < NSEQ * 8 * 32; u += G) { const int b = u >> 8, h = (u >> 5) & 7, qb = u & 31, kvh = h >> 2;
                attn_body::attn_unit<8>(proj + ((size_t)b * LSEQ + NMETA + qb * 256) * INW + h * 64, proj + (size_t)b * LSEQ * INW + COL_K + kvh * 64, proj + (size_t)b * LSEQ * INW + COL_V + kvh * 64,
                                        mix + ((size_t)b * SEQ + qb * 256) * DM + h * 64, (char*)lds_raw, negM, wave, a.q_norm_g, (const float*)(ws + WS_COS), (const float*)(ws + WS_SIN), qb * 256); }
        }
    }
    SEAM(3);
    if (IN(4)) { FRESH_IDS; mix_norm_phase(a, vcu, G, wave, lane); }
    SEAM(4);
    if (IN(5)) {
        pg8::Gemm g{(const pg8::bf16_t*)(ws + WS_XN), (const pg8::bf16_t*)(ws + WS_WOUT), MC, DM, DM}; pg8::StaticOrder S; S.init(MC, DM, G, bx);
        pg8::EpiResid1 E{a.x_prompt, a.x_sample, a.out, (pg8::bf16_t*)(ws + WS_H1B), (float*)(ws + WS_SSQ1)};
        pg8::gemm_phase<pg8::EpiResid1, pg8::StaticOrder, true, true>(lds, g, S, E, wave);
    }
    SEAM(5);
    if (IN(6)) {
        pg8::Gemm g{(const pg8::bf16_t*)(ws + WS_H1B), (const pg8::bf16_t*)(ws + WS_WGU), MC, 2 * FFH, DM}; pg8::StaticOrder S; S.init(MC, 2 * FFH, G, bx);
        pg8::EpiSwiglu E{(pg8::bf16_t*)(ws + WS_HID), FFH, (const float*)(ws + WS_SSQ1)};
        pg8::gemm_phase<pg8::EpiSwiglu, pg8::StaticOrder, true, true>(lds, g, S, E, wave);
    }
    SEAM(6);
    if (IN(7)) {
        pg8::Gemm g{(const pg8::bf16_t*)(ws + WS_HID), (const pg8::bf16_t*)(ws + WS_WDN), MC, DM, FFH}; pg8::StaticOrder S; S.init(MC, DM, G, bx);
        if (G == 256) { pg8::EpiFinal E{a.out, (const pg8::bf16_t*)(ws + WS_H1B), a.final_norm_g, (float*)(ws + WS_SSQ2), (unsigned*)(ws + WS_CNT), lds + 131072};
            pg8::gemm_phase<pg8::EpiFinal, pg8::StaticOrder, true, true>(lds, g, S, E, wave); }
        else { pg8::EpiResid2 E{a.out, (float*)(ws + WS_SSQ2), (const pg8::bf16_t*)(ws + WS_H1B)};
            pg8::gemm_phase<pg8::EpiResid2, pg8::StaticOrder, true, true>(lds, g, S, E, wave); }
    }
    if (G != 256) {
    SEAM(7);
    if (IN(8)) {
        FRESH_IDS;
        const int gw = vcu * NWAVES + wave, NGW = G * NWAVES; const float* ssq = (const float*)(ws + WS_SSQ2);
        f32x4 g4[4];
#pragma unroll
        for (int j = 0; j < 4; ++j) g4[j] = *((const f32x4*)a.final_norm_g + lane + 64 * j);
        for (int r = gw; r < MC; r += NGW) { f32x4* xr = (f32x4*)(a.out + (size_t)r * DM) + lane;
            const f32x4* sp = (const f32x4*)(ssq + (size_t)r * 16); const f32x4 s0 = sp[0], s1 = sp[1], s2 = sp[2], s3 = sp[3];
            const float tot = (((s0[0] + s0[1]) + (s0[2] + s0[3])) + ((s1[0] + s1[1]) + (s1[2] + s1[3]))) + (((s2[0] + s2[1]) + (s2[2] + s2[3])) + ((s3[0] + s3[1]) + (s3[2] + s3[3])));
            const float rstd = __builtin_amdgcn_rsqf(tot * (1.0f / DM) + 1e-6f);
#pragma unroll
            for (int j = 0; j < 4; ++j) xr[64 * j] = xr[64 * j] * rstd * g4[j]; }
    }
    }
#undef IN
#undef SEAM
}

extern "C" void kernel_launch(void* const* d_in, const int* in_sizes, int n_in, void* d_out, int out_size, void* d_ws, size_t ws_size, hipStream_t stream) {
    static int grid = 0;
    if (grid == 0) {
        if (n_in != 21 || out_size != MC * DM || ws_size < WS_END) { fprintf(stderr, "kernel_launch: unexpected shapes (n_in %d out %d ws %zu)\n", n_in, out_size, ws_size); grid = -1; return; }
        int dev = 0, cus = 0, per_cu = 0;
        (void)hipGetDevice(&dev); (void)hipDeviceGetAttribute(&cus, hipDeviceAttributeMultiprocessorCount, dev);
        if (hipFuncSetAttribute((const void*)hymba_fwd, hipFuncAttributeMaxDynamicSharedMemorySize, LDS_BYTES) != hipSuccess) { fprintf(stderr, "kernel_launch: hipFuncSetAttribute failed\n"); grid = -1; return; }
        if (hipOccupancyMaxActiveBlocksPerMultiprocessor(&per_cu, (const void*)hymba_fwd, NWAVES * 64, LDS_BYTES) != hipSuccess || per_cu < 1) { fprintf(stderr, "kernel_launch: occupancy query says %d\n", per_cu); per_cu = 1; }
        (void)hipGetLastError();
        grid = cus * 1;
        if (grid <= 0) grid = 256;
    }
    if (grid < 0) return;
    (void)hipMemsetAsync(d_ws, 0, 16384 * NPHASE, stream);
    Args a{};
    const float** slots[21] = {&a.x_prompt, &a.x_sample, &a.meta, &a.norm_mix_g, &a.w_in, &a.q_norm_g, &a.k_norm_g, &a.conv_w, &a.conv_b, &a.lru_w_a, &a.lru_b_a, &a.lru_w_x, &a.lru_b_x, &a.lru_lam,
                               &a.attn_out_g, &a.lru_out_g, &a.w_out, &a.norm_ffn_g, &a.w_gate_up, &a.w_down, &a.final_norm_g};
    for (int i = 0; i < 21; ++i) *slots[i] = (const float*)d_in[i];
    a.out = (float*)d_out; a.ws = (unsigned char*)d_ws;
#if MK_N_LAUNCHES == 1
    a.ph_lo = 0; a.ph_hi = NPHASE;
    void* args[] = {&a};
    hipError_t e = hipLaunchCooperativeKernel((const void*)hymba_fwd, dim3(grid), dim3(NWAVES * 64), args, LDS_BYTES, stream);
    if (e != hipSuccess) fprintf(stderr, "kernel_launch: cooperative launch failed: %s (grid %d)\n", hipGetErrorString(e), grid);
#else
    for (int p = 0; p < NPHASE; ++p) { a.ph_lo = p; a.ph_hi = p + 1; hipLaunchKernelGGL(hymba_fwd, dim3(grid), dim3(NWAVES * 64), LDS_BYTES, stream, a); }
#endif
}
```

```cpp
#include <hip/hip_runtime.h>
#include <hip/hip_cooperative_groups.h>
#include <hip/hip_bf16.h>
#include <cstdio>
#include <cstdint>
#include <cmath>
namespace cg = cooperative_groups;
__device__ __forceinline__ int fresh_lane() { int l; asm volatile("v_mbcnt_lo_u32_b32 %0, -1, 0\n\tv_mbcnt_hi_u32_b32 %0, -1, %0" : "=v"(l)); return l; }

namespace pg8 {
#define PG8_LAS __attribute__((address_space(3)))
typedef unsigned short bf16_t;
typedef short bf16x8 __attribute__((ext_vector_type(8)));
typedef float f32x4 __attribute__((ext_vector_type(4)));
typedef unsigned u32x4 __attribute__((ext_vector_type(4)));
constexpr int BM = 256, BK = 64, HALF = 128, HTB = HALF * BK * 2  , STAGE_BYTES = 8 * HTB, NXCD = 8, WGM = 8;

__host__ __device__ __forceinline__ int lds_byte(int r, int c) { const int st = (r >> 4) * 2 + (c >> 5), rr = r & 15, cc = c & 31, ob = rr * 64 + cc * 2; return st * 1024 + (ob ^ (((ob >> 9) & 1) << 5)); }
__host__ __device__ __forceinline__ void stage_rc(int b, int& R, int& C) { const int st = b / 1024, sb = b % 1024, swz = sb ^ (((sb >> 9) & 1) << 5); R = (st >> 1) * 16 + swz / 64; C = (st & 1) * 32 + (swz % 64) / 2; }
__host__ __device__ __forceinline__ int perm32(int rho) { const int n = rho >> 4, i = rho & 15; return 8 * (i >> 2) + 4 * n + (i & 3); }

struct Unit { int pm, pn; };
struct Gemm { const bf16_t* A; const bf16_t* Bt; int M, N, K; };

struct StaticOrder {
    int nM, nN, nwg, G, c;
    __host__ __device__ void init(int M, int N, int G_, int c_) { nM = M / BM; nN = N / BM; nwg = nM * nN; G = G_; c = c_; }
    __host__ __device__ bool next(int i, Unit& u) const {
        const long L = (long)i * G + c; if (L >= nwg) return false;
        int wgid = (int)L; { const int q = nwg / NXCD, r = nwg % NXCD, xcd = wgid % NXCD, off = wgid / NXCD; wgid = (xcd < r ? xcd * (q + 1) : r * (q + 1) + (xcd - r) * q) + off; }
        const int nig = WGM * nN, gid = wgid / nig, fm = gid * WGM, gsz = (nM - fm) < WGM ? (nM - fm) : WGM;
        u.pm = fm + ((wgid % nig) % gsz); u.pn = (wgid % nig) / gsz; return true;
    }
    __device__ __forceinline__ void a_ready(const Unit&) const {}
    __device__ __forceinline__ void done(const Unit&) const {}
};


template <class Epi, class Sched, bool ALIGN_EPI = false, bool SP2 = false>
__device__ __forceinline__ void gemm_phase(PG8_LAS unsigned char* lds, const Gemm g, const Sched& S, const Epi& E, const int wid) {
    const int lane = fresh_lane(), tid = wid * 64 + lane, wr = wid >> 2, wc = wid & 3, fr = lane & 15, fq = lane >> 4;
    const int K = g.K, nt = K / BK;
    unsigned voffA[2], voffB[2];
#pragma unroll
    for (int i = 0; i < 2; ++i) { int R, C; stage_rc(tid * 16 + i * 8192, R, C); const int Rb = Epi::PERM ? ((R & ~31) + perm32(R & 31)) : R;
        voffA[i] = (unsigned)(R * K + C) * 2u; voffB[i] = (unsigned)(Rb * K + C) * 2u; }
    const size_t kstep = (size_t)(BK * 2);
    const size_t hstep = (size_t)HALF * K * 2;
    const size_t tstep = 2 * hstep;
    const unsigned ldsw = (unsigned)wid * 1024u;
    const int aoff = lds_byte(wr * 64 + fr, fq * 8), boff = lds_byte(wc * 32 + fr, fq * 8);
#define PG8_SA(b, h) (((b) * 2 + (h)) * HTB)
#define PG8_SB(b, h) ((4 + (b) * 2 + (h)) * HTB)
#define PG8_STAGE(bufoff, gbase, voff) do { _Pragma("unroll") for (int _i = 0; _i < 2; ++_i) \
        __builtin_amdgcn_global_load_lds((const unsigned*)((const char*)(gbase) + (voff)[_i]), (PG8_LAS unsigned*)(lds + (bufoff) + ldsw + _i * 8192), 16, 0, 0); } while (0)
#define PG8_LDA(dst, b, h) do { _Pragma("unroll") for (int m = 0; m < 4; ++m) _Pragma("unroll") for (int k = 0; k < 2; ++k) dst[m][k] = *(const PG8_LAS bf16x8*)(lds + PG8_SA(b, h) + aoff + m * 2048 + k * 1024); } while (0)
#define PG8_LDB(dst, b, h) do { _Pragma("unroll") for (int n = 0; n < 2; ++n) _Pragma("unroll") for (int k = 0; k < 2; ++k) dst[n][k] = *(const PG8_LAS bf16x8*)(lds + PG8_SB(b, h) + boff + n * 2048 + k * 1024); } while (0)
#define PG8_MMA(ai, bj, At, Bt) do { __builtin_amdgcn_s_setprio(1); _Pragma("unroll") for (int m = 0; m < 4; ++m) _Pragma("unroll") for (int n = 0; n < 2; ++n) _Pragma("unroll") for (int k = 0; k < 2; ++k) \
        acc[ai][bj][m][n] = __builtin_amdgcn_mfma_f32_16x16x32_bf16(Bt[n][k], At[m][k], acc[ai][bj][m][n], 0, 0, 0); __builtin_amdgcn_s_setprio(0); } while (0)
#define PG8_WAIT_V(n) asm volatile("s_waitcnt vmcnt(" #n ")" ::: "memory")
#define PG8_WAIT_L(n) asm volatile("s_waitcnt lgkmcnt(" #n ")" ::: "memory")
#define PG8_BAR __builtin_amdgcn_s_barrier()
#define PG8_SCHED __builtin_amdgcn_sched_barrier(0)
    Unit cur, nxt; int ui = 0;
    if (!S.next(0, cur)) return;
    f32x4 acc[2][2][4][2];
#pragma unroll
    for (int a = 0; a < 2; ++a)
#pragma unroll
        for (int b = 0; b < 2; ++b)
#pragma unroll
            for (int m = 0; m < 4; ++m)
#pragma unroll
                for (int n = 0; n < 2; ++n) acc[a][b][m][n] = (f32x4){0.f, 0.f, 0.f, 0.f};
    bf16x8 At[4][2], B0[2][2], B1[2][2];
    const char* cA = (const char*)g.A + (size_t)cur.pm * tstep; const char* cB = (const char*)g.Bt + (size_t)cur.pn * tstep;
    S.a_ready(cur);
    if constexpr (SP2) {
        PG8_STAGE(PG8_SB(0, 0), cB, voffB); PG8_STAGE(PG8_SB(0, 1), cB + hstep, voffB); PG8_STAGE(PG8_SA(0, 0), cA, voffA); PG8_STAGE(PG8_SA(0, 1), cA + hstep, voffA);
        if (wr == 1) PG8_BAR;
        PG8_WAIT_V(2); PG8_BAR;
        PG8_STAGE(PG8_SB(1, 0), cB + kstep, voffB); PG8_STAGE(PG8_SA(1, 0), cA + kstep, voffA); PG8_STAGE(PG8_SB(1, 1), cB + hstep + kstep, voffB);
        PG8_WAIT_V(6); PG8_BAR;
    } else {
        PG8_STAGE(PG8_SB(0, 0), cB, voffB); PG8_STAGE(PG8_SA(0, 0), cA, voffA); PG8_STAGE(PG8_SB(0, 1), cB + hstep, voffB); PG8_STAGE(PG8_SA(0, 1), cA + hstep, voffA);
        if (wr == 1) PG8_BAR;
        PG8_WAIT_V(4); PG8_BAR;
        PG8_STAGE(PG8_SB(1, 0), cB + kstep, voffB); PG8_STAGE(PG8_SA(1, 0), cA + kstep, voffA); PG8_STAGE(PG8_SB(1, 1), cB + hstep + kstep, voffB);
        PG8_WAIT_V(6); PG8_BAR;
    }
    for (;;) {
        const bool has_next = S.next(ui + 1, nxt);
        const char* nA = has_next ? (const char*)g.A + (size_t)nxt.pm * tstep : cA; const char* nB = has_next ? (const char*)g.Bt + (size_t)nxt.pn * tstep : cB;
        for (int t = 0; t < nt; t += 2) {
            const bool last = (t == nt - 2);
            const char* a1 = cA + (size_t)(t + 1) * kstep;
            const char* a2 = last ? nA : cA + (size_t)(t + 2) * kstep; const char* b2 = last ? nB : cB + (size_t)(t + 2) * kstep;
            const char* a3 = a2 + kstep; const char* b3 = b2 + kstep;
            if (last && has_next) S.a_ready(nxt);
            if constexpr (SP2) {
            PG8_LDB(B0, 0, 0); PG8_LDB(B1, 0, 1); PG8_SCHED; PG8_LDA(At, 0, 0); PG8_STAGE(PG8_SA(1, 1), a1 + hstep, voffA);
            PG8_WAIT_V(8); PG8_WAIT_L(0); PG8_BAR; PG8_MMA(0, 0, At, B0); PG8_MMA(0, 1, At, B1); PG8_BAR; PG8_SCHED;
            PG8_LDA(At, 0, 1); PG8_STAGE(PG8_SB(0, 0), b2, voffB); PG8_STAGE(PG8_SB(0, 1), b2 + hstep, voffB); PG8_STAGE(PG8_SA(0, 0), a2, voffA);
            PG8_WAIT_V(8); PG8_WAIT_L(0); PG8_BAR; PG8_MMA(1, 0, At, B0); PG8_MMA(1, 1, At, B1); PG8_BAR; PG8_SCHED;
            PG8_LDB(B0, 1, 0); PG8_LDB(B1, 1, 1); PG8_SCHED; PG8_LDA(At, 1, 0); PG8_STAGE(PG8_SA(0, 1), a2 + hstep, voffA);
            PG8_WAIT_V(8); PG8_WAIT_L(0); PG8_BAR; PG8_MMA(0, 0, At, B0); PG8_MMA(0, 1, At, B1); PG8_BAR; PG8_SCHED;
            PG8_LDA(At, 1, 1); PG8_STAGE(PG8_SB(1, 0), b3, voffB); PG8_STAGE(PG8_SB(1, 1), b3 + hstep, voffB); PG8_STAGE(PG8_SA(1, 0), a3, voffA);
            PG8_WAIT_V(8); PG8_WAIT_L(0); PG8_BAR; PG8_MMA(1, 0, At, B0); PG8_MMA(1, 1, At, B1); PG8_BAR; PG8_SCHED;
            } else {
            PG8_LDB(B0, 0, 0); PG8_SCHED; PG8_LDA(At, 0, 0); PG8_STAGE(PG8_SA(1, 1), a1 + hstep, voffA);
            PG8_WAIT_L(8); PG8_BAR; PG8_WAIT_L(0); PG8_MMA(0, 0, At, B0); PG8_BAR; PG8_SCHED;
            PG8_LDB(B1, 0, 1); PG8_STAGE(PG8_SB(0, 0), b2, voffB);
            PG8_BAR; PG8_WAIT_L(0); PG8_MMA(0, 1, At, B1); PG8_BAR;
            PG8_LDA(At, 0, 1); PG8_STAGE(PG8_SA(0, 0), a2, voffA);
            PG8_BAR; PG8_WAIT_L(0); PG8_MMA(1, 0, At, B0); PG8_BAR; PG8_SCHED;
            PG8_STAGE(PG8_SB(0, 1), b2 + hstep, voffB);
            PG8_WAIT_V(6); PG8_BAR; PG8_MMA(1, 1, At, B1); PG8_BAR;
            PG8_LDB(B0, 1, 0); PG8_SCHED; PG8_LDA(At, 1, 0); PG8_STAGE(PG8_SA(0, 1), a2 + hstep, voffA);
            PG8_WAIT_L(8); PG8_BAR; PG8_WAIT_L(0); PG8_MMA(0, 0, At, B0); PG8_BAR; PG8_SCHED;
            PG8_LDB(B1, 1, 1); PG8_STAGE(PG8_SB(1, 0), b3, voffB);
            PG8_BAR; PG8_WAIT_L(0); PG8_MMA(0, 1, At, B1); PG8_BAR;
            PG8_LDA(At, 1, 1); PG8_STAGE(PG8_SA(1, 0), a3, voffA);
            PG8_BAR; PG8_WAIT_L(0); PG8_MMA(1, 0, At, B0); PG8_BAR; PG8_SCHED;
            PG8_STAGE(PG8_SB(1, 1), b3 + hstep, voffB);
            PG8_WAIT_V(6); PG8_BAR; PG8_MMA(1, 1, At, B1); PG8_BAR;
            }
        }
        if constexpr (ALIGN_EPI) { if (wr == 0) PG8_BAR; }
        if constexpr (!Epi::AFTER_DRAIN) { E(acc, cur, wr, wc, fr, fq); S.done(cur); }
        if (!has_next) break;
#pragma unroll
        for (int a = 0; a < 2; ++a)
#pragma unroll
            for (int b = 0; b < 2; ++b)
#pragma unroll
                for (int m = 0; m < 4; ++m)
#pragma unroll
                    for (int n = 0; n < 2; ++n) acc[a][b][m][n] = (f32x4){0.f, 0.f, 0.f, 0.f};
        cur = nxt; cA = nA; cB = nB; ++ui;
        if constexpr (ALIGN_EPI) { if (wr == 1) PG8_BAR; }
    }
    PG8_WAIT_V(0);
    if constexpr (!ALIGN_EPI) { if (wr == 0) PG8_BAR; }
    PG8_BAR;
    if constexpr (Epi::AFTER_DRAIN) { E.fused(acc, cur, wr, wc, fr, fq, lds, wid, lane); S.done(cur); }
#undef PG8_SA
#undef PG8_SB
#undef PG8_STAGE
#undef PG8_LDA
#undef PG8_LDB
#undef PG8_MMA
#undef PG8_WAIT_V
#undef PG8_WAIT_L
#undef PG8_BAR
#undef PG8_SCHED
}
}

namespace pg8 {
typedef float f32x2e __attribute__((ext_vector_type(2))); typedef __bf16 bf16x2e __attribute__((ext_vector_type(2))); typedef unsigned u32x2e __attribute__((ext_vector_type(2)));
__device__ __forceinline__ unsigned pkbf(float lo, float hi) { f32x2e v = {lo, hi}; bf16x2e b = __builtin_convertvector(v, bf16x2e); return __builtin_bit_cast(unsigned, b); }
struct EpiStore {
    static constexpr bool PERM = true, AFTER_DRAIN = false;
    bf16_t* O; int ldc;
    __device__ __forceinline__ void operator()(const f32x4 (&acc)[2][2][4][2], const Unit& u, int wr, int wc, int fr, int fq) const {
        const int row0 = u.pm * BM + wr * 64 + fr, col0 = u.pn * BM + wc * 32 + 8 * fq;
#pragma unroll
        for (int ai = 0; ai < 2; ++ai)
#pragma unroll
            for (int m = 0; m < 4; ++m) { bf16_t* rowp = O + (size_t)(row0 + ai * HALF + m * 16) * ldc + col0;
#pragma unroll
                for (int bj = 0; bj < 2; ++bj) { const f32x4 v0 = acc[ai][bj][m][0], v1 = acc[ai][bj][m][1];
                    u32x4 w; w.x = pkbf(v0[0], v0[1]); w.y = pkbf(v0[2], v0[3]); w.z = pkbf(v1[0], v1[1]); w.w = pkbf(v1[2], v1[3]);
                    *(u32x4*)(rowp + bj * HALF) = w; } }
    }
};
struct EpiResid1 {
    static constexpr bool PERM = false, AFTER_DRAIN = false;
    const float* xp; const float* xs; float* out; bf16_t* hb; float* ssq;
    __device__ __forceinline__ void operator()(const f32x4 (&acc)[2][2][4][2], const Unit& u, int wr, int wc, int fr, int fq) const {
        asm volatile("" : "+v"(fr), "+v"(fq));
        const int rbase = u.pm * BM;
        const float* xb = rbase < 65536 ? xp + (size_t)rbase * 1024 : xs + (size_t)(rbase - 65536) * 1024;
        bf16_t* hbb = hb + (size_t)rbase * 1024;
        const int col0 = u.pn * BM + wc * 32 + 4 * fq;
#pragma unroll
        for (int ai = 0; ai < 2; ++ai) {
            f32x4 xv[4][2][2];
#pragma unroll
            for (int m = 0; m < 4; ++m)
#pragma unroll
                for (int bj = 0; bj < 2; ++bj)
#pragma unroll
                    for (int n = 0; n < 2; ++n) xv[m][bj][n] = *(const f32x4*)(xb + (size_t)(ai * HALF + wr * 64 + m * 16 + fr) * 1024 + col0 + bj * HALF + n * 16);
            asm volatile("" : "+v"(xv[0][0][0]), "+v"(xv[0][0][1]), "+v"(xv[0][1][0]), "+v"(xv[0][1][1]), "+v"(xv[1][0][0]), "+v"(xv[1][0][1]), "+v"(xv[1][1][0]), "+v"(xv[1][1][1]), "+v"(xv[2][0][0]), "+v"(xv[2][0][1]), "+v"(xv[2][1][0]), "+v"(xv[2][1][1]), "+v"(xv[3][0][0]), "+v"(xv[3][0][1]), "+v"(xv[3][1][0]), "+v"(xv[3][1][1]) :: "memory");
#pragma unroll
            for (int m = 0; m < 4; ++m) { const int r = ai * HALF + wr * 64 + m * 16 + fr; float s = 0.f;
#pragma unroll
                for (int bj = 0; bj < 2; ++bj)
#pragma unroll
                    for (int n = 0; n < 2; ++n) { const size_t off = (size_t)r * 1024 + col0 + bj * HALF + n * 16;
                        const f32x4 h = xv[m][bj][n] + acc[ai][bj][m][n];
                        u32x2e w; w.x = pkbf(h[0], h[1]); w.y = pkbf(h[2], h[3]); *(u32x2e*)(hbb + off) = w;
                        s += (h[0] * h[0] + h[1] * h[1]) + (h[2] * h[2] + h[3] * h[3]); }
                s += __shfl_xor(s, 16); s += __shfl_xor(s, 32);
                if (fq == 0) ssq[(size_t)(rbase + r) * 16 + u.pn * 4 + wc] = s; }
        }
    }
};
struct EpiSwiglu {
    static constexpr bool PERM = true, AFTER_DRAIN = false;
    bf16_t* H; int ldh; const float* ssq;
    __device__ __forceinline__ void operator()(const f32x4 (&acc)[2][2][4][2], const Unit& u, int wr, int wc, int fr, int fq) const {
        const int col0 = u.pn * HALF + wc * 32 + 8 * fq;
        f32x4 part[2][4];
#pragma unroll
        for (int ai = 0; ai < 2; ++ai)
#pragma unroll
            for (int m = 0; m < 4; ++m) part[ai][m] = *(const f32x4*)(ssq + (size_t)(u.pm * BM + ai * HALF + wr * 64 + m * 16 + fr) * 16 + 4 * fq);
        asm volatile("" : "+v"(part[0][0]), "+v"(part[0][1]), "+v"(part[0][2]), "+v"(part[0][3]), "+v"(part[1][0]), "+v"(part[1][1]), "+v"(part[1][2]), "+v"(part[1][3]) :: "memory");
#pragma unroll
        for (int ai = 0; ai < 2; ++ai)
#pragma unroll
            for (int m = 0; m < 4; ++m) { const int row = u.pm * BM + ai * HALF + wr * 64 + m * 16 + fr;
                float tot = (part[ai][m][0] + part[ai][m][1]) + (part[ai][m][2] + part[ai][m][3]);
                tot += __shfl_xor(tot, 16); tot += __shfl_xor(tot, 32);
                const float rstd = __builtin_amdgcn_rsqf(tot * (1.0f / 1024.0f) + 1e-6f);
                float hv[8];
#pragma unroll
                for (int n = 0; n < 2; ++n)
#pragma unroll
                    for (int i = 0; i < 4; ++i) { const float g = acc[ai][0][m][n][i] * rstd, uu = acc[ai][1][m][n][i] * rstd;
                        const float sg = g * __builtin_amdgcn_rcpf(1.0f + __builtin_amdgcn_exp2f(g * -1.4426950408889634f)); hv[n * 4 + i] = sg * uu; }
                u32x4 w; w.x = pkbf(hv[0], hv[1]); w.y = pkbf(hv[2], hv[3]); w.z = pkbf(hv[4], hv[5]); w.w = pkbf(hv[6], hv[7]);
                *(u32x4*)(H + (size_t)row * ldh + col0) = w; }
    }
};
struct EpiResid2 {
    static constexpr bool PERM = false, AFTER_DRAIN = false;
    float* out; float* ssq; const bf16_t* hb;
    __device__ __forceinline__ void operator()(const f32x4 (&acc)[2][2][4][2], const Unit& u, int wr, int wc, int fr, int fq) const {
        const int rbase = u.pm * BM; float* ob = out + (size_t)rbase * 1024;
        const int col0 = u.pn * BM + wc * 32 + 4 * fq;
#pragma unroll
        for (int ai = 0; ai < 2; ++ai)
#pragma unroll
            for (int m = 0; m < 4; ++m) { const int r = ai * HALF + wr * 64 + m * 16 + fr; float s = 0.f;
#pragma unroll
                for (int bj = 0; bj < 2; ++bj)
#pragma unroll
                    for (int n = 0; n < 2; ++n) { const size_t off = (size_t)r * 1024 + col0 + bj * HALF + n * 16;
                        const u32x2e hw = *(const u32x2e*)(hb + (size_t)rbase * 1024 + off);
                        const f32x4 h = (f32x4){__uint_as_float(hw.x << 16), __uint_as_float(hw.x & 0xffff0000u), __uint_as_float(hw.y << 16), __uint_as_float(hw.y & 0xffff0000u)} + acc[ai][bj][m][n];
                        *(f32x4*)(ob + off) = h;
                        s += (h[0] * h[0] + h[1] * h[1]) + (h[2] * h[2] + h[3] * h[3]); }
                s += __shfl_xor(s, 16); s += __shfl_xor(s, 32);
                if (fq == 0) ssq[(size_t)(rbase + r) * 16 + u.pn * 4 + wc] = s; }
    }
};
struct EpiFinal {
    static constexpr bool PERM = false, AFTER_DRAIN = false;
    float* out; const bf16_t* hb; const float* g; float* xbuf; unsigned* cnt; PG8_LAS unsigned char* lx;
    __device__ __forceinline__ void operator()(f32x4 (&acc)[2][2][4][2], const Unit& u, int wr, int wc, int fr, int fq) const {
        int tid = (wr * 4 + wc) * 64 + fresh_lane(); asm volatile("" : "+v"(tid));
        asm volatile("" : "+v"(fr), "+v"(fq));
        const int lane = tid & 63, wid = __builtin_amdgcn_readfirstlane(tid >> 6);
        PG8_LAS float* P = (PG8_LAS float*)lx; PG8_LAS float* S = (PG8_LAS float*)(lx + 4096);
        const int rbase = u.pm * BM; float* ob = out + (size_t)rbase * 1024;
        const int col0 = u.pn * BM + wc * 32 + 4 * fq;
        u32x2e hv[2][4][2][2];
#pragma unroll
        for (int ai = 0; ai < 2; ++ai)
#pragma unroll
            for (int m = 0; m < 4; ++m)
#pragma unroll
                for (int bj = 0; bj < 2; ++bj)
#pragma unroll
                    for (int n = 0; n < 2; ++n) hv[ai][m][bj][n] = *(const u32x2e*)(hb + (size_t)(rbase + ai * HALF + wr * 64 + m * 16 + fr) * 1024 + col0 + bj * HALF + n * 16);
        asm volatile("" : "+v"(hv[0][0][0][0]), "+v"(hv[0][0][0][1]), "+v"(hv[0][0][1][0]), "+v"(hv[0][0][1][1]), "+v"(hv[0][1][0][0]), "+v"(hv[0][1][0][1]), "+v"(hv[0][1][1][0]), "+v"(hv[0][1][1][1]), "+v"(hv[0][2][0][0]), "+v"(hv[0][2][0][1]), "+v"(hv[0][2][1][0]), "+v"(hv[0][2][1][1]), "+v"(hv[0][3][0][0]), "+v"(hv[0][3][0][1]), "+v"(hv[0][3][1][0]), "+v"(hv[0][3][1][1]) :: "memory");
        asm volatile("" : "+v"(hv[1][0][0][0]), "+v"(hv[1][0][0][1]), "+v"(hv[1][0][1][0]), "+v"(hv[1][0][1][1]), "+v"(hv[1][1][0][0]), "+v"(hv[1][1][0][1]), "+v"(hv[1][1][1][0]), "+v"(hv[1][1][1][1]), "+v"(hv[1][2][0][0]), "+v"(hv[1][2][0][1]), "+v"(hv[1][2][1][0]), "+v"(hv[1][2][1][1]), "+v"(hv[1][3][0][0]), "+v"(hv[1][3][0][1]), "+v"(hv[1][3][1][0]), "+v"(hv[1][3][1][1]) :: "memory");
#pragma unroll
        for (int ai = 0; ai < 2; ++ai)
#pragma unroll
            for (int m = 0; m < 4; ++m) { const int r = ai * HALF + wr * 64 + m * 16 + fr; float s = 0.f;
#pragma unroll
                for (int bj = 0; bj < 2; ++bj)
#pragma unroll
                    for (int n = 0; n < 2; ++n) { const u32x2e hw = hv[ai][m][bj][n];
                        const f32x4 h = (f32x4){__uint_as_float(hw.x << 16), __uint_as_float(hw.x & 0xffff0000u), __uint_as_float(hw.y << 16), __uint_as_float(hw.y & 0xffff0000u)} + acc[ai][bj][m][n]; acc[ai][bj][m][n] = h;
                        s += (h[0] * h[0] + h[1] * h[1]) + (h[2] * h[2] + h[3] * h[3]); }
                s += __shfl_xor(s, 16); s += __shfl_xor(s, 32);
                if (fq == 0) P[r * 4 + wc] = s; }
        asm volatile("s_waitcnt lgkmcnt(0)" ::: "memory"); __builtin_amdgcn_s_barrier(); asm volatile("" ::: "memory");
        if (tid < 256) { const f32x4 p = *(const PG8_LAS f32x4*)(P + tid * 4);
            __hip_atomic_store(xbuf + (size_t)(rbase + tid) * 4 + u.pn, (p[0] + p[1]) + (p[2] + p[3]), __ATOMIC_RELAXED, __HIP_MEMORY_SCOPE_AGENT); }
        if (tid < 256) { const float* sl = xbuf + (size_t)(rbase + tid) * 4; float t0 = 0.f, t1 = 0.f, t2 = 0.f, t3 = 0.f;
            for (unsigned sp = 0; sp < (1u << 20); ++sp) {
                t0 = __hip_atomic_load(sl + 0, __ATOMIC_RELAXED, __HIP_MEMORY_SCOPE_AGENT); t1 = __hip_atomic_load(sl + 1, __ATOMIC_RELAXED, __HIP_MEMORY_SCOPE_AGENT);
                t2 = __hip_atomic_load(sl + 2, __ATOMIC_RELAXED, __HIP_MEMORY_SCOPE_AGENT); t3 = __hip_atomic_load(sl + 3, __ATOMIC_RELAXED, __HIP_MEMORY_SCOPE_AGENT);
                if (__float_as_uint(t0) != 0xFFFFFFFFu && __float_as_uint(t1) != 0xFFFFFFFFu && __float_as_uint(t2) != 0xFFFFFFFFu && __float_as_uint(t3) != 0xFFFFFFFFu) break;
                __builtin_amdgcn_s_sleep(2); }
            S[tid] = __builtin_amdgcn_rsqf(((t0 + t1) + (t2 + t3)) * (1.0f / 1024.0f) + 1e-6f); }
        asm volatile("s_waitcnt vmcnt(0) lgkmcnt(0)" ::: "memory"); __builtin_amdgcn_s_barrier(); asm volatile("" ::: "memory");
        f32x4 gv[2][2];
#pragma unroll
        for (int bj = 0; bj < 2; ++bj)
#pragma unroll
            for (int n = 0; n < 2; ++n) gv[bj][n] = *(const f32x4*)(g + col0 + bj * HALF + n * 16);
#pragma unroll
        for (int ai = 0; ai < 2; ++ai)
#pragma unroll
            for (int m = 0; m < 4; ++m) { const int r = ai * HALF + wr * 64 + m * 16 + fr; const float rs = S[r];
#pragma unroll
                for (int bj = 0; bj < 2; ++bj)
#pragma unroll
                    for (int n = 0; n < 2; ++n) *(f32x4*)(ob + (size_t)r * 1024 + col0 + bj * HALF + n * 16) = acc[ai][bj][m][n] * rs * gv[bj][n]; }
        asm volatile("s_waitcnt lgkmcnt(0)" ::: "memory"); __builtin_amdgcn_s_barrier(); asm volatile("" ::: "memory");
    }
};
}

#include <hip/hip_bf16.h>
#include <cmath>
namespace attn_body {
using bf16=__hip_bfloat16;
using bf16x8=__attribute__((ext_vector_type(8)))short;
using s16x4=__attribute__((ext_vector_type(4)))short;
using f32x16=__attribute__((ext_vector_type(16)))float;
using u32x4=__attribute__((ext_vector_type(4)))unsigned;
constexpr int D=64,QP=1792,OP=1024;
constexpr int NW=8,QBLK=32,QB=QBLK*NW,KVBLK=64,NT=129;
__device__ __forceinline__ int crow(int r,int hi){return (r&3)+8*(r>>2)+4*hi;}
#define SBAR() __builtin_amdgcn_sched_barrier(0)
__device__ __forceinline__ void tmask(f32x16&p0,f32x16&p1){
  const float NEG=-INFINITY;
  #pragma unroll
  for(int r=0;r<16;++r){ if(r>=8)p0[r]=NEG; p1[r]=NEG; }
}

constexpr int NSLOT=3, SLOTB=8192;
constexpr int LDS_K=0, LDS_V=NSLOT*SLOTB, LDS_WS=2*NSLOT*SLOTB, LDS_OST=LDS_WS+NW*64*4, LDS_BYTES=LDS_OST+NW*4096;
constexpr float C2=0.125f*1.4426950408889634f;
__device__ __forceinline__ void glds16(const void*gsrc,unsigned lds_dst){unsigned keep;
  asm volatile("s_mov_b32 %0, m0\n\ts_mov_b32 m0, %2\n\ts_nop 0\n\tglobal_load_lds_dwordx4 %1, off\n\ts_mov_b32 m0, %0":"=&s"(keep):"v"(gsrc),"s"(lds_dst):"memory");}
__device__ __forceinline__ float max3f(float a,float b,float c){float r;asm("v_max3_f32 %0, %1, %2, %3":"=v"(r):"v"(a),"v"(b),"v"(c));return r;}
__device__ __forceinline__ float max2f(float a,float b){float r;asm("v_max_f32_e32 %0, %1, %2":"=v"(r):"v"(a),"v"(b));return r;}
__device__ __forceinline__ float fadd_s(float a,float b){float r;asm("v_add_f32_e32 %0, %1, %2":"=v"(r):"v"(a),"v"(b));return r;}
__device__ __forceinline__ float fsub_s(float a,float b){float r;asm("v_sub_f32_e32 %0, %1, %2":"=v"(r):"v"(a),"v"(b));return r;}
typedef float f32x2_t __attribute__((ext_vector_type(2))); typedef __bf16 bf16x2_t __attribute__((ext_vector_type(2)));
__device__ __forceinline__ unsigned cvtpk_s(float lo,float hi){f32x2_t v={lo,hi};bf16x2_t b=__builtin_convertvector(v,bf16x2_t);return __builtin_bit_cast(unsigned,b);}
#define WAIT_BAR(N) asm volatile("s_waitcnt vmcnt(" #N ") lgkmcnt(0)\n\ts_barrier":::"memory")

__device__ __forceinline__ void qkt(f32x16&p0,f32x16&p1,const char*Kslot,const bf16x8*qr,const f32x16&negm,int r32,int hi){
  const char*kb=Kslot+hi*1024+r32*16;
  #pragma unroll
  for(int d0=0;d0<4;++d0){
    const bf16x8 b0=*reinterpret_cast<const bf16x8*>(kb+d0*2048);
    const bf16x8 b1=*reinterpret_cast<const bf16x8*>(kb+d0*2048+512);
    if(d0==0){p0=__builtin_amdgcn_mfma_f32_32x32x16_bf16(b0,qr[0],negm,0,0,0);p1=__builtin_amdgcn_mfma_f32_32x32x16_bf16(b1,qr[0],negm,0,0,0);}
    else{p0=__builtin_amdgcn_mfma_f32_32x32x16_bf16(b0,qr[d0],p0,0,0,0);p1=__builtin_amdgcn_mfma_f32_32x32x16_bf16(b1,qr[d0],p1,0,0,0);}}
}
typedef __attribute__((address_space(3))) const char* lds_cptr;
typedef short v4i16_t __attribute__((ext_vector_type(4)));
__device__ __forceinline__ void kload8(bf16x8*kf,lds_cptr kp){
  kf[0]=*(const __attribute__((address_space(3))) bf16x8*)(kp);      kf[1]=*(const __attribute__((address_space(3))) bf16x8*)(kp+512);
  kf[2]=*(const __attribute__((address_space(3))) bf16x8*)(kp+2048); kf[3]=*(const __attribute__((address_space(3))) bf16x8*)(kp+2560);
  kf[4]=*(const __attribute__((address_space(3))) bf16x8*)(kp+4096); kf[5]=*(const __attribute__((address_space(3))) bf16x8*)(kp+4608);
  kf[6]=*(const __attribute__((address_space(3))) bf16x8*)(kp+6144); kf[7]=*(const __attribute__((address_space(3))) bf16x8*)(kp+6656);
}
__device__ __forceinline__ void kload2(bf16x8*kf,lds_cptr kp,int j){ kf[2*j]=*(const __attribute__((address_space(3))) bf16x8*)(kp+j*2048); kf[2*j+1]=*(const __attribute__((address_space(3))) bf16x8*)(kp+j*2048+512); }
__device__ __forceinline__ s16x4 vtr(lds_cptr p){ return __builtin_bit_cast(s16x4,__builtin_amdgcn_ds_read_tr16_b64_v4i16((__attribute__((address_space(3))) v4i16_t*)p)); }
__device__ __forceinline__ float rowmax(const f32x16&p0,const f32x16&p1){
  float a=max3f(p0[0],p0[1],p1[0]),b=max3f(p0[2],p0[3],p1[1]);a=max3f(a,p1[2],p1[3]);
  #pragma unroll
  for(int r=4;r<16;r+=4){a=max3f(a,p0[r],p0[r+1]);b=max3f(b,p0[r+2],p0[r+3]);a=max3f(a,p1[r],p1[r+1]);b=max3f(b,p1[r+2],p1[r+3]);}
  const float m=max2f(a,b);
  auto rr=__builtin_amdgcn_permlane32_swap(__float_as_uint(m),__float_as_uint(m),false,false);
  return max2f(__uint_as_float(rr[0]),__uint_as_float(rr[1]));
}
__device__ __forceinline__ void pv(f32x16*o,int vb,bf16x8 pa0,bf16x8 pa1,bf16x8 pa2,bf16x8 pa3){
  #pragma unroll
  for(int d0=0;d0<2;++d0){s16x4 lo[4],hi[4];
    #pragma unroll
    for(int ks=0;ks<4;++ks){
      asm volatile("ds_read_b64_tr_b16 %0,%1 offset:%c2":"=&v"(lo[ks]):"v"(vb),"i"(d0*4096+ks*1024):"memory");
      asm volatile("ds_read_b64_tr_b16 %0,%1 offset:%c2":"=&v"(hi[ks]):"v"(vb),"i"(d0*4096+ks*1024+512):"memory");}
    asm volatile("s_waitcnt lgkmcnt(0)":::"memory");SBAR();
    #define PK(k) (bf16x8){lo[k][0],lo[k][1],lo[k][2],lo[k][3],hi[k][0],hi[k][1],hi[k][2],hi[k][3]}
    o[d0]=__builtin_amdgcn_mfma_f32_32x32x16_bf16(pa0,PK(0),o[d0],0,0,0);
    o[d0]=__builtin_amdgcn_mfma_f32_32x32x16_bf16(pa1,PK(1),o[d0],0,0,0);
    o[d0]=__builtin_amdgcn_mfma_f32_32x32x16_bf16(pa2,PK(2),o[d0],0,0,0);
    o[d0]=__builtin_amdgcn_mfma_f32_32x32x16_bf16(pa3,PK(3),o[d0],0,0,0);
    #undef PK
  }
}

#ifndef ATTN_STORE16
#define ATTN_STORE16(p,v) (*(u32x4*)(p)=(v))
#endif
template<int THRL> __device__ __forceinline__ void attn_unit(const bf16*Qw0,const bf16*__restrict__ Kh,const bf16*__restrict__ Vh,bf16*Ow0,char*shm,const float negM,const int wid,const float*qg,const float*ctab,const float*stab,const int t0){
  const int lane=fresh_lane(),r32=lane&31,hi=lane>>5;
  const bf16*Qw=Qw0+(long)(wid*QBLK)*QP;
  const unsigned lds0=(unsigned)(uintptr_t)shm;
  float*wsf=(float*)(shm+LDS_WS)+wid*64;
  const bf16*ksrc=Kh+(long)lane*QP+wid*8;
  const bf16*vsrc=Vh+(long)(16*(wid&3)+(lane>>2))*QP+(wid>>2)*32+(lane&3)*8;
  const unsigned kdst=lds0+LDS_K+wid*1024, vdst=lds0+LDS_V+wid*1024;
  #define DMA_K(t,slot) glds16(ksrc+(long)(t)*KVBLK*QP,(unsigned)__builtin_amdgcn_readfirstlane(kdst+(slot)))
  #define DMA_V(t,slot) glds16(vsrc+(long)(t)*KVBLK*QP,(unsigned)__builtin_amdgcn_readfirstlane(vdst+(slot)))
  const int vb0=(int)(lds0+LDS_V)+((lane>>4)&1)*32+(lane&3)*8+(4*hi+((lane&15)>>2))*64;
  const char*Kbase=shm+LDS_K; bf16x8 kf[8];
  const lds_cptr shm3=(lds_cptr)shm; const lds_cptr kp0=shm3+LDS_K+hi*1024+r32*16; const lds_cptr vp0=shm3+LDS_V+((lane>>4)&1)*32+(lane&3)*8+(4*hi+((lane&15)>>2))*64;
  DMA_K(0,0);DMA_V(0,0);DMA_K(1,SLOTB);
  bf16x8 qr[4];
  #pragma unroll
  for(int d0=0;d0<4;++d0)qr[d0]=*reinterpret_cast<const bf16x8*>(&Qw[(long)r32*QP+d0*16+hi*8]);
  { float x[4][8]; float ss=0.f;
    #pragma unroll
    for(int d0=0;d0<4;++d0){
      #pragma unroll
      for(int j=0;j<8;++j){x[d0][j]=__uint_as_float(((unsigned)(unsigned short)qr[d0][j])<<16);ss+=x[d0][j]*x[d0][j];}}
    {auto rr=__builtin_amdgcn_permlane32_swap(__float_as_uint(ss),__float_as_uint(ss),false,false);ss=__uint_as_float(rr[0])+__uint_as_float(rr[1]);}
    const float rstd=__builtin_amdgcn_rsqf(ss*(1.0f/64.0f)+1e-6f);
    #pragma unroll
    for(int d0=0;d0<4;++d0){ const float*gp=qg+d0*16+hi*8;
      #pragma unroll
      for(int j=0;j<8;++j)x[d0][j]*=rstd*gp[j]; }
    const long trow=(long)(t0+wid*QBLK+r32)*32+hi*8;
    #pragma unroll
    for(int hf=0;hf<2;++hf){ const float*cp=ctab+trow+hf*16,*sp=stab+trow+hf*16;
      #pragma unroll
      for(int j=0;j<8;++j){ const float c=cp[j],sn=sp[j],a=x[2*hf][j],b=x[2*hf+1][j]; x[2*hf][j]=(a*c-b*sn)*C2; x[2*hf+1][j]=(b*c+a*sn)*C2; } }
    #pragma unroll
    for(int d0=0;d0<4;++d0){ u32x4 w; w.x=cvtpk_s(x[d0][0],x[d0][1]); w.y=cvtpk_s(x[d0][2],x[d0][3]); w.z=cvtpk_s(x[d0][4],x[d0][5]); w.w=cvtpk_s(x[d0][6],x[d0][7]); qr[d0]=__builtin_bit_cast(bf16x8,w); }
  }
  f32x16 o[2];o[0]=f32x16{};o[1]=f32x16{};float l_reg=0.f;const f32x16 negm=f32x16{};(void)negM;
  #define CMASK(P0,P1,t) do{ if((t)==NT-1)tmask(P0,P1); }while(0)
  #define START(P0,P1) do{ _Pragma("unroll") for(int r=0;r<16;++r)P0[r]=__builtin_amdgcn_exp2f(P0[r]); }while(0)
  #define RESC() do{}while(0)
  f32x16 pA0,pA1,pB0,pB1;
  int sl_prev=0,sl_cur=0,sl_next=SLOTB;
  #define ROT() do{sl_prev=sl_cur;sl_cur=sl_next;sl_next=(sl_next==(NSLOT-1)*SLOTB)?0:sl_next+SLOTB;}while(0)
  DMA_K(2,2*SLOTB);
  WAIT_BAR(3);
  qkt(pA0,pA1,Kbase,qr,negm,r32,hi);asm volatile("s_nop 15\n\ts_nop 7":"+v"(pA0),"+v"(pA1));CMASK(pA0,pA1,0);
  START(pA0,pA1);
  _Pragma("unroll") for(int r=0;r<16;++r)pA1[r]=__builtin_amdgcn_exp2f(pA1[r]);
  WAIT_BAR(0);
  DMA_K(3,0);DMA_V(1,SLOTB);
  ROT();
  kload8(kf,kp0+sl_cur);
  WAIT_BAR(2);
  s16x4 vlo[8],vhi[8]; u32x4 pw0,pw1,pw2,pw3;
  #define PKW(P,B) cvtpk_s(P[B],P[B+1])
  #define PAF(k) __builtin_bit_cast(bf16x8,pw##k)
  #define VFR(i) (bf16x8){vlo[i][0],vlo[i][1],vlo[i][2],vlo[i][3],vhi[i][0],vhi[i][1],vhi[i][2],vhi[i][3]}
  #define PIN(x) asm volatile("":"+v"(x))
  #define MX3(a,b,c) __builtin_fmaxf(__builtin_fmaxf((a),(b)),(c))
  #define GAPA(MF,A0,A1,A2,A3,W0,W1,PW) do{ MF; sacc+=A0; sacc+=A1; sacc+=A2; sacc+=A3; PIN(sacc); W0; W1; PIN(PW); SBAR(); }while(0)
  #define EX(v) __builtin_amdgcn_exp2f(v)
  #define GAPB(MF,X,B) do{ MF; X[B]=EX(X[B]); X[B+1]=EX(X[B+1]); X[B+2]=EX(X[B+2]); X[B+3]=EX(X[B+3]); PIN(X); SBAR(); }while(0)
  #define VRD(i) do{ vlo[i]=vtr(vp_+(((i)>>2)*4096+((i)&3)*1024)); vhi[i]=vtr(vp_+(((i)>>2)*4096+((i)&3)*1024+512)); }while(0)
  #define KRD(G,j) do{ if(G){ kload2(kf,kp0+sl_next,j); SBAR(); } }while(0)
  #define STEP(C0,C1,P0,P1,t,GK,GV,GL) do{ SBAR(); \
    const lds_cptr vp_=vp0+sl_prev; \
    VRD(0); SBAR(); float sacc=(P0[0]+P0[1]); \
    GAPA(C0=__builtin_amdgcn_mfma_f32_32x32x16_bf16(kf[0],qr[0],negm,0,0,0), P0[2],P0[3],P0[4],P0[5],     pw0[0]=PKW(P0,0), pw0[1]=PKW(P0,2), pw0); \
    VRD(4); SBAR(); GAPA(C1=__builtin_amdgcn_mfma_f32_32x32x16_bf16(kf[1],qr[0],negm,0,0,0), P0[6],P0[7],P0[8],P0[9],     pw0[2]=PKW(P0,4), pw0[3]=PKW(P0,6), pw0); \
    VRD(1); SBAR(); GAPA(C0=__builtin_amdgcn_mfma_f32_32x32x16_bf16(kf[2],qr[1],C0,0,0,0),   P0[10],P0[11],P0[12],P0[13], pw1[0]=PKW(P0,8), pw1[1]=PKW(P0,10), pw1); \
    VRD(5); SBAR(); GAPA(C1=__builtin_amdgcn_mfma_f32_32x32x16_bf16(kf[3],qr[1],C1,0,0,0),   P0[14],P0[15],P1[0],P1[1],   pw1[2]=PKW(P0,12),pw1[3]=PKW(P0,14), pw1); \
    VRD(2); SBAR(); GAPA(C0=__builtin_amdgcn_mfma_f32_32x32x16_bf16(kf[4],qr[2],C0,0,0,0),   P1[2],P1[3],P1[4],P1[5],     pw2[0]=PKW(P1,0), pw2[1]=PKW(P1,2), pw2); \
    VRD(6); SBAR(); GAPA(C1=__builtin_amdgcn_mfma_f32_32x32x16_bf16(kf[5],qr[2],C1,0,0,0),   P1[6],P1[7],P1[8],P1[9],     pw2[2]=PKW(P1,4), pw2[3]=PKW(P1,6), pw2); \
    VRD(3); SBAR(); GAPA(C0=__builtin_amdgcn_mfma_f32_32x32x16_bf16(kf[6],qr[3],C0,0,0,0),   P1[10],P1[11],P1[12],P1[13], pw3[0]=PKW(P1,8), pw3[1]=PKW(P1,10), pw3); \
    VRD(7); SBAR(); GAPA(C1=__builtin_amdgcn_mfma_f32_32x32x16_bf16(kf[7],qr[3],C1,0,0,0),   P1[14],P1[15],0.f,0.f,       pw3[2]=PKW(P1,12),pw3[3]=PKW(P1,14), pw3); \
    l_reg+=sacc; \
    if(GK){DMA_K((t)+3,sl_cur);} if(GV){DMA_V((t)+1,sl_next);} \
    CMASK(C0,C1,t); \
    SBAR(); \
    GAPB(o[0]=__builtin_amdgcn_mfma_f32_32x32x16_bf16(PAF(0),VFR(0),o[0],0,0,0), C0,0); \
    GAPB(o[1]=__builtin_amdgcn_mfma_f32_32x32x16_bf16(PAF(0),VFR(4),o[1],0,0,0), C0,4); \
    KRD(GL,0); GAPB(o[0]=__builtin_amdgcn_mfma_f32_32x32x16_bf16(PAF(1),VFR(1),o[0],0,0,0), C0,8); \
    KRD(GL,1); GAPB(o[1]=__builtin_amdgcn_mfma_f32_32x32x16_bf16(PAF(1),VFR(5),o[1],0,0,0), C0,12); \
    KRD(GL,2); GAPB(o[0]=__builtin_amdgcn_mfma_f32_32x32x16_bf16(PAF(2),VFR(2),o[0],0,0,0), C1,0); \
    KRD(GL,3); GAPB(o[1]=__builtin_amdgcn_mfma_f32_32x32x16_bf16(PAF(2),VFR(6),o[1],0,0,0), C1,4); \
    GAPB(o[0]=__builtin_amdgcn_mfma_f32_32x32x16_bf16(PAF(3),VFR(3),o[0],0,0,0), C1,8); \
    GAPB(o[1]=__builtin_amdgcn_mfma_f32_32x32x16_bf16(PAF(3),VFR(7),o[1],0,0,0), C1,12); \
    }while(0)
  int t=1;
  #define ENDW(tt) do{ if((tt)+3<NT){WAIT_BAR(2);} else if((tt)+2<NT){WAIT_BAR(1);} else {WAIT_BAR(0);} }while(0)
  #undef CMASK
  #define CMASK(P0,P1,t) do{}while(0)
  for(;t+4<NT;t+=2){
    STEP(pB0,pB1,pA0,pA1,t,true,true,true);     WAIT_BAR(2); RESC(); ROT();
    STEP(pA0,pA1,pB0,pB1,t+1,true,true,true);   WAIT_BAR(2); RESC(); ROT();
  }
  for(;t+2<NT;t+=2){
    STEP(pB0,pB1,pA0,pA1,t,(t+3<NT),(t+1<NT),(t+1<NT));       ENDW(t);   RESC(); ROT();
    STEP(pA0,pA1,pB0,pB1,t+1,(t+4<NT),(t+2<NT),(t+2<NT));     ENDW(t+1); RESC(); ROT();
  }
  STEP(pB0,pB1,pA0,pA1,NT-2,false,true,true); WAIT_BAR(0); RESC(); ROT();
  #undef CMASK
  #define CMASK(P0,P1,t) tmask(P0,P1)
  STEP(pA0,pA1,pB0,pB1,NT-1,false,false,false); RESC();
  { float sacc=pA0[0]+pA0[1]; _Pragma("unroll") for(int r=2;r<16;++r)sacc+=pA0[r]; _Pragma("unroll") for(int r=0;r<16;++r)sacc+=pA1[r]; l_reg+=sacc;
    pw0=(u32x4){PKW(pA0,0),PKW(pA0,2),PKW(pA0,4),PKW(pA0,6)};pw1=(u32x4){PKW(pA0,8),PKW(pA0,10),PKW(pA0,12),PKW(pA0,14)};pw2=(u32x4){PKW(pA1,0),PKW(pA1,2),PKW(pA1,4),PKW(pA1,6)};pw3=(u32x4){PKW(pA1,8),PKW(pA1,10),PKW(pA1,12),PKW(pA1,14)};
    SBAR(); pv(o,vb0+sl_cur,PAF(0),PAF(1),PAF(2),PAF(3)); }
  #undef PKW
  #undef PAF
  #undef VFR
  #undef PIN
  #undef MX3
  #undef GAPA
  #undef GAPB
  #undef EX
  #undef VRD
  #undef KRD
  #undef STEP
  #undef ENDW
  {auto rr=__builtin_amdgcn_permlane32_swap(__float_as_uint(l_reg),__float_as_uint(l_reg),false,false);l_reg=__uint_as_float(rr[0])+__uint_as_float(rr[1]);}
  if(hi==0)wsf[32+r32]=l_reg;asm volatile("s_waitcnt lgkmcnt(0)":::"memory");
  float rli[16];
  #pragma unroll
  for(int r=0;r<16;++r)rli[r]=__builtin_amdgcn_rcpf(wsf[32+crow(r,hi)]);
  bf16*Ow=Ow0+(long)(wid*QBLK)*OP;
  { bf16*stg=(bf16*)(shm+LDS_OST)+wid*2048;
    #pragma unroll
    for(int r=0;r<16;++r){const int orow=crow(r,hi);
      #pragma unroll
      for(int d0=0;d0<2;++d0)stg[orow*64+d0*32+r32]=__float2bfloat16(o[d0][r]*rli[r]);}
    asm volatile("s_waitcnt lgkmcnt(0)":::"memory");
    #pragma unroll
    for(int i=0;i<4;++i){const int row=i*8+(lane>>3),ch=lane&7; const u32x4 v=*(const u32x4*)(stg+row*64+ch*8); ATTN_STORE16(Ow+(long)row*OP+ch*8,v);} }
  asm volatile("s_waitcnt lgkmcnt(0)\n\ts_barrier":::"memory");
  #undef DMA_K
  #undef DMA_V
  #undef CMASK
  #undef START
  #undef RESC
  #undef ROT
}
constexpr int ATTN_LDS_BYTES=LDS_BYTES;
#undef SBAR
#undef WAIT_BAR
}

#ifndef MK_N_LAUNCHES
#define MK_N_LAUNCHES 1
#endif
constexpr int NWAVES = 8, NPHASE = 9;
constexpr int DM = 1024, NSEQ = 12, SEQ = 8192, NMETA = 16, LSEQ = SEQ + NMETA;
constexpr int TNAT = NSEQ * LSEQ, MP = 98560, MC = NSEQ * SEQ;
constexpr int INW = 1792, FFH = 2816, LRUW = 512;
constexpr int COL_K = 512, COL_V = 640, COL_LIN = 768, COL_LG = 1280;
constexpr int CT = 32, NCH = 257, NLU = NSEQ * NCH;
constexpr float QSCALE = 0.125f * 1.4426950408889634f;
constexpr size_t MiB = 1u << 20;
constexpr size_t WS_WIN = 2 * MiB, WS_WOUT = 6 * MiB, WS_WGU = 8 * MiB, WS_WDN = 20 * MiB, WS_WLRU = 26 * MiB, WS_NL = 26 * MiB + 512 * 1024;
constexpr size_t WS_COS = 27 * MiB, WS_SIN = 28 * MiB, WS_NEGM = 29 * MiB, WS_CNT = 30 * MiB;
constexpr size_t WS_AGG = 32 * MiB, WS_CARRY = 60 * MiB, WS_SSQ1 = 74 * MiB, WS_SSQ2 = 82 * MiB;
constexpr size_t WS_XN = 96 * MiB;
constexpr size_t WS_PROJ = 300 * MiB;
constexpr size_t WS_HID = 96 * MiB;
constexpr size_t WS_H1B = 656 * MiB;
constexpr size_t WS_SP = 656 * MiB;
constexpr size_t WS_END = 960 * MiB;
static_assert(WS_AGG + (size_t)NLU * 2048 * 4 <= WS_CARRY && WS_CARRY + (size_t)NLU * 1024 * 4 <= WS_SSQ1 && WS_SSQ1 + (size_t)MC * 64 <= WS_SSQ2 && WS_SSQ2 + (size_t)MC * 64 <= WS_XN, "ws map 1");
static_assert(WS_XN + (size_t)MP * 1024 * 2 <= WS_PROJ && WS_PROJ + (size_t)MP * INW * 2 <= WS_H1B && WS_HID + (size_t)MC * FFH * 2 <= WS_H1B && WS_H1B + (size_t)MC * 1024 * 2 <= WS_END && WS_SP + (size_t)(TNAT + 64) * 2048 <= WS_END, "ws map 2");
constexpr int LDS_BYTES = 147456;

#define GAS __attribute__((address_space(1)))
#define LAS __attribute__((address_space(3)))
typedef unsigned short bf16;
typedef unsigned v4u __attribute__((ext_vector_type(4)));
typedef unsigned v2u __attribute__((ext_vector_type(2)));
typedef float f32x4 __attribute__((ext_vector_type(4)));
typedef short bf16x8 __attribute__((ext_vector_type(8)));
using pg8::pkbf;
__device__ __forceinline__ float bflo(unsigned w) { return __uint_as_float(w << 16); }
__device__ __forceinline__ float bfhi(unsigned w) { return __uint_as_float(w & 0xffff0000u); }
__device__ __forceinline__ float wave_sum(float v) {
#pragma unroll
    for (int o = 1; o < 64; o <<= 1) v += __shfl_xor(v, o);
    return v;
}
template <int CTRL> __device__ __forceinline__ float dppf(float old, float v) { return __builtin_bit_cast(float, __builtin_amdgcn_update_dpp(__builtin_bit_cast(int, old), __builtin_bit_cast(int, v), CTRL, 0xf, 0xf, false)); }
__device__ __forceinline__ void scan_fwd16(float& A, float& B) {
#define SF(S) { const float Ap = dppf<0x110 + S>(1.f, A), Bp = dppf<0x110 + S>(0.f, B); B = fmaf(A, Bp, B); A = A * Ap; }
    SF(1) SF(2) SF(4) SF(8)
#undef SF
}
__device__ __forceinline__ void scan_bwd16(float& A, float& B) {
#define SB(S) { const float Ap = dppf<0x100 + S>(1.f, A), Bp = dppf<0x100 + S>(0.f, B); B = fmaf(A, Bp, B); A = A * Ap; }
    SB(1) SB(2) SB(4) SB(8)
#undef SB
}

#define LRU_DPP_STEP(DIR, S) \
    "v_fmac_f32_dpp %0, %0, %4 " DIR ":" #S " row_mask:0xf bank_mask:0xf\n\tv_fmac_f32_dpp %1, %1, %5 " DIR ":" #S " row_mask:0xf bank_mask:0xf\n\t" \
    "v_fmac_f32_dpp %2, %2, %6 " DIR ":" #S " row_mask:0xf bank_mask:0xf\n\tv_fmac_f32_dpp %3, %3, %7 " DIR ":" #S " row_mask:0xf bank_mask:0xf\n\t" \
    "v_mul_f32_dpp %4, %4, %4 " DIR ":" #S " row_mask:0xf bank_mask:0xf\n\tv_mul_f32_dpp %5, %5, %5 " DIR ":" #S " row_mask:0xf bank_mask:0xf\n\t" \
    "v_mul_f32_dpp %6, %6, %6 " DIR ":" #S " row_mask:0xf bank_mask:0xf\n\tv_mul_f32_dpp %7, %7, %7 " DIR ":" #S " row_mask:0xf bank_mask:0xf\n\t"
__device__ __forceinline__ void scan4_fwd16(float (&A)[4], float (&B)[4]) {
    asm volatile("s_nop 1\n\t" LRU_DPP_STEP("row_shr", 1) LRU_DPP_STEP("row_shr", 2) LRU_DPP_STEP("row_shr", 4) LRU_DPP_STEP("row_shr", 8)
                 : "+v"(B[0]), "+v"(B[1]), "+v"(B[2]), "+v"(B[3]), "+v"(A[0]), "+v"(A[1]), "+v"(A[2]), "+v"(A[3]));
}
__device__ __forceinline__ void scan4_bwd16(float (&A)[4], float (&B)[4]) {
    asm volatile("s_nop 1\n\t" LRU_DPP_STEP("row_shl", 1) LRU_DPP_STEP("row_shl", 2) LRU_DPP_STEP("row_shl", 4) LRU_DPP_STEP("row_shl", 8)
                 : "+v"(B[0]), "+v"(B[1]), "+v"(B[2]), "+v"(B[3]), "+v"(A[0]), "+v"(A[1]), "+v"(A[2]), "+v"(A[3]));
}

struct Args {
    const float *x_prompt, *x_sample, *meta, *norm_mix_g, *w_in, *q_norm_g, *k_norm_g, *conv_w, *conv_b, *lru_w_a, *lru_b_a, *lru_w_x, *lru_b_x, *lru_lam,
                *attn_out_g, *lru_out_g, *w_out, *norm_ffn_g, *w_gate_up, *w_down, *final_norm_g;
    float* out; unsigned char* ws; int ph_lo, ph_hi;
};

__device__ __forceinline__ void p0_transpose_item(const float* W, int K, int N, bf16* WT, int mode, const float* kscale, LAS float* scr, int item, int lane) {
    const int nblk = N / 32, kb = item / nblk, nb = item % nblk, k0 = 64 * kb, n0 = 32 * nb;
#pragma unroll 8
    for (int i = 0; i < 32; ++i) { const int kk = 2 * i + (lane >> 5); float v = W[(size_t)(k0 + kk) * N + n0 + (lane & 31)]; if (kscale) v *= kscale[k0 + kk]; scr[kk * 33 + (lane & 31)] = v; }
    asm volatile("s_waitcnt lgkmcnt(0)" ::: "memory");
    int rbase = n0;
    if (mode == 1) { if (n0 < FFH) rbase = (n0 / 128) * 256 + (n0 % 128); else { const int j = n0 - FFH; rbase = (j / 128) * 256 + 128 + (j % 128); } }
    const int c = lane & 7;
#pragma unroll
    for (int j = 0; j < 4; ++j) { const int n = (lane >> 3) + 8 * j; const LAS float* s = scr + (8 * c) * 33 + n;
        v4u o; o.x = pkbf(s[0 * 33], s[1 * 33]); o.y = pkbf(s[2 * 33], s[3 * 33]); o.z = pkbf(s[4 * 33], s[5 * 33]); o.w = pkbf(s[6 * 33], s[7 * 33]);
        *(GAS v4u*)(WT + (size_t)(rbase + n) * K + k0 + 8 * c) = o; }
    asm volatile("s_waitcnt lgkmcnt(0)" ::: "memory");
}

__device__ __forceinline__ void phase0(const Args& a, LAS unsigned char* lds, int vcu, int G, int wave, int lane, int tid) {
    unsigned char* ws = a.ws;
    LAS float* scr = (LAS float*)(lds + wave * 16384);
    const int gw = vcu * NWAVES + wave, NGW = G * NWAVES;
    constexpr int I_IN = (DM / 64) * (INW / 32), I_OUT = (DM / 64) * (DM / 32), I_GU = (DM / 64) * (2 * FFH / 32), I_DN = (FFH / 64) * (DM / 32);
    constexpr int NITEMS = I_IN + I_OUT + I_GU + I_DN;
    for (int it = gw; it < NITEMS; it += NGW) {
        int r = it;
        if (r < I_IN) { p0_transpose_item(a.w_in, DM, INW, (bf16*)(ws + WS_WIN), 0, nullptr, scr, r, lane); continue; } r -= I_IN;
        if (r < I_OUT) { p0_transpose_item(a.w_out, DM, DM, (bf16*)(ws + WS_WOUT), 0, nullptr, scr, r, lane); continue; } r -= I_OUT;
        if (r < I_GU) { p0_transpose_item(a.w_gate_up, DM, 2 * FFH, (bf16*)(ws + WS_WGU), 1, a.norm_ffn_g, scr, r, lane); continue; } r -= I_GU;
        p0_transpose_item(a.w_down, FFH, DM, (bf16*)(ws + WS_WDN), 0, nullptr, scr, r, lane);
    }
    const int gt = vcu * (NWAVES * 64) + tid, NGT = G * NWAVES * 64;
    { bf16* Wl = (bf16*)(ws + WS_WLRU);
      for (int e = gt; e < 8 * 256 * 64; e += NGT) { const int h = e >> 14, o = (e >> 6) & 255, i = e & 63, g4 = o >> 6, j = o & 63, d = g4 >> 1;
          const float* src = (g4 & 1) ? a.lru_w_x : a.lru_w_a; Wl[e] = (bf16)(pkbf(src[((size_t)(d * 8 + h) * 64 + i) * 64 + j], 0.f) & 0xffffu); } }
    if (gt == 0) { float mq = 0.f, mk = 0.f; for (int e = 0; e < 64; ++e) { mq = fmaxf(mq, fabsf(a.q_norm_g[e])); mk = fmaxf(mk, fabsf(a.k_norm_g[e])); }
        *(float*)(ws + WS_NEGM) = -(8.0f * 1.4426950408889634f * mq * mk * 1.02f + 0.5f); }
    { unsigned* xs = (unsigned*)(ws + WS_SSQ2); for (int e = gt; e < MC * 4; e += NGT) xs[e] = 0xFFFFFFFFu; }
    { float* nl = (float*)(ws + WS_NL); for (int e = gt; e < 2 * LRUW; e += NGT) nl[e] = -8.0f * log1pf(expf(-a.lru_lam[e])); }
    { float* ct = (float*)(ws + WS_COS); float* st = (float*)(ws + WS_SIN);
      for (int e = gt; e < SEQ * 32; e += NGT) { const int t = e >> 5, k = e & 31, pos = (k < 16) ? (t >> 6) : (t & 63), i = k & 15;
          const float freq = __builtin_amdgcn_exp2f(-(float)i * (13.287712379549449f / 16.0f));
          const float rev = (float)pos * freq * 0.15915494309189535f; const float fr = rev - rintf(rev);
          ct[e] = __builtin_amdgcn_cosf(fr); st[e] = __builtin_amdgcn_sinf(fr); } }
    { bf16* XN = (bf16*)(ws + WS_XN);
      f32x4 g4[4];
#pragma unroll
      for (int j = 0; j < 4; ++j) g4[j] = *((const f32x4*)a.norm_mix_g + lane + 64 * j);
      for (int r = gw; r < MP; r += NGW) {
          GAS unsigned long long* o8 = (GAS unsigned long long*)(XN + (size_t)r * DM) + lane;
          if (r >= TNAT) {
#pragma unroll
              for (int j = 0; j < 4; ++j) o8[64 * j] = 0ull;
              continue; }
          const int b = r / LSEQ, p = r - b * LSEQ;
          const float* src = (p < NMETA) ? a.meta + (size_t)p * DM : (b < 8 ? a.x_prompt + ((size_t)b * SEQ + (p - NMETA)) * DM : a.x_sample + ((size_t)(b - 8) * SEQ + (p - NMETA)) * DM);
          const f32x4* xr = (const f32x4*)src + lane; f32x4 v[4]; float s = 0.f;
#pragma unroll
          for (int j = 0; j < 4; ++j) { v[j] = xr[64 * j]; s += (v[j][0] * v[j][0] + v[j][1] * v[j][1]) + (v[j][2] * v[j][2] + v[j][3] * v[j][3]); }
          const float rstd = __builtin_amdgcn_rsqf(wave_sum(s) * (1.0f / DM) + 1e-6f);
#pragma unroll
          for (int j = 0; j < 4; ++j) { const f32x4 y = v[j] * rstd * g4[j]; o8[64 * j] = (unsigned long long)pkbf(y[0], y[1]) | ((unsigned long long)pkbf(y[2], y[3]) << 32); }
      } }
}

__device__ __forceinline__ void phase_qk(const Args& a, int vcu, int G, int wave, int lane) {
    bf16* proj = (bf16*)(a.ws + WS_PROJ); const float* ct = (const float*)(a.ws + WS_COS); const float* st = (const float*)(a.ws + WS_SIN);
    const int gw = vcu * NWAVES + wave, NGW = G * NWAVES; const int sub = lane >> 3, j = lane & 7;
    constexpr int NGRP = TNAT * 2 / 8;
    for (int grp = gw; grp < NGRP; grp += NGW) {
        const int item = grp * 8 + sub, row = item >> 1, hh = 8 + (item & 1);
        bf16* ptr = proj + (size_t)row * INW + hh * 64 + j * 8;
        const v4u raw = *(const v4u*)ptr;
        float x[8] = {bflo(raw.x), bfhi(raw.x), bflo(raw.y), bfhi(raw.y), bflo(raw.z), bfhi(raw.z), bflo(raw.w), bfhi(raw.w)};
        float ss = 0.f;
#pragma unroll
        for (int e = 0; e < 8; ++e) ss += x[e] * x[e];
        ss += __shfl_xor(ss, 1); ss += __shfl_xor(ss, 2); ss += __shfl_xor(ss, 4);
        const float rstd = __builtin_amdgcn_rsqf(ss * (1.0f / 64.0f) + 1e-6f);
        const float* gp = (hh < 8 ? a.q_norm_g : a.k_norm_g) + j * 8;
        const f32x4 g0 = *(const f32x4*)gp, g1 = *(const f32x4*)(gp + 4);
        float y[8];
#pragma unroll
        for (int e = 0; e < 8; ++e) y[e] = x[e] * rstd * (e < 4 ? g0[e] : g1[e - 4]);
        const int b = row / LSEQ, p = row - b * LSEQ;
        float c[8], s[8];
        if (p >= NMETA) { const int toff = (p - NMETA) * 32 + (j >> 2) * 16 + (j & 1) * 8;
            const f32x4 c0 = *(const f32x4*)(ct + toff), c1 = *(const f32x4*)(ct + toff + 4), s0 = *(const f32x4*)(st + toff), s1 = *(const f32x4*)(st + toff + 4);
#pragma unroll
            for (int e = 0; e < 4; ++e) { c[e] = c0[e]; c[e + 4] = c1[e]; s[e] = s0[e]; s[e + 4] = s1[e]; }
        } else {
#pragma unroll
            for (int e = 0; e < 8; ++e) { c[e] = 1.f; s[e] = 0.f; } }
        const float sgn = (j & 2) ? 1.f : -1.f, sc = (hh < 8) ? QSCALE : 1.f;
        float o[8];
#pragma unroll
        for (int e = 0; e < 8; ++e) { const float py = __shfl_xor(y[e], 2); o[e] = (y[e] * c[e] + sgn * py * s[e]) * sc; }
        v4u w; w.x = pkbf(o[0], o[1]); w.y = pkbf(o[2], o[3]); w.z = pkbf(o[4], o[5]); w.w = pkbf(o[6], o[7]);
        *(v4u*)ptr = w;
    }
}

constexpr int CB_ROW = 144, CB_WAVE = CT * CB_ROW, LRU_CB = 0, LRU_CONST = NWAVES * CB_WAVE, LRU_SLAB = LRU_CONST + 11 * 512 * 4, SLAB_WAVE = 40 * 128, LRU_Y = 0, Y_ROW = 2064, LRU_PART = 0;
static_assert(LRU_SLAB + NWAVES * SLAB_WAVE <= LDS_BYTES, "lru lds");
static_assert(LSEQ == (NCH - 1) * CT + 16, "the last chunk of a sequence holds exactly one 16-token tile");
#define LRU_LOADW(dst, cgi_) do { _Pragma("unroll") for (int g4 = 0; g4 < 4; ++g4) _Pragma("unroll") for (int ks = 0; ks < 2; ++ks) \
    dst[g4][ks] = *(const bf16x8*)(Wl + (size_t)(g4 * 64 + (cgi_) * 16 + fr) * 64 + ks * 32 + 8 * fq); } while (0)
template <bool FINAL> __device__ __forceinline__ void lru_phase(const Args& a, LAS unsigned char* lds, int bx, int G, int wave, int lane, int tid) {
    const bf16* proj = (const bf16*)(a.ws + WS_PROJ);
    const int fr = lane & 15, fq = lane >> 4;
    constexpr float L2E = 1.4426950408889634f;
    { LAS float* cst = (LAS float*)(lds + LRU_CONST); const float* nl = (const float*)(a.ws + WS_NL); const int e = tid;
      cst[0 * 512 + e] = -a.lru_b_a[e] * L2E; cst[1 * 512 + e] = -a.lru_b_x[e] * L2E; cst[2 * 512 + e] = -a.lru_b_a[LRUW + e] * L2E; cst[3 * 512 + e] = -a.lru_b_x[LRUW + e] * L2E;
      cst[4 * 512 + e] = nl[e] * L2E; cst[5 * 512 + e] = nl[LRUW + e] * L2E;
      cst[6 * 512 + e] = a.conv_w[e]; cst[7 * 512 + e] = a.conv_w[LRUW + e]; cst[8 * 512 + e] = a.conv_w[2 * LRUW + e]; cst[9 * 512 + e] = a.conv_w[3 * LRUW + e]; cst[10 * 512 + e] = a.conv_b[e]; }
    __syncthreads();
    LAS unsigned char* cb = lds + LRU_CB + wave * CB_WAVE;
    const bf16* Wl = (const bf16*)(a.ws + WS_WLRU) + (size_t)wave * 256 * 64;
#define LRU_DMA_SLAB(b_, p0_) do { _Pragma("unroll") for (int k_ = 0; k_ < 5; ++k_) { int pp_ = (p0_) - 2 + 8 * k_ + (lane >> 3); pp_ = pp_ < 0 ? 0 : (pp_ >= LSEQ ? LSEQ - 1 : pp_); \
        __builtin_amdgcn_global_load_lds((const unsigned*)(proj + ((size_t)(b_) * LSEQ + pp_) * INW + COL_LIN + 64 * wave + (lane & 7) * 8), (LAS unsigned*)(lds + LRU_SLAB + wave * SLAB_WAVE + k_ * 1024), 16, 0, 0); } } while (0)
    if (bx < NLU) { const int b0_ = bx / NCH, p00_ = (bx - b0_ * NCH) * CT; LRU_DMA_SLAB(b0_, p00_); }
    bf16x8 wall[4][4][2];
#pragma unroll
    for (int c4 = 0; c4 < 4; ++c4) LRU_LOADW(wall[c4], c4);
    for (int unit = bx; unit < NLU; unit += G) {
        const int b = unit / NCH, ci = unit - b * NCH, p0 = ci * CT; const size_t rowbase = (size_t)b * LSEQ;
        const bool lastc = (ci == NCH - 1);
        { const int j8 = lane & 7, tg = lane >> 3, ch = 64 * wave + 8 * j8;
          if (unit == bx) asm volatile("s_waitcnt vmcnt(0)" ::: "memory"); else asm volatile("s_waitcnt vmcnt(8)" ::: "memory");
          v4u raw[7];
#pragma unroll
          for (int k = 0; k < 7; ++k) { const int pp = p0 + tg * 4 + k - 2;
              const v4u r = *(const LAS v4u*)(lds + LRU_SLAB + wave * SLAB_WAVE + (tg * 4 + k) * 128 + j8 * 16); const bool ok = (pp >= 0 && pp < LSEQ);
              raw[k].x = ok ? r.x : 0u; raw[k].y = ok ? r.y : 0u; raw[k].z = ok ? r.z : 0u; raw[k].w = ok ? r.w : 0u; }
          asm volatile("s_waitcnt lgkmcnt(0)" ::: "memory");
          { const int nu = unit + G;
            if (nu < NLU) { const int nb = nu / NCH, np0 = (nu - nb * NCH) * CT; LRU_DMA_SLAB(nb, np0); } }
          const LAS float* cc = (const LAS float*)(lds + LRU_CONST) + 6 * 512 + ch;
          float acc[4][8];
          { const f32x4 b0 = *(const LAS f32x4*)(cc + 4 * 512), b1 = *(const LAS f32x4*)(cc + 4 * 512 + 4);
#pragma unroll
            for (int o = 0; o < 4; ++o)
#pragma unroll
                for (int e = 0; e < 4; ++e) { acc[o][e] = b0[e]; acc[o][e + 4] = b1[e]; } }
#pragma unroll
          for (int jj = 0; jj < 4; ++jj) { const f32x4 w0 = *(const LAS f32x4*)(cc + jj * 512), w1 = *(const LAS f32x4*)(cc + jj * 512 + 4);
#pragma unroll
              for (int o = 0; o < 4; ++o) { const v4u r = raw[o + jj];
                  acc[o][0] += w0[0] * bflo(r.x); acc[o][1] += w0[1] * bfhi(r.x); acc[o][2] += w0[2] * bflo(r.y); acc[o][3] += w0[3] * bfhi(r.y);
                  acc[o][4] += w1[0] * bflo(r.z); acc[o][5] += w1[1] * bfhi(r.z); acc[o][6] += w1[2] * bflo(r.w); acc[o][7] += w1[3] * bfhi(r.w); } }
#pragma unroll
          for (int o = 0; o < 4; ++o) { v4u w; w.x = pkbf(acc[o][0], acc[o][1]); w.y = pkbf(acc[o][2], acc[o][3]); w.z = pkbf(acc[o][4], acc[o][5]); w.w = pkbf(acc[o][6], acc[o][7]);
              *(LAS v4u*)(cb + (tg * 4 + o) * CB_ROW + j8 * 16) = w; }
        }
        asm volatile("s_waitcnt lgkmcnt(0)" ::: "memory");
        float ssq[2] = {0.f, 0.f};
#pragma unroll
        for (int cgi = 0; cgi < 4; ++cgi) {
            const int chl = cgi * 16 + 4 * fq, ch = 64 * wave + chl;
            f32x4 cf, cbk; v2u graw[2];
            if constexpr (FINAL) { const float* carry = (const float*)(a.ws + WS_CARRY) + (size_t)unit * 1024; cf = *(const f32x4*)(carry + ch); cbk = *(const f32x4*)(carry + LRUW + ch);
#pragma unroll
                for (int tt = 0; tt < 2; ++tt) { const int p = p0 + tt * 16 + fr; graw[tt] = (p < LSEQ) ? *(const v2u*)(proj + (rowbase + p) * INW + COL_LG + ch) : (v2u){0u, 0u}; } }
            const LAS float* cst = (const LAS float*)(lds + LRU_CONST) + ch;
            const f32x4 baf = *(const LAS f32x4*)(cst), bxf = *(const LAS f32x4*)(cst + 512), bab = *(const LAS f32x4*)(cst + 1024), bxb = *(const LAS f32x4*)(cst + 1536), nlf = *(const LAS f32x4*)(cst + 2048), nlb = *(const LAS f32x4*)(cst + 2560);
            float AF[2][4], UF[2][4], AB[2][4], UB[2][4];
#pragma unroll
            for (int tt = 0; tt < 2; ++tt) {
                if (tt == 1 && lastc) {
#pragma unroll
                    for (int i = 0; i < 4; ++i) { AF[1][i] = 1.f; UF[1][i] = 0.f; AB[1][i] = 1.f; UB[1][i] = 0.f; }
                } else {
                const LAS unsigned char* crow = cb + (tt * 16 + fr) * CB_ROW;
                const bf16x8 b0 = *(const LAS bf16x8*)(crow + fq * 16), b1 = *(const LAS bf16x8*)(crow + 64 + fq * 16);
                f32x4 pre[4];
#pragma unroll
                for (int g4 = 0; g4 < 4; ++g4) { pre[g4] = __builtin_amdgcn_mfma_f32_16x16x32_bf16(wall[cgi][g4][0], b0, (f32x4){0.f, 0.f, 0.f, 0.f}, 0, 0, 0);
                    pre[g4] = __builtin_amdgcn_mfma_f32_16x16x32_bf16(wall[cgi][g4][1], b1, pre[g4], 0, 0, 0); }
                const v2u craw = *(const LAS v2u*)(crow + chl * 2);
                const float cv[4] = {bflo(craw.x), bfhi(craw.x), bflo(craw.y), bfhi(craw.y)};
#pragma unroll
                for (int i = 0; i < 4; ++i) {
                    const float rf = __builtin_amdgcn_rcpf(1.0f + __builtin_amdgcn_exp2f(fmaf(pre[0][i], -L2E, baf[i])));
                    const float xf = __builtin_amdgcn_rcpf(1.0f + __builtin_amdgcn_exp2f(fmaf(pre[1][i], -L2E, bxf[i])));
                    const float rb = __builtin_amdgcn_rcpf(1.0f + __builtin_amdgcn_exp2f(fmaf(pre[2][i], -L2E, bab[i])));
                    const float xb = __builtin_amdgcn_rcpf(1.0f + __builtin_amdgcn_exp2f(fmaf(pre[3][i], -L2E, bxb[i])));
                    const float af = __builtin_amdgcn_exp2f(nlf[i] * rf), ab = __builtin_amdgcn_exp2f(nlb[i] * rb);
                    AF[tt][i] = af; AB[tt][i] = ab;
                    UF[tt][i] = __builtin_amdgcn_sqrtf(fmaf(-af, af, 1.0f)) * (xf * cv[i]); UB[tt][i] = __builtin_amdgcn_sqrtf(fmaf(-ab, ab, 1.0f)) * (xb * cv[i]);
                }
                }
                scan4_fwd16(AF[tt], UF[tt]); scan4_bwd16(AB[tt], UB[tt]);
            }
            if constexpr (!FINAL) {
                float S[2][4], PF[2][4], PB[2][4];
#pragma unroll
                for (int i = 0; i < 4; ++i) {
                    const float A0t = __shfl(AF[0][i], 15, 16), B0t = __shfl(UF[0][i], 15, 16), A1t = __shfl(AB[1][i], 0, 16), B1t = __shfl(UB[1][i], 0, 16);
                    PF[0][i] = AF[0][i]; PF[1][i] = AF[1][i] * A0t; const float hf0 = UF[0][i], hf1 = fmaf(AF[1][i], B0t, UF[1][i]);
                    PB[1][i] = AB[1][i]; PB[0][i] = AB[0][i] * A1t; const float hb1 = UB[1][i], hb0 = fmaf(AB[0][i], B1t, UB[0][i]);
                    S[0][i] = hf0 + hb0; S[1][i] = hf1 + hb1;
                    AF[1][i] = hf1; AB[0][i] = hb0; }
                float* agg = (float*)(a.ws + WS_AGG) + (size_t)unit * 2048;
                { const bool isf = (fr == 15);
                  if (isf || fr == 0) { float* dst = agg + (isf ? 0 : LRUW) + ch;
                      *(f32x4*)dst = isf ? (f32x4){PF[1][0], PF[1][1], PF[1][2], PF[1][3]} : (f32x4){PB[0][0], PB[0][1], PB[0][2], PB[0][3]};
                      *(f32x4*)(dst + 1024) = isf ? (f32x4){AF[1][0], AF[1][1], AF[1][2], AF[1][3]} : (f32x4){AB[0][0], AB[0][1], AB[0][2], AB[0][3]}; } }
#pragma unroll
                for (int tt = 0; tt < 2; ++tt) { const int p = p0 + tt * 16 + fr;
                    unsigned* sp = (unsigned*)(a.ws + WS_SP) + ((p < LSEQ) ? (rowbase + p) : (size_t)(TNAT + (p - LSEQ))) * 512 + ch;
                    v4u w;
#pragma unroll
                    for (int i = 0; i < 4; ++i) { const unsigned sb = pkbf(0.f, S[tt][i]) & 0xffff0000u;
                        const unsigned pf = (unsigned)__builtin_rintf(PF[tt][i] * 255.0f), pb = (unsigned)__builtin_rintf(PB[tt][i] * 255.0f); w[i] = sb | (pf << 8) | pb; }
                    *(v4u*)sp = w; }
            } else {
                float hs[2][4];
#pragma unroll
                for (int i = 0; i < 4; ++i) {
                    const float hf0 = fmaf(AF[0][i], cf[i], UF[0][i]); const float c1 = __shfl(hf0, 15, 16); const float hf1 = fmaf(AF[1][i], c1, UF[1][i]);
                    const float hb1 = fmaf(AB[1][i], cbk[i], UB[1][i]); const float c0 = __shfl(hb1, 0, 16); const float hb0 = fmaf(AB[0][i], c0, UB[0][i]);
                    hs[0][i] = hf0 + hb0; hs[1][i] = hf1 + hb1; }
#pragma unroll
                for (int tt = 0; tt < 2; ++tt) { const int tok = tt * 16 + fr; f32x4 y;
                    const float gv[4] = {bflo(graw[tt].x), bfhi(graw[tt].x), bflo(graw[tt].y), bfhi(graw[tt].y)};
#pragma unroll
                    for (int i = 0; i < 4; ++i) { const float g = gv[i], z = (-1.5957691216057308f * L2E) * fmaf(0.044715f * g * g, g, g);
                        y[i] = hs[tt][i] * g * __builtin_amdgcn_rcpf(1.0f + __builtin_amdgcn_exp2f(z)); }
                    ssq[tt] += (y[0] * y[0] + y[1] * y[1]) + (y[2] * y[2] + y[3] * y[3]);
                    *(LAS f32x4*)(lds + LRU_Y + tok * Y_ROW + ch * 4) = y; }
            }
        }
        if constexpr (FINAL) {
#pragma unroll
            for (int tt = 0; tt < 2; ++tt) { float s = ssq[tt]; s += __shfl_xor(s, 16); s += __shfl_xor(s, 32); if (fq == 0) *(LAS float*)(lds + LRU_PART + ((tt * 16 + fr) * 8 + wave) * 4) = s; }
            __syncthreads();
            { const int tok = tid >> 4, seg = tid & 15, p = p0 + tok;
              if (p >= NMETA && p < LSEQ) {
                  const LAS f32x4* pp = (const LAS f32x4*)(lds + LRU_PART + tok * 32); const f32x4 s0 = pp[0], s1 = pp[1];
                  const float tot = ((s0[0] + s0[1]) + (s0[2] + s0[3])) + ((s1[0] + s1[1]) + (s1[2] + s1[3]));
                  const float rstd = __builtin_amdgcn_rsqf(tot * (1.0f / LRUW) + 1e-6f);
                  bf16* orow = (bf16*)(a.ws + WS_XN) + ((size_t)b * SEQ + (p - NMETA)) * DM + LRUW;
#pragma unroll
                  for (int k = 0; k < 4; ++k) { const int ch = k * 128 + seg * 8;
                      const LAS f32x4* yp = (const LAS f32x4*)(lds + LRU_Y + tok * Y_ROW + ch * 4); const f32x4 y0 = yp[0], y1 = yp[1];
                      const f32x4 g0 = *(const f32x4*)(a.lru_out_g + ch), g1 = *(const f32x4*)(a.lru_out_g + ch + 4);
                      v4u w; w.x = pkbf(y0[0] * rstd * g0[0], y0[1] * rstd * g0[1]); w.y = pkbf(y0[2] * rstd * g0[2], y0[3] * rstd * g0[3]);
                      w.z = pkbf(y1[0] * rstd * g1[0], y1[1] * rstd * g1[1]); w.w = pkbf(y1[2] * rstd * g1[2], y1[3] * rstd * g1[3]);
                      *(v4u*)(orow + ch) = w; } } }
            __syncthreads();
        }
    }
    __syncthreads();
}

__device__ __forceinline__ void mix_norm_phase(const Args& a, int vcu, int G, int wave, int lane) {
    const bf16* proj = (const bf16*)(a.ws + WS_PROJ); const unsigned* SP = (const unsigned*)(a.ws + WS_SP); const float* carry = (const float*)(a.ws + WS_CARRY); bf16* mix = (bf16*)(a.ws + WS_XN);
    const int gw = vcu * NWAVES + wave, NGW = G * NWAVES, ch = lane * 8; constexpr float L2E = 1.4426950408889634f;
    const f32x4 ga0 = *(const f32x4*)(a.attn_out_g + ch), ga1 = *(const f32x4*)(a.attn_out_g + ch + 4), gl0 = *(const f32x4*)(a.lru_out_g + ch), gl1 = *(const f32x4*)(a.lru_out_g + ch + 4);
    for (int r = gw; r < MC; r += NGW) {
        const int b = r >> 13, p = (r & 8191) + NMETA; const size_t nat = (size_t)b * LSEQ + p; const int unit = b * NCH + (p >> 5);
        bf16* mrow = mix + (size_t)r * DM;
        const v4u ao = *(const v4u*)(mrow + ch);
        const v4u sp0 = *(const v4u*)(SP + nat * 512 + ch), sp1 = *(const v4u*)(SP + nat * 512 + ch + 4), gr = *(const v4u*)(proj + nat * INW + COL_LG + ch);
        const float* cp = carry + (size_t)unit * 1024 + ch;
        const f32x4 cf0 = *(const f32x4*)cp, cf1 = *(const f32x4*)(cp + 4), cb0 = *(const f32x4*)(cp + 512), cb1 = *(const f32x4*)(cp + 516);
        { float x[8] = {bflo(ao.x), bfhi(ao.x), bflo(ao.y), bfhi(ao.y), bflo(ao.z), bfhi(ao.z), bflo(ao.w), bfhi(ao.w)}; float s = 0.f;
#pragma unroll
          for (int e = 0; e < 8; ++e) s += x[e] * x[e];
          const float rstd = __builtin_amdgcn_rsqf(wave_sum(s) * (1.0f / 512.0f) + 1e-6f);
          v4u w; w.x = pkbf(x[0] * rstd * ga0[0], x[1] * rstd * ga0[1]); w.y = pkbf(x[2] * rstd * ga0[2], x[3] * rstd * ga0[3]);
          w.z = pkbf(x[4] * rstd * ga1[0], x[5] * rstd * ga1[1]); w.w = pkbf(x[6] * rstd * ga1[2], x[7] * rstd * ga1[3]);
          *(v4u*)(mrow + ch) = w; }
        { const unsigned spw[8] = {sp0.x, sp0.y, sp0.z, sp0.w, sp1.x, sp1.y, sp1.z, sp1.w};
          float S[8], PF[8], PB[8];
#pragma unroll
          for (int e = 0; e < 8; ++e) { S[e] = __uint_as_float(spw[e] & 0xffff0000u); PF[e] = (float)((spw[e] >> 8) & 255u) * (1.0f / 255.0f); PB[e] = (float)(spw[e] & 255u) * (1.0f / 255.0f); }
          const float gv[8] = {bflo(gr.x), bfhi(gr.x), bflo(gr.y), bfhi(gr.y), bflo(gr.z), bfhi(gr.z), bflo(gr.w), bfhi(gr.w)};
          float y[8]; float s = 0.f;
#pragma unroll
          for (int e = 0; e < 8; ++e) { const float cf = e < 4 ? cf0[e & 3] : cf1[e & 3], cbk = e < 4 ? cb0[e & 3] : cb1[e & 3];
              const float h = fmaf(PF[e], cf, fmaf(PB[e], cbk, S[e])); const float g = gv[e], z = (-1.5957691216057308f * L2E) * fmaf(0.044715f * g * g, g, g);
              y[e] = h * g * __builtin_amdgcn_rcpf(1.0f + __builtin_amdgcn_exp2f(z)); s += y[e] * y[e]; }
          const float rstd = __builtin_amdgcn_rsqf(wave_sum(s) * (1.0f / 512.0f) + 1e-6f);
          v4u w; w.x = pkbf(y[0] * rstd * gl0[0], y[1] * rstd * gl0[1]); w.y = pkbf(y[2] * rstd * gl0[2], y[3] * rstd * gl0[3]);
          w.z = pkbf(y[4] * rstd * gl1[0], y[5] * rstd * gl1[1]); w.w = pkbf(y[6] * rstd * gl1[2], y[7] * rstd * gl1[3]);
          *(v4u*)(mrow + LRUW + ch) = w; }
    }
}

__device__ __forceinline__ void lru_carry(const Args& a, LAS unsigned char* lds, int g, int tid) {
    const float* __restrict__ agg = (const float*)(a.ws + WS_AGG); float* __restrict__ carry = (float*)(a.ws + WS_CARRY);
    const int b = g >> 4, dc0 = (g & 15) * 64, dir = dc0 >> 9;
    const int lane = tid & 63, wv = __builtin_amdgcn_readfirstlane(tid >> 6);
    LAS float* sm = (LAS float*)lds;
    { const int sub = lane >> 4, j = lane & 15;
      for (int k = wv; k < (NCH + 1) / 2; k += NWAVES) { int ci = 2 * k + (sub >> 1); ci = ci < NCH ? ci : NCH - 1;
          __builtin_amdgcn_global_load_lds((const unsigned*)(agg + (size_t)(b * NCH + ci) * 2048 + (sub & 1) * 1024 + dc0 + j * 4), (LAS unsigned*)(lds + k * 1024), 16, 0, 0); } }
    asm volatile("s_waitcnt vmcnt(0)" ::: "memory");
    __syncthreads();
    LAS float* seg = (LAS float*)(lds + 258 * 512);
    const int q0 = 33 * wv, q1 = (q0 + 33 < NCH) ? q0 + 33 : NCH;
    { float As = 1.f, Bs = 0.f;
      for (int q = q0; q < q1; ++q) { const int ci = dir ? (NCH - 1 - q) : q; const float A = sm[ci * 128 + lane], B = sm[ci * 128 + 64 + lane]; Bs = fmaf(A, Bs, B); As *= A; }
      seg[wv * 128 + lane] = As; seg[wv * 128 + 64 + lane] = Bs; }
    __syncthreads();
    { float h = 0.f;
      for (int v = 0; v < wv; ++v) h = fmaf(seg[v * 128 + lane], h, seg[v * 128 + 64 + lane]);
      float* cp = carry + (size_t)b * NCH * 1024 + dc0 + lane;
      for (int q = q0; q < q1; ++q) { const int ci = dir ? (NCH - 1 - q) : q; const float A = sm[ci * 128 + lane], B = sm[ci * 128 + 64 + lane]; cp[(size_t)ci * 1024] = h; h = fmaf(A, h, B); } }
    __syncthreads();
}

#define XB_TMO      128
#define XB_XCNT(j)  (256  + 64 * (j))
#define XB_XSUB(j)  (1280 + 64 * (j))
#define XB_XGEN(j)  (2304 + 64 * (j))
#define XB_TOP      3328
#define XB_TOPGEN   3392
#define XCD_BAR_WORDS 3456
#define XB_SPIN_CAP (1u << 18)

__device__ __forceinline__ unsigned xb_ld(unsigned* p)              { return __hip_atomic_load(p, __ATOMIC_RELAXED, __HIP_MEMORY_SCOPE_AGENT); }
__device__ __forceinline__ unsigned xb_add(unsigned* p, unsigned v) { return __hip_atomic_fetch_add(p, v, __ATOMIC_RELAXED, __HIP_MEMORY_SCOPE_AGENT); }
__device__ __forceinline__ unsigned xb_xcc_id() { return (unsigned)__builtin_amdgcn_s_getreg((3 << 11) | 20) & 0xFu; }
#define XB_SPIN(cond, bar) do { unsigned _sp = 0; while (cond) { __builtin_amdgcn_s_sleep(1); \
    if ((++_sp & 255u) == 0u) { if (xb_ld(&(bar)[XB_TMO])) break; if (_sp > XB_SPIN_CAP) { atomicAdd(&(bar)[XB_TMO], 1u); break; } } } } while (0)

struct XcdBarrier {
    unsigned* bar; unsigned x;
    volatile LAS unsigned* st;
};

__device__ __forceinline__ XcdBarrier xcd_barrier_post(unsigned* bar, volatile LAS unsigned* st) {
    XcdBarrier b; b.bar = bar; b.x = xb_xcc_id(); b.st = st;
    if (threadIdx.x == 0) (void)xb_add(&bar[XB_XCNT(b.x)], 1u);
    return b;
}
__device__ __forceinline__ void xcd_barrier_complete(unsigned* bar, unsigned x, unsigned& nloc, unsigned& nx) {
    const unsigned G = gridDim.x * gridDim.y * gridDim.z;
    unsigned sum, cnt, mine, sp = 0u;
    for (;;) {
        sum = 0u; cnt = 0u; mine = 0u;
#pragma unroll
        for (unsigned j = 0; j < 16; ++j) { const unsigned c = xb_ld(&bar[XB_XCNT(j)]); sum += c; cnt += (c > 0u) ? 1u : 0u; mine = (j == x) ? c : mine; }
        if (sum == G) break;
        __builtin_amdgcn_s_sleep(1);
        if ((++sp & 255u) == 0u) { if (xb_ld(&bar[XB_TMO])) break; if (sp > XB_SPIN_CAP) { atomicAdd(&bar[XB_TMO], 1u); break; } }
    }
    nloc = mine > 0u ? mine : 1u; nx = cnt > 0u ? cnt : 1u;
}

__device__ __forceinline__ void xcd_barrier(const XcdBarrier& b) {
    asm volatile("s_waitcnt vmcnt(0)" ::: "memory");
    __syncthreads();
    if (threadIdx.x == 0) {
        unsigned* bar = b.bar;
        __builtin_amdgcn_s_waitcnt(0);
        unsigned nloc = b.st[0], nx = b.st[1];
        if (nloc == 0u) { xcd_barrier_complete(bar, b.x, nloc, nx); b.st[0] = nloc; b.st[1] = nx; }
        const unsigned old = xb_add(&bar[XB_XSUB(b.x)], 1u);
        const unsigned gen = old / nloc;
        if (old + 1u == (gen + 1u) * nloc) {
            __builtin_amdgcn_fence(__ATOMIC_RELEASE, "agent");
            asm volatile("s_waitcnt vmcnt(0)" ::: "memory");
            const unsigned og = xb_add(&bar[XB_TOP], 1u);
            const unsigned tg = og / nx;
            if (og + 1u == (tg + 1u) * nx) xb_add(&bar[XB_TOPGEN], 1u);
            else XB_SPIN(xb_ld(&bar[XB_TOPGEN]) == tg, bar);
            __builtin_amdgcn_fence(__ATOMIC_ACQUIRE, "agent");
            xb_add(&bar[XB_XGEN(b.x)], 1u);
            asm volatile("s_waitcnt vmcnt(0)" ::: "memory");
        } else {
            XB_SPIN(xb_ld(&bar[XB_XGEN(b.x)]) == gen, bar);
            __builtin_amdgcn_fence(__ATOMIC_ACQUIRE, "agent");
            asm volatile("s_waitcnt vmcnt(0)" ::: "memory");
        }
    }
    __syncthreads();
}

__global__ void __launch_bounds__(NWAVES * 64, 2) hymba_fwd(Args a) {
    extern __shared__ __attribute__((aligned(16))) unsigned char lds_raw[];
    LAS unsigned char* lds = (LAS unsigned char*)lds_raw;
    cg::grid_group grid = cg::this_grid();
    const int wave = __builtin_amdgcn_readfirstlane((int)threadIdx.x >> 6);
#define FRESH_IDS const int lane = fresh_lane(), tid = wave * 64 + lane; (void)tid; (void)lane
    const int G = gridDim.x, bx = blockIdx.x, vcu = (G % 8 == 0) ? (bx % 8) * (G / 8) + bx / 8 : bx;
    volatile LAS unsigned* bst = (volatile LAS unsigned*)(lds + LDS_BYTES - 32);
    if (threadIdx.x < 2) bst[threadIdx.x] = 0u;
    __syncthreads();
    XcdBarrier bar = xcd_barrier_post((unsigned*)a.ws + a.ph_lo * 4096, bst);
    unsigned char* ws = a.ws;
    const int lo = a.ph_lo, hi = a.ph_hi;
#define IN(k) (lo <= (k) && (k) < hi)
#define SEAM(k) do { if (IN(k) && IN((k) + 1)) xcd_barrier(bar); } while (0)
    if (a.ph_hi > 1000) grid.sync();

    if (IN(0)) { FRESH_IDS; phase0(a, lds, vcu, G, wave, lane, tid); }
    SEAM(0);
    if (IN(1)) {
        pg8::Gemm g{(const pg8::bf16_t*)(ws + WS_XN), (const pg8::bf16_t*)(ws + WS_WIN), MP, INW, DM}; pg8::StaticOrder S; S.init(MP, INW, G, bx);
        pg8::EpiStore E{(pg8::bf16_t*)(ws + WS_PROJ), INW};
        pg8::gemm_phase<pg8::EpiStore, pg8::StaticOrder, true, true>(lds, g, S, E, wave);
    }
    SEAM(1);
    if (IN(2)) {
        { FRESH_IDS; phase_qk(a, vcu, G, wave, lane); }
        { FRESH_IDS; lru_phase<false>(a, lds, bx, G, wave, lane, tid); }
    }
    SEAM(2);
    if (IN(3)) {
        for (int g = bx; g < 192; g += G) { FRESH_IDS; lru_carry(a, lds, g, tid); }
        const float negM = *(const float*)(ws + WS_NEGM);
        const attn_body::bf16* proj = (const attn_body::bf16*)(ws + WS_PROJ); attn_body::bf16* mix = (attn_body::bf16*)(ws + WS_XN);
        if (G == 256) {
            const int x = bx & 7, jl = bx >> 3;
            for (int i = 0; i < 12; ++i) { const int pi = x + 8 * (i >> 2), w = jl * 4 + (i & 3), b = pi >> 1, kvh = pi & 1, h = kvh * 4 + (w >> 5), qb = w & 31;
                attn_body::attn_unit<8>(proj + ((size_t)b * LSEQ + NMETA + qb * 256) * INW + h * 64, proj + (size_t)b * LSEQ * INW + COL_K + kvh * 64, proj + (size_t)b * LSEQ * INW + COL_V + kvh * 64,
                                        mix + ((size_t)b * SEQ + qb * 256) * DM + h * 64, (char*)lds_raw, negM, wave, a.q_norm_g, (const float*)(ws + WS_COS), (const float*)(ws + WS_SIN), qb * 256); }
        } else {
            for (int u = bx; u < NSEQ * 8 * 32; u += G) { const int b = u >> 8, h = (u >> 5) & 7, qb = u & 31, kvh = h >> 2;
                attn_body::attn_unit<8>(proj + ((size_t)b * LSEQ + NMETA + qb * 256) * INW + h * 64, proj + (size_t)b * LSEQ * INW + COL_K + kvh * 64, proj + (size_t)b * LSEQ * INW + COL_V + kvh * 64,
                                        mix + ((size_t)b * SEQ + qb * 256) * DM + h * 64, (char*)lds_raw, negM, wave, a.q_norm_g, (const float*)(ws + WS_COS), (const float*)(ws + WS_SIN), qb * 256); }
        }
    }
    SEAM(3);
    if (IN(4)) { FRESH_IDS; mix_norm_phase(a, vcu, G, wave, lane); }
    SEAM(4);
    if (IN(5)) {
        pg8::Gemm g{(const pg8::bf16_t*)(ws + WS_XN), (const pg8::bf16_t*)(ws + WS_WOUT), MC, DM, DM}; pg8::StaticOrder S; S.init(MC, DM, G, bx);
        pg8::EpiResid1 E{a.x_prompt, a.x_sample, a.out, (pg8::bf16_t*)(ws + WS_H1B), (float*)(ws + WS_SSQ1)};
        pg8::gemm_phase<pg8::EpiResid1, pg8::StaticOrder, true, true>(lds, g, S, E, wave);
    }
    SEAM(5);
    if (IN(6)) {
        pg8::Gemm g{(const pg8::bf16_t*)(ws + WS_H1B), (const pg8::bf16_t*)(ws + WS_WGU), MC, 2 * FFH, DM}; pg8::StaticOrder S; S.init(MC, 2 * FFH, G, bx);
        pg8::EpiSwiglu E{(pg8::bf16_t*)(ws + WS_HID), FFH, (const float*)(ws + WS_SSQ1)};
        pg8::gemm_phase<pg8::EpiSwiglu, pg8::StaticOrder, true, true>(lds, g, S, E, wave);
    }
    SEAM(6);
    if (IN(7)) {
        pg8::Gemm g{(const pg8::bf16_t*)(ws + WS_HID), (const pg8::bf16_t*)(ws + WS_WDN), MC, DM, FFH}; pg8::StaticOrder S; S.init(MC, DM, G, bx);
        if (G == 256) { pg8::EpiFinal E{a.out, (const pg8::bf16_t*)(ws + WS_H1B), a.final_norm_g, (float*)(ws + WS_SSQ2), (unsigned*)(ws + WS_CNT), lds + 131072};
            pg8::gemm_phase<pg8::EpiFinal, pg8::StaticOrder, true, true>(lds, g, S, E, wave); }
        else { pg8::EpiResid2 E{a.out, (float*)(ws + WS_SSQ2), (const pg8::bf16_t*)(ws + WS_H1B)};
            pg8::gemm_phase<pg8::EpiResid2, pg8::StaticOrder, true, true>(lds, g, S, E, wave); }
    }
    if (G != 256) {
    SEAM(7);
    if (IN(8)) {
        FRESH_IDS;
        const int gw = vcu * NWAVES + wave, NGW = G * NWAVES; const float* ssq = (const float*)(ws + WS_SSQ2);
        f32x4 g4[4];
#pragma unroll
        for (int j = 0; j < 4; ++j) g4[j] = *((const f32x4*)a.final_norm_g + lane + 64 * j);
        for (int r = gw; r < MC; r += NGW) { f32x4* xr = (f32x4*)(a.out + (size_t)r * DM) + lane;
            const f32x4* sp = (const f32x4*)(ssq + (size_t)r * 16); const f32x4 s0 = sp[0], s1 = sp[1], s2 = sp[2], s3 = sp[3];
            const float tot = (((s0[0] + s0[1]) + (s0[2] + s0[3])) + ((s1[0] + s1[1]) + (s1[2] + s1[3]))) + (((s2[0] + s2[1]) + (s2[2] + s2[3])) + ((s3[0] + s3[1]) + (s3[2] + s3[3])));
            const float rstd = __builtin_amdgcn_rsqf(tot * (1.0f / DM) + 1e-6f);
#pragma unroll
            for (int j = 0; j < 4; ++j) xr[64 * j] = xr[64 * j] * rstd * g4[j]; }
    }
    }
#undef IN
#undef SEAM
}

extern "C" void kernel_launch(void* const* d_in, const int* in_sizes, int n_in, void* d_out, int out_size, void* d_ws, size_t ws_size, hipStream_t stream) {
    static int grid = 0;
    if (grid == 0) {
        if (n_in != 21 || out_size != MC * DM || ws_size < WS_END) { fprintf(stderr, "kernel_launch: unexpected shapes (n_in %d out %d ws %zu)\n", n_in, out_size, ws_size); grid = -1; return; }
        int dev = 0, cus = 0, per_cu = 0;
        (void)hipGetDevice(&dev); (void)hipDeviceGetAttribute(&cus, hipDeviceAttributeMultiprocessorCount, dev);
        if (hipFuncSetAttribute((const void*)hymba_fwd, hipFuncAttributeMaxDynamicSharedMemorySize, LDS_BYTES) != hipSuccess) { fprintf(stderr, "kernel_launch: hipFuncSetAttribute failed\n"); grid = -1; return; }
        if (hipOccupancyMaxActiveBlocksPerMultiprocessor(&per_cu, (const void*)hymba_fwd, NWAVES * 64, LDS_BYTES) != hipSuccess || per_cu < 1) { fprintf(stderr, "kernel_launch: occupancy query says %d\n", per_cu); per_cu = 1; }
        (void)hipGetLastError();
        grid = cus * 1;
        if (grid <= 0) grid = 256;
    }
    if (grid < 0) return;
    (void)hipMemsetAsync(d_ws, 0, 16384 * NPHASE, stream);
    Args a{};
    const float** slots[21] = {&a.x_prompt, &a.x_sample, &a.meta, &a.norm_mix_g, &a.w_in, &a.q_norm_g, &a.k_norm_g, &a.conv_w, &a.conv_b, &a.lru_w_a, &a.lru_b_a, &a.lru_w_x, &a.lru_b_x, &a.lru_lam,
                               &a.attn_out_g, &a.lru_out_g, &a.w_out, &a.norm_ffn_g, &a.w_gate_up, &a.w_down, &a.final_norm_g};
    for (int i = 0; i < 21; ++i) *slots[i] = (const float*)d_in[i];
    a.out = (float*)d_out; a.ws = (unsigned char*)d_ws;
#if MK_N_LAUNCHES == 1
    a.ph_lo = 0; a.ph_hi = NPHASE;
    void* args[] = {&a};
    hipError_t e = hipLaunchCooperativeKernel((const void*)hymba_fwd, dim3(grid), dim3(NWAVES * 64), args, LDS_BYTES, stream);
    if (e != hipSuccess) fprintf(stderr, "kernel_launch: cooperative launch failed: %s (grid %d)\n", hipGetErrorString(e), grid);
#else
    for (int p = 0; p < NPHASE; ++p) { a.ph_lo = p; a.ph_hi = p + 1; hipLaunchKernelGGL(hymba_fwd, dim3(grid), dim3(NWAVES * 64), LDS_BYTES, stream, a); }
#endif
}
```
